# Optimizing an MI355X kernel written in HIP

```python
import jax, jax.numpy as jnp
from jax import lax
import numpy as np

D_MODEL = 1024
BATCH = 16
SEQ = 4096
DEPTH = 4

GRID_W = 64
NORM_EPS = 1e-6
N_DIR = 2
RW_HEADS = 8
RW_HEAD_DIM = 64
RW_WIDTH = RW_HEADS * RW_HEAD_DIM
RW_DECAY_LORA = 64
RW_ICLR_LORA = 64
RW_GATE_LORA = 128
RW_LN_EPS = 64e-5
CV_GROUPS = 8
CV_WIDTH = CV_GROUPS * 64
CV_KSIZE = 3
AT_Q_HEADS = 8
AT_KV_HEADS = 2
AT_HEAD_DIM = 64
AT_Q_BLOCK = 128
ROPE_THETA = 10000.0
N_BRANCH = 3
BRANCH_WIDTH = 512
D_FF = 4 * D_MODEL

RW_COLS = 3 * RW_WIDTH + N_DIR * RW_DECAY_LORA + N_DIR * RW_ICLR_LORA + RW_GATE_LORA
CV_COLS = 3 * CV_WIDTH
AT_COLS = (AT_Q_HEADS + 2 * AT_KV_HEADS) * AT_HEAD_DIM
GATE_COLS = N_BRANCH * D_MODEL
IN_COLS = RW_COLS + CV_COLS + AT_COLS + GATE_COLS

kernel_name = "hybrid_rwkv7_conv_gqa_gated_encoder"


def rmsnorm(x, g, eps=NORM_EPS):
    xf = x.astype(jnp.float32)
    y = xf * lax.rsqrt(jnp.mean(xf * xf, axis=-1, keepdims=True) + eps)
    return (y * g.astype(jnp.float32)).astype(x.dtype)


def split_cols(z, sizes):
    offs = np.concatenate([[0], np.cumsum(sizes)]).astype(int)
    return [z[..., int(offs[i]):int(offs[i + 1])] for i in range(len(sizes))]


def token_shift_centred(z, mu_prev, mu_next):
    zp = jnp.pad(z, ((0, 0), (1, 0), (0, 0)))[:, :-1]
    zn = jnp.pad(z, ((0, 0), (0, 1), (0, 0)))[:, 1:]
    return z + mu_prev * (zp - z) + mu_next * (zn - z)


def to_dir_scan(z):
    z = jnp.stack([z[:, :, 0], jnp.flip(z[:, :, 1], axis=1)], axis=0)
    return jnp.moveaxis(z, 2, 0)


def rwkv7_bidir(cols, mu_prev, mu_next, w0, w2, a0, a2, g2, k_k, k_a, r_k, ln_g, ln_b):
    B, S, _ = cols.shape
    H, N = RW_HEADS, RW_HEAD_DIM
    z = token_shift_centred(cols.astype(jnp.float32), mu_prev, mu_next)
    r, k, v, wd, ad, gd = split_cols(z, [RW_WIDTH] * 3 + [N_DIR * RW_DECAY_LORA, N_DIR * RW_ICLR_LORA, RW_GATE_LORA])
    heads = lambda t: t.reshape(t.shape[:-1] + (H, N))
    shared = lambda t: jnp.broadcast_to(t[:, :, None], (B, S, N_DIR, H, N))
    w_raw = w0 + jnp.einsum('bsdr,drc->bsdc', jnp.tanh(wd.reshape(B, S, N_DIR, RW_DECAY_LORA)), w2)
    decay = jnp.exp(-jnp.exp(-jax.nn.softplus(-w_raw) - 0.5))
    a = jax.nn.sigmoid(a0 + jnp.einsum('bsdr,drc->bsdc', ad.reshape(B, S, N_DIR, RW_ICLR_LORA), a2))
    g = jnp.einsum('bsr,rc->bsc', jax.nn.sigmoid(gd), g2)
    kk = heads(k * k_k)
    kk = kk / jnp.maximum(jnp.sqrt(jnp.sum(kk * kk, axis=-1, keepdims=True)), 1e-12)
    k_dir = k[:, :, None, :] * (1.0 + (a - 1.0) * k_a)
    kka = kk[:, :, None] * heads(a)
    xs = (to_dir_scan(shared(heads(r))), to_dir_scan(heads(decay)), to_dir_scan(heads(k_dir)),
          to_dir_scan(shared(heads(v))), to_dir_scan(shared(kk)), to_dir_scan(kka))

    def step(state, inp):
        r_t, w_t, k_t, v_t, kk_t, kka_t = inp
        sa = jnp.einsum('dbhvk,dbhk->dbhv', state, kk_t)
        state = state * w_t[..., None, :] - sa[..., :, None] * kka_t[..., None, :] + v_t[..., :, None] * k_t[..., None, :]
        y = jnp.einsum('dbhvk,dbhk->dbhv', state, r_t)
        return state, y

    state0 = jnp.zeros((N_DIR, B, H, N, N), jnp.float32)
    _, ys = lax.scan(step, state0, xs)
    y = jnp.moveaxis(ys[:, 0] + jnp.flip(ys[:, 1], axis=0), 0, 1)
    mu = jnp.mean(y, axis=-1, keepdims=True)
    var = jnp.mean(jnp.square(y - mu), axis=-1, keepdims=True)
    y = ((y - mu) * lax.rsqrt(var + RW_LN_EPS)).reshape(B, S, RW_WIDTH) * ln_g + ln_b
    k_bonus = heads(jnp.mean(k_dir, axis=2))
    bonus = jnp.sum(heads(r) * k_bonus * r_k, axis=-1, keepdims=True) * heads(v)
    return ((y + bonus.reshape(B, S, RW_WIDTH)) * g).astype(cols.dtype)


def short_gated_conv(cols, w, b):
    b_gate, c_gate, x_in = split_cols(cols, [CV_WIDTH] * 3)
    z = c_gate * x_in
    S = z.shape[1]
    zp = jnp.pad(z, ((0, 0), (1, 1), (0, 0)))
    conv = b + sum(w[j] * zp[:, j:j + S] for j in range(CV_KSIZE))
    return b_gate * conv


def axial_rope_tables(S):
    rows = S // GRID_W
    row = jnp.repeat(jnp.arange(rows), GRID_W).astype(jnp.float32)
    col = jnp.tile(jnp.arange(GRID_W), rows).astype(jnp.float32)
    half = AT_HEAD_DIM // 2
    inv = ROPE_THETA ** (-jnp.arange(0, half, 2, dtype=jnp.float32) / half)
    ang_r = row[:, None] * inv
    ang_c = col[:, None] * inv
    return jnp.cos(ang_r), jnp.sin(ang_r), jnp.cos(ang_c), jnp.sin(ang_c)


def rotate_half(x, cos, sin):
    d2 = x.shape[-1] // 2
    x1, x2 = x[..., :d2], x[..., d2:]
    c, s = cos[:, None, :], sin[:, None, :]
    return jnp.concatenate([x1 * c - x2 * s, x2 * c + x1 * s], axis=-1)


def apply_axial_rope(x, tabs):
    cr, sr, cc, sc = tabs
    half = AT_HEAD_DIM // 2
    xf = x.astype(jnp.float32)
    out = jnp.concatenate([rotate_half(xf[..., :half], cr, sr), rotate_half(xf[..., half:], cc, sc)], axis=-1)
    return out.astype(x.dtype)


def gqa_axial(cols, q_g, k_g, tabs):
    B, S, _ = cols.shape
    G = AT_Q_HEADS // AT_KV_HEADS
    q, k, v = split_cols(cols, [AT_Q_HEADS * AT_HEAD_DIM, AT_KV_HEADS * AT_HEAD_DIM, AT_KV_HEADS * AT_HEAD_DIM])
    q = apply_axial_rope(rmsnorm(q.reshape(B, S, AT_Q_HEADS, AT_HEAD_DIM), q_g), tabs)
    k = apply_axial_rope(rmsnorm(k.reshape(B, S, AT_KV_HEADS, AT_HEAD_DIM), k_g), tabs)
    v = v.reshape(B, S, AT_KV_HEADS, AT_HEAD_DIM)
    q = (q * (AT_HEAD_DIM ** -0.5)).reshape(B, S // AT_Q_BLOCK, AT_Q_BLOCK, AT_KV_HEADS, G, AT_HEAD_DIM)
    q = jnp.moveaxis(q, 1, 0)

    def block(qb):
        s = jnp.einsum('bqkgd,bskd->bkgqs', qb, k).astype(jnp.float32)
        p = jax.nn.softmax(s, axis=-1).astype(v.dtype)
        return jnp.einsum('bkgqs,bskd->bqkgd', p, v)

    o = lax.map(block, q)
    return jnp.moveaxis(o, 0, 1).reshape(B, S, AT_Q_HEADS * AT_HEAD_DIM)


def setup_inputs(seed: int = 0) -> dict:
    key = jax.random.key(seed)
    ks = jax.random.split(key, 32)
    L, D = DEPTH, D_MODEL
    nrm = lambda k, shape, s: jax.random.normal(k, shape, jnp.float32) * s
    uni = lambda k, shape, lo, hi: jax.random.uniform(k, shape, jnp.float32, lo, hi)
    return {
        "x": nrm(ks[0], (BATCH, SEQ, D), 1.0),
        "norm1_g": 1.0 + nrm(ks[1], (L, D), 0.02),
        "w_in": nrm(ks[2], (L, D, IN_COLS), D ** -0.5),
        "rw_mu_prev": uni(ks[3], (L, RW_COLS), 0.0, 0.5),
        "rw_mu_next": uni(ks[4], (L, RW_COLS), 0.0, 0.5),
        "rw_w0": uni(ks[5], (L, N_DIR, RW_WIDTH), -6.0, 1.0),
        "rw_w2": nrm(ks[6], (L, N_DIR, RW_DECAY_LORA, RW_WIDTH), 0.1),
        "rw_a0": nrm(ks[7], (L, N_DIR, RW_WIDTH), 0.5),
        "rw_a2": nrm(ks[8], (L, N_DIR, RW_ICLR_LORA, RW_WIDTH), 0.1),
        "rw_g2": nrm(ks[9], (L, RW_GATE_LORA, RW_WIDTH), RW_GATE_LORA ** -0.5),
        "rw_k_k": 0.85 + nrm(ks[10], (L, RW_WIDTH), 0.05),
        "rw_k_a": 1.0 + nrm(ks[11], (L, RW_WIDTH), 0.05),
        "rw_r_k": nrm(ks[12], (L, RW_HEADS, RW_HEAD_DIM), 0.1),
        "rw_ln_g": 1.0 + nrm(ks[13], (L, RW_WIDTH), 0.02),
        "rw_ln_b": nrm(ks[14], (L, RW_WIDTH), 0.01),
        "cv_w": nrm(ks[15], (L, CV_KSIZE, CV_WIDTH), 0.5),
        "cv_b": nrm(ks[16], (L, CV_WIDTH), 0.01),
        "at_q_g": 1.0 + nrm(ks[17], (L, AT_HEAD_DIM), 0.02),
        "at_k_g": 1.0 + nrm(ks[18], (L, AT_HEAD_DIM), 0.02),
        "w_branch": nrm(ks[19], (L, N_BRANCH, BRANCH_WIDTH, D), BRANCH_WIDTH ** -0.5),
        "w_out": nrm(ks[20], (L, D, D), D ** -0.5),
        "norm2_g": 1.0 + nrm(ks[21], (L, D), 0.02),
        "w_mlp1": nrm(ks[22], (L, D, D_FF), D ** -0.5),
        "w_mlp2": nrm(ks[23], (L, D_FF, D), D_FF ** -0.5),
    }


def reference(x, norm1_g, w_in, rw_mu_prev, rw_mu_next, rw_w0, rw_w2, rw_a0, rw_a2, rw_g2,
              rw_k_k, rw_k_a, rw_r_k, rw_ln_g, rw_ln_b, cv_w, cv_b, at_q_g, at_k_g,
              w_branch, w_out, norm2_g, w_mlp1, w_mlp2):
    B, S, D = x.shape
    tabs = axial_rope_tables(S)
    for l in range(DEPTH):
        h = rmsnorm(x, norm1_g[l])
        cols = h @ w_in[l]
        rw_c, cv_c, at_c, gate_c = split_cols(cols, [RW_COLS, CV_COLS, AT_COLS, GATE_COLS])
        y_rw = rwkv7_bidir(rw_c, rw_mu_prev[l], rw_mu_next[l], rw_w0[l], rw_w2[l], rw_a0[l], rw_a2[l],
                           rw_g2[l], rw_k_k[l], rw_k_a[l], rw_r_k[l], rw_ln_g[l], rw_ln_b[l])
        y_cv = short_gated_conv(cv_c, cv_w[l], cv_b[l])
        y_at = gqa_axial(at_c, at_q_g[l], at_k_g[l], tabs)
        gates = jax.nn.sigmoid(gate_c.reshape(B, S, N_BRANCH, D))
        merged = (gates[:, :, 0] * (y_rw @ w_branch[l, 0])
                  + gates[:, :, 1] * (y_cv @ w_branch[l, 1])
                  + gates[:, :, 2] * (y_at @ w_branch[l, 2]))
        x = x + (merged @ w_out[l]).astype(x.dtype)
        h = rmsnorm(x, norm2_g[l])
        u = jnp.square(jax.nn.relu(h @ w_mlp1[l]))
        x = x + (u @ w_mlp2[l]).astype(x.dtype)
    return x
```

```cpp
#include <hip/hip_runtime.h>
#include <hip/hip_cooperative_groups.h>
#include <cstdio>
#include <cstdint>
namespace cg = cooperative_groups;

#define LAS __attribute__((address_space(3)))
#define GAS __attribute__((address_space(1)))
typedef unsigned short bf16_t;
typedef short bf16x8 __attribute__((ext_vector_type(8)));
typedef short bf16x4 __attribute__((ext_vector_type(4)));
typedef float f32x2 __attribute__((ext_vector_type(2)));
typedef float f32x4 __attribute__((ext_vector_type(4)));
typedef float f32x16 __attribute__((ext_vector_type(16)));
typedef unsigned u32x2 __attribute__((ext_vector_type(2)));
typedef unsigned u32x4 __attribute__((ext_vector_type(4)));

constexpr int D_MODEL = 1024, BATCH = 16, SEQ = 4096, DEPTH = 4, D_FF = 4096;
constexpr int T = BATCH * SEQ;
constexpr int IN_COLS = 7296, RW_COLS = 1920;
constexpr int NWIN = 7424;
constexpr int LD_RWC = 2048, LD_C2 = 2304;
constexpr float LOG2E = 1.4426950408889634f;

constexpr size_t MiB = 1u << 20;
constexpr size_t WS_WIN = 2 * MiB, WS_WBR = 17 * MiB, WS_WOUT = 20 * MiB, WS_W1 = 22 * MiB, WS_W2 = 30 * MiB;
constexpr size_t WS_W2T = 38 * MiB, WS_A2T = 38 * MiB + 131072, WS_G2T = 38 * MiB + 262144;
constexpr size_t WS_H = 40 * MiB, WS_RWC = 168 * MiB, WS_C2 = 424 * MiB, WS_YF = 712 * MiB, WS_YB = 776 * MiB;
constexpr size_t WS_SG = 840 * MiB, WS_VT = 872 * MiB, WS_SB = 888 * MiB, WS_END = 892 * MiB;
#ifdef MK_GT_FRESH
constexpr size_t WS_GT = 892 * MiB;
#else
constexpr size_t WS_GT = WS_RWC;
#endif
constexpr size_t WS_MRG = WS_RWC + 128 * MiB, WS_U = WS_RWC;

#ifndef MK_GATE_ACT
#define MK_GATE_ACT 1
#endif
#ifndef MK_P4_CALLS
#define MK_P4_CALLS 6
#endif
constexpr int P4_CALLS = MK_P4_CALLS;
#ifndef MK_PHMASK
#define MK_PHMASK 0xffffffffu
#endif
constexpr unsigned PHMASK = MK_PHMASK;
constexpr int LDS_BYTES = 135168;

typedef __bf16 bf16x2_t __attribute__((ext_vector_type(2)));
__device__ __forceinline__ unsigned cvt_pk_bf16(float lo, float hi) { const f32x2 v = {lo, hi}; const bf16x2_t b = __builtin_convertvector(v, bf16x2_t); return __builtin_bit_cast(unsigned, b); }
__device__ __forceinline__ bf16_t f2bf(float f) { return (bf16_t)(cvt_pk_bf16(f, 0.f) & 0xffffu); }
__device__ __forceinline__ float bflo(unsigned u) { return __builtin_bit_cast(float, u << 16); }
__device__ __forceinline__ float bfhi(unsigned u) { return __builtin_bit_cast(float, u & 0xffff0000u); }
__device__ __forceinline__ void unpack8(const u32x4 v, float* f) { f[0] = bflo(v.x); f[1] = bfhi(v.x); f[2] = bflo(v.y); f[3] = bfhi(v.y); f[4] = bflo(v.z); f[5] = bfhi(v.z); f[6] = bflo(v.w); f[7] = bfhi(v.w); }
__device__ __forceinline__ u32x4 pack8(const float* f) { u32x4 w; w.x = cvt_pk_bf16(f[0], f[1]); w.y = cvt_pk_bf16(f[2], f[3]); w.z = cvt_pk_bf16(f[4], f[5]); w.w = cvt_pk_bf16(f[6], f[7]); return w; }
__device__ __forceinline__ float trans_settle(float x) { float r; asm volatile("s_nop 1\n\tv_mov_b32 %0, %1" : "=v"(r) : "v"(x)); return r; }
__device__ __forceinline__ float sigmoid_f(float x) { return __builtin_amdgcn_rcpf(1.f + __builtin_amdgcn_exp2f(-LOG2E * x)); }
__device__ __forceinline__ float tanh_f(float x) { return 1.f - 2.f * __builtin_amdgcn_rcpf(1.f + __builtin_amdgcn_exp2f(2.f * LOG2E * x)); }
__device__ __forceinline__ float wave_sum(float v) {
#pragma unroll
    for (int o = 1; o < 64; o <<= 1) v += __shfl_xor(v, o);
    return v;
}
template <int CTRL> __device__ __forceinline__ float dpp_f(float x) { return __builtin_bit_cast(float, __builtin_amdgcn_update_dpp(0, __builtin_bit_cast(int, x), CTRL, 0xf, 0xf, true)); }
__device__ __forceinline__ float red8(float x) { x += dpp_f<0xB1>(x); x += dpp_f<0x4E>(x); x += dpp_f<0x141>(x); return x; }
__device__ __forceinline__ float red16(float x) { x = red8(x); x += dpp_f<0x140>(x); return x; }

namespace pg8 {
constexpr int BM = 256, BK = 64, HALF = 128, HTB = HALF * BK * 2, STAGE_BYTES = 8 * HTB, NXCD = 8, WGM = 8;
__host__ __device__ __forceinline__ int lds_byte(int r, int c) { const int st = (r >> 4) * 2 + (c >> 5), rr = r & 15, cc = c & 31, ob = rr * 64 + cc * 2; return st * 1024 + (ob ^ (((ob >> 9) & 1) << 5)); }
__host__ __device__ __forceinline__ void stage_rc(int b, int& R, int& C) { const int st = b / 1024, sb = b % 1024, swz = sb ^ (((sb >> 9) & 1) << 5); R = (st >> 1) * 16 + swz / 64; C = (st & 1) * 32 + (swz % 64) / 2; }
__host__ __device__ __forceinline__ int perm32(int rho) { const int n = rho >> 4, i = rho & 15; return 8 * (i >> 2) + 4 * n + (i & 3); }

struct Unit { int pm, pn; };
struct Gemm { const bf16_t* A; const bf16_t* Bt; int M, N, K, lda; };

struct StaticOrder {
    int nM, nN, nwg, G, c;
    __device__ void init(int M, int N, int G_, int c_) { nM = M / BM; nN = N / BM; nwg = nM * nN; G = G_; c = c_; }
    __device__ bool next(int i, Unit& u) const {
        const long L = (long)i * G + c; if (L >= nwg) return false;
        int wgid = (int)L; { const int q = nwg / NXCD, r = nwg % NXCD, xcd = wgid % NXCD, off = wgid / NXCD; wgid = (xcd < r ? xcd * (q + 1) : r * (q + 1) + (xcd - r) * q) + off; }
        const int nig = WGM * nN, gid = wgid / nig, fm = gid * WGM, gsz = (nM - fm) < WGM ? (nM - fm) : WGM;
        u.pm = fm + ((wgid % nig) % gsz); u.pn = (wgid % nig) / gsz; return true;
    }
};

template <class Epi>
__device__ __forceinline__ void gemm_phase(LAS unsigned char* lds, const Gemm g, const StaticOrder& S, const Epi& E) {
    int tid = threadIdx.x; asm volatile("" : "+v"(tid));
    const int wid = __builtin_amdgcn_readfirstlane(tid >> 6), lane = tid & 63, wr = wid >> 2, wc = wid & 3, fr = lane & 15, fq = lane >> 4;
    const int K = g.K, nt = K / BK, lda = g.lda;
    unsigned voffA[2], voffB[2];
#pragma unroll
    for (int i = 0; i < 2; ++i) { int R, C; stage_rc(tid * 16 + i * 8192, R, C); const int Rb = Epi::PERM ? ((R & ~31) + perm32(R & 31)) : R;
        voffA[i] = (unsigned)(R * lda + C) * 2u; voffB[i] = (unsigned)(Rb * K + C) * 2u; }
    const size_t kstep = (size_t)(BK * 2);
    const size_t hstepA = (size_t)HALF * lda * 2, hstepB = (size_t)HALF * K * 2;
    const size_t tstepA = 2 * hstepA, tstepB = 2 * hstepB;
    const unsigned ldsw = (unsigned)wid * 1024u;
    const int aoff = lds_byte(wr * 64 + fr, fq * 8), boff = lds_byte(wc * 32 + fr, fq * 8);
#define PG8_SA(b, h) (((b) * 2 + (h)) * HTB)
#define PG8_SB(b, h) ((4 + (b) * 2 + (h)) * HTB)
#define PG8_STAGE(bufoff, gbase, voff) do { _Pragma("unroll") for (int _i = 0; _i < 2; ++_i) \
        __builtin_amdgcn_global_load_lds((const unsigned*)((const char*)(gbase) + (voff)[_i]), (LAS unsigned*)(lds + (bufoff) + ldsw + _i * 8192), 16, 0, 0); } while (0)
#define PG8_LDA(dst, b, h) do { _Pragma("unroll") for (int m = 0; m < 4; ++m) _Pragma("unroll") for (int k = 0; k < 2; ++k) dst[m][k] = *(const LAS bf16x8*)(lds + PG8_SA(b, h) + aoff + m * 2048 + k * 1024); } while (0)
#define PG8_LDB(dst, b, h) do { _Pragma("unroll") for (int n = 0; n < 2; ++n) _Pragma("unroll") for (int k = 0; k < 2; ++k) dst[n][k] = *(const LAS bf16x8*)(lds + PG8_SB(b, h) + boff + n * 2048 + k * 1024); } while (0)
#define PG8_MMA(ai, bj, At, Bt) do { __builtin_amdgcn_s_setprio(1); _Pragma("unroll") for (int m = 0; m < 4; ++m) _Pragma("unroll") for (int n = 0; n < 2; ++n) _Pragma("unroll") for (int k = 0; k < 2; ++k) \
        acc[ai][bj][m][n] = __builtin_amdgcn_mfma_f32_16x16x32_bf16(Bt[n][k], At[m][k], acc[ai][bj][m][n], 0, 0, 0); __builtin_amdgcn_s_setprio(0); } while (0)
#define PG8_WAIT_V(n) asm volatile("s_waitcnt vmcnt(" #n ")" ::: "memory")
#define PG8_WAIT_L(n) asm volatile("s_waitcnt lgkmcnt(" #n ")" ::: "memory")
#define PG8_BAR __builtin_amdgcn_s_barrier()
#define PG8_SCHED __builtin_amdgcn_sched_barrier(0)
    Unit cur, nxt; int ui = 0;
    if (!S.next(0, cur)) return;
    f32x4 acc[2][2][4][2];
#pragma unroll
    for (int a = 0; a < 2; ++a)
#pragma unroll
        for (int b = 0; b < 2; ++b)
#pragma unroll
            for (int m = 0; m < 4; ++m)
#pragma unroll
                for (int n = 0; n < 2; ++n) acc[a][b][m][n] = (f32x4){0.f, 0.f, 0.f, 0.f};
    bf16x8 At[4][2], B0[2][2], B1[2][2];
    const char* cA = (const char*)g.A + (size_t)cur.pm * tstepA; const char* cB = (const char*)g.Bt + (size_t)cur.pn * tstepB;
    PG8_STAGE(PG8_SB(0, 0), cB, voffB); PG8_STAGE(PG8_SB(0, 1), cB + hstepB, voffB); PG8_STAGE(PG8_SA(0, 0), cA, voffA); PG8_STAGE(PG8_SA(0, 1), cA + hstepA, voffA);
    if (wr == 1) PG8_BAR;
    PG8_WAIT_V(2); PG8_BAR;
    PG8_STAGE(PG8_SB(1, 0), cB + kstep, voffB); PG8_STAGE(PG8_SA(1, 0), cA + kstep, voffA); PG8_STAGE(PG8_SB(1, 1), cB + hstepB + kstep, voffB);
    PG8_WAIT_V(6); PG8_BAR;
    for (;;) {
        const bool has_next = S.next(ui + 1, nxt);
        const char* nA = has_next ? (const char*)g.A + (size_t)nxt.pm * tstepA : cA; const char* nB = has_next ? (const char*)g.Bt + (size_t)nxt.pn * tstepB : cB;
#pragma nounroll
        for (int t = 0; t < nt; t += 2) {
            const bool last = (t == nt - 2);
            const char* a1 = cA + (size_t)(t + 1) * kstep;
            const char* a2 = last ? nA : cA + (size_t)(t + 2) * kstep; const char* b2 = last ? nB : cB + (size_t)(t + 2) * kstep;
            const char* a3 = a2 + kstep; const char* b3 = b2 + kstep;
            PG8_LDB(B0, 0, 0); PG8_LDB(B1, 0, 1); PG8_SCHED; PG8_LDA(At, 0, 0); PG8_STAGE(PG8_SA(1, 1), a1 + hstepA, voffA);
            PG8_WAIT_V(8); PG8_WAIT_L(0); PG8_BAR; PG8_MMA(0, 0, At, B0); PG8_MMA(0, 1, At, B1); PG8_BAR; PG8_SCHED;
            PG8_LDA(At, 0, 1); PG8_STAGE(PG8_SB(0, 0), b2, voffB); PG8_STAGE(PG8_SB(0, 1), b2 + hstepB, voffB); PG8_STAGE(PG8_SA(0, 0), a2, voffA);
            PG8_WAIT_V(8); PG8_WAIT_L(0); PG8_BAR; PG8_MMA(1, 0, At, B0); PG8_MMA(1, 1, At, B1); PG8_BAR; PG8_SCHED;
            PG8_LDB(B0, 1, 0); PG8_LDB(B1, 1, 1); PG8_SCHED; PG8_LDA(At, 1, 0); PG8_STAGE(PG8_SA(0, 1), a2 + hstepA, voffA);
            PG8_WAIT_V(8); PG8_WAIT_L(0); PG8_BAR; PG8_MMA(0, 0, At, B0); PG8_MMA(0, 1, At, B1); PG8_BAR; PG8_SCHED;
            PG8_LDA(At, 1, 1); PG8_STAGE(PG8_SB(1, 0), b3, voffB); PG8_STAGE(PG8_SB(1, 1), b3 + hstepB, voffB); PG8_STAGE(PG8_SA(1, 0), a3, voffA);
            PG8_WAIT_V(8); PG8_WAIT_L(0); PG8_BAR; PG8_MMA(1, 0, At, B0); PG8_MMA(1, 1, At, B1); PG8_BAR; PG8_SCHED;
        }
        if (wr == 0) PG8_BAR;
        E(acc, cur, wr, wc, fr, fq);
        if (!has_next) break;
#pragma unroll
        for (int a = 0; a < 2; ++a)
#pragma unroll
            for (int b = 0; b < 2; ++b)
#pragma unroll
                for (int m = 0; m < 4; ++m)
#pragma unroll
                    for (int n = 0; n < 2; ++n) acc[a][b][m][n] = (f32x4){0.f, 0.f, 0.f, 0.f};
        cur = nxt; cA = nA; cB = nB; ++ui;
        if (wr == 1) PG8_BAR;
    }
    PG8_WAIT_V(0);
    PG8_BAR;
#undef PG8_SA
#undef PG8_SB
#undef PG8_STAGE
#undef PG8_LDA
#undef PG8_LDB
#undef PG8_MMA
#undef PG8_WAIT_V
#undef PG8_WAIT_L
#undef PG8_BAR
#undef PG8_SCHED
}

#define EPI_FENCE() do { asm volatile("" ::: "memory"); __builtin_amdgcn_sched_barrier(0); } while (0)
template <int ACT> struct EpiStore {
    static constexpr bool PERM = true;
    bf16_t* O0; int ld0; bf16_t* O1; int ld1; int pn_split;
    __device__ __forceinline__ void operator()(const f32x4 (&acc)[2][2][4][2], const Unit& u, int wr, int wc, int fr, int fq) const {
        bf16_t* base; int ld, colt;
        if (u.pn < pn_split) { base = O0; ld = ld0; colt = u.pn * BM; } else { base = O1; ld = ld1; colt = (u.pn - pn_split) * BM; }
        const int row0 = u.pm * BM + wr * 64 + fr, col0 = colt + wc * 32 + 8 * fq;
#pragma unroll
        for (int ai = 0; ai < 2; ++ai)
#pragma unroll
            for (int m = 0; m < 4; ++m) { bf16_t* rowp = base + (size_t)(row0 + ai * HALF + m * 16) * ld + col0;
#pragma unroll
                for (int bj = 0; bj < 2; ++bj) { float v[8];
#pragma unroll
                    for (int j = 0; j < 4; ++j) { v[j] = acc[ai][bj][m][0][j]; v[4 + j] = acc[ai][bj][m][1][j]; }
#pragma unroll
                    for (int j = 0; j < 8; ++j) { if (ACT == 1) v[j] = sigmoid_f(v[j]); if (ACT == 2) { const float r = fmaxf(v[j], 0.f); v[j] = r * r; } }
                    *(u32x4*)(rowp + bj * HALF) = pack8(v); }
                EPI_FENCE(); }
    }
};
struct EpiResidual {
    static constexpr bool PERM = false;
    const float* xin; float* xout;
    __device__ __forceinline__ void operator()(const f32x4 (&acc)[2][2][4][2], const Unit& u, int wr, int wc, int fr, int fq) const {
        const int row0 = u.pm * BM + wr * 64 + fr, col0 = u.pn * BM + wc * 32 + 4 * fq;
#pragma unroll
        for (int ai = 0; ai < 2; ++ai)
#pragma unroll
            for (int m = 0; m < 4; ++m) { const size_t off = (size_t)(row0 + ai * HALF + m * 16) * D_MODEL + col0;
#pragma unroll
                for (int bj = 0; bj < 2; ++bj)
#pragma unroll
                    for (int n = 0; n < 2; ++n) { const f32x4 b = *(const f32x4*)(xin + off + bj * HALF + n * 16); *(f32x4*)(xout + off + bj * HALF + n * 16) = b + acc[ai][bj][m][n]; } }
    }
};
struct EpiMulInPlace {
    static constexpr bool PERM = true;
    bf16_t* Y; int ld;
    __device__ __forceinline__ void operator()(const f32x4 (&acc)[2][2][4][2], const Unit& u, int wr, int wc, int fr, int fq) const {
        const int row0 = u.pm * BM + wr * 64 + fr, col0 = u.pn * BM + wc * 32 + 8 * fq;
#pragma unroll
        for (int ai = 0; ai < 2; ++ai)
#pragma unroll
            for (int m = 0; m < 4; ++m) { bf16_t* rowp = Y + (size_t)(row0 + ai * HALF + m * 16) * ld + col0;
#pragma unroll
                for (int bj = 0; bj < 2; ++bj) { float y[8]; unpack8(*(const u32x4*)(rowp + bj * HALF), y);
#pragma unroll
                    for (int j = 0; j < 4; ++j) { y[j] *= acc[ai][bj][m][0][j]; y[4 + j] *= acc[ai][bj][m][1][j]; }
                    *(u32x4*)(rowp + bj * HALF) = pack8(y); }
                EPI_FENCE(); }
    }
};
template <bool FIRST> struct EpiBranch {
    static constexpr bool PERM = true;
    const bf16_t* Gt; bf16_t* Mg;
    __device__ __forceinline__ void operator()(const f32x4 (&acc)[2][2][4][2], const Unit& u, int wr, int wc, int fr, int fq) const {
        const int row0 = u.pm * BM + wr * 64 + fr, col0 = u.pn * BM + wc * 32 + 8 * fq;
#pragma unroll
        for (int ai = 0; ai < 2; ++ai) {
            u32x4 gq[4][2], mq[4][2];
#pragma unroll
            for (int m = 0; m < 4; ++m) { const size_t off = (size_t)(row0 + ai * HALF + m * 16) * D_MODEL + col0;
#pragma unroll
                for (int bj = 0; bj < 2; ++bj) { gq[m][bj] = *(const u32x4*)(Gt + off + bj * HALF); if (!FIRST) mq[m][bj] = *(const u32x4*)(Mg + off + bj * HALF); } }
#pragma unroll
            for (int m = 0; m < 4; ++m) { const size_t off = (size_t)(row0 + ai * HALF + m * 16) * D_MODEL + col0;
#pragma unroll
                for (int bj = 0; bj < 2; ++bj) { float gt[8], o[8]; unpack8(gq[m][bj], gt);
                    if (FIRST) {
#pragma unroll
                        for (int j = 0; j < 8; ++j) o[j] = 0.f;
                    } else unpack8(mq[m][bj], o);
#pragma unroll
                    for (int j = 0; j < 4; ++j) { o[j] += gt[j] * acc[ai][bj][m][0][j]; o[4 + j] += gt[4 + j] * acc[ai][bj][m][1][j]; }
                    *(u32x4*)(Mg + off + bj * HALF) = pack8(o); } }
            EPI_FENCE(); }
    }
};
struct EpiAttn {
    static constexpr bool PERM = false;
    bf16_t* C2; bf16_t* VT; const float* qg; const float* kg;
    __device__ __forceinline__ void operator()(const f32x4 (&acc)[2][2][4][2], const Unit& u, int wr, int wc, int fr, int fq) const {
        if (u.pn == 2 && wc >= 2) {
#pragma unroll
            for (int ai = 0; ai < 2; ++ai)
#pragma unroll
                for (int m = 0; m < 4; ++m) { const int row = u.pm * BM + ai * HALF + wr * 64 + m * 16 + fr;
                    bf16_t* rowp = C2 + (size_t)row * LD_C2 + 2048 + wc * 64 + 4 * fq;
#pragma unroll
                    for (int bj = 0; bj < 2; ++bj)
#pragma unroll
                        for (int n = 0; n < 2; ++n) { const f32x4 x = acc[ai][bj][m][n]; u32x2 w; w.x = cvt_pk_bf16(x[0], x[1]); w.y = cvt_pk_bf16(x[2], x[3]); *(u32x2*)(rowp + 32 * bj + 16 * n) = w; }
                    EPI_FENCE(); }
        } else {
            const bool isK = (u.pn == 2);
            int opq = 0; asm volatile("" : "+v"(opq));
            fq += opq; fr += opq;
            const float* gp = isK ? kg : qg;
            const int colbase = isK ? (2048 + wc * 64) : (1536 + (u.pn * 4 + wc) * 64);
            const float sc = isK ? 1.f : 0.125f * LOG2E;
            float gv[2][2][4], invf[4];
#pragma unroll
            for (int bj = 0; bj < 2; ++bj)
#pragma unroll
                for (int n = 0; n < 2; ++n)
#pragma unroll
                    for (int j = 0; j < 4; ++j) gv[bj][n][j] = gp[32 * bj + 16 * n + 4 * fq + j] * sc;
#pragma unroll
            for (int j = 0; j < 4; ++j) invf[j] = __builtin_amdgcn_exp2f(-(float)(4 * fq + j) * (13.287712379549449f / 16.f));
#pragma unroll
            for (int ai = 0; ai < 2; ++ai)
#pragma unroll
                for (int m = 0; m < 4; ++m) { const int row = u.pm * BM + ai * HALF + wr * 64 + m * 16 + fr; const int t = row & 4095;
                    float ss = 0.f;
#pragma unroll
                    for (int bj = 0; bj < 2; ++bj)
#pragma unroll
                        for (int n = 0; n < 2; ++n) { const f32x4 x = acc[ai][bj][m][n]; ss += (x[0] * x[0] + x[1] * x[1]) + (x[2] * x[2] + x[3] * x[3]); }
                    ss += __shfl_xor(ss, 16); ss += __shfl_xor(ss, 32);
                    const float rinv = __builtin_amdgcn_rsqf(ss * (1.f / 64.f) + 1e-6f);
                    bf16_t* rowp = C2 + (size_t)row * LD_C2 + colbase + 4 * fq;
#pragma unroll
                    for (int bj = 0; bj < 2; ++bj) { const float pos = (float)(bj ? (t & 63) : (t >> 6)); float o1[4], o2[4];
#pragma unroll
                        for (int j = 0; j < 4; ++j) { const float ang = pos * invf[j], c = __cosf(ang), s = __sinf(ang);
                            const float x1 = acc[ai][bj][m][0][j] * rinv * gv[bj][0][j], x2 = acc[ai][bj][m][1][j] * rinv * gv[bj][1][j];
                            o1[j] = x1 * c - x2 * s; o2[j] = x2 * c + x1 * s; }
                        u32x2 w1, w2; w1.x = cvt_pk_bf16(o1[0], o1[1]); w1.y = cvt_pk_bf16(o1[2], o1[3]); w2.x = cvt_pk_bf16(o2[0], o2[1]); w2.y = cvt_pk_bf16(o2[2], o2[3]);
                        *(u32x2*)(rowp + 32 * bj) = w1; *(u32x2*)(rowp + 32 * bj + 16) = w2; }
                    EPI_FENCE(); }
        }
    }
};
}

struct Params { const float* in[24]; float* out; unsigned char* ws; };

__device__ __forceinline__ void transpose_item(const float* W, int ldw, int k0, int n_src, bf16_t* WT, int ldt, int dst_row0, LAS float* scr, int lane) {
#pragma unroll 8
    for (int i = 0; i < 32; ++i) { const int kk = 2 * i + (lane >> 5); scr[kk * 33 + (lane & 31)] = W[(size_t)(k0 + kk) * ldw + n_src + (lane & 31)]; }
    asm volatile("s_waitcnt lgkmcnt(0)" ::: "memory");
    const int c = lane & 7;
#pragma unroll
    for (int j = 0; j < 4; ++j) { const int n = (lane >> 3) + 8 * j; const LAS float* s = scr + (8 * c) * 33 + n;
        u32x4 o; o.x = cvt_pk_bf16(s[0 * 33], s[1 * 33]); o.y = cvt_pk_bf16(s[2 * 33], s[3 * 33]); o.z = cvt_pk_bf16(s[4 * 33], s[5 * 33]); o.w = cvt_pk_bf16(s[6 * 33], s[7 * 33]);
        *(u32x4*)(WT + (size_t)(dst_row0 + n) * ldt + k0 + 8 * c) = o; }
    asm volatile("s_waitcnt lgkmcnt(0)" ::: "memory");
}
__device__ __forceinline__ void rms_row2(const float* xrow0, const float* xrow1, const float* g, bf16_t* orow0, bf16_t* orow1, int lane) {
    const f32x4* xr0 = (const f32x4*)xrow0 + lane; const f32x4* xr1 = (const f32x4*)xrow1 + lane; const f32x4* gr = (const f32x4*)g + lane;
    f32x4 v0[4], v1[4]; float s0 = 0.f, s1 = 0.f;
#pragma unroll
    for (int j = 0; j < 4; ++j) { v0[j] = xr0[64 * j]; v1[j] = xr1[64 * j]; }
#pragma unroll
    for (int j = 0; j < 4; ++j) { s0 += (v0[j].x * v0[j].x + v0[j].y * v0[j].y) + (v0[j].z * v0[j].z + v0[j].w * v0[j].w); s1 += (v1[j].x * v1[j].x + v1[j].y * v1[j].y) + (v1[j].z * v1[j].z + v1[j].w * v1[j].w); }
    const float inv0 = __builtin_amdgcn_rsqf(wave_sum(s0) * (1.f / D_MODEL) + 1e-6f), inv1 = __builtin_amdgcn_rsqf(wave_sum(s1) * (1.f / D_MODEL) + 1e-6f);
    u32x2* o0 = (u32x2*)orow0 + lane; u32x2* o1 = (u32x2*)orow1 + lane;
#pragma unroll
    for (int j = 0; j < 4; ++j) { const f32x4 gg = gr[64 * j]; u32x2 w;
        w.x = cvt_pk_bf16(v0[j].x * inv0 * gg.x, v0[j].y * inv0 * gg.y); w.y = cvt_pk_bf16(v0[j].z * inv0 * gg.z, v0[j].w * inv0 * gg.w); o0[64 * j] = w;
        w.x = cvt_pk_bf16(v1[j].x * inv1 * gg.x, v1[j].y * inv1 * gg.y); w.y = cvt_pk_bf16(v1[j].z * inv1 * gg.z, v1[j].w * inv1 * gg.w); o1[64 * j] = w; }
}
__device__ __forceinline__ void rms_row(const float* xrow, const float* g, bf16_t* orow, int lane) {
    const f32x4* xr = (const f32x4*)xrow + lane; const f32x4* gr = (const f32x4*)g + lane;
    f32x4 v[4]; float s = 0.f;
#pragma unroll
    for (int j = 0; j < 4; ++j) { v[j] = xr[64 * j]; s += (v[j].x * v[j].x + v[j].y * v[j].y) + (v[j].z * v[j].z + v[j].w * v[j].w); }
    const float inv = __builtin_amdgcn_rsqf(wave_sum(s) * (1.f / D_MODEL) + 1e-6f);
    u32x2* o8 = (u32x2*)orow + lane;
#pragma unroll
    for (int j = 0; j < 4; ++j) { const f32x4 gg = gr[64 * j]; u32x2 w; w.x = cvt_pk_bf16(v[j].x * inv * gg.x, v[j].y * inv * gg.y); w.y = cvt_pk_bf16(v[j].z * inv * gg.z, v[j].w * inv * gg.w); o8[64 * j] = w; }
}

constexpr int AT_KSTR = 72, AT_VSTR = 68;
constexpr int AT_KBYTES = 64 * AT_KSTR * 2, AT_VBYTES = 64 * AT_VSTR * 2;
__device__ __forceinline__ void vt_write(LAS unsigned char* p, const u32x4 v) {
    *(LAS unsigned short*)(p + 0 * (AT_VSTR * 2)) = (unsigned short)(v.x & 0xffffu); *(LAS unsigned short*)(p + 1 * (AT_VSTR * 2)) = (unsigned short)(v.x >> 16);
    *(LAS unsigned short*)(p + 2 * (AT_VSTR * 2)) = (unsigned short)(v.y & 0xffffu); *(LAS unsigned short*)(p + 3 * (AT_VSTR * 2)) = (unsigned short)(v.y >> 16);
    *(LAS unsigned short*)(p + 4 * (AT_VSTR * 2)) = (unsigned short)(v.z & 0xffffu); *(LAS unsigned short*)(p + 5 * (AT_VSTR * 2)) = (unsigned short)(v.z >> 16);
    *(LAS unsigned short*)(p + 6 * (AT_VSTR * 2)) = (unsigned short)(v.w & 0xffffu); *(LAS unsigned short*)(p + 7 * (AT_VSTR * 2)) = (unsigned short)(v.w >> 16);
}
__device__ __forceinline__ void attn_tile(LAS unsigned char* lds, int cur, int r32, int hi, const bf16x8 (&qf)[4], float& mref, float& lrun, f32x16& o0, f32x16& o1) {
        const LAS unsigned char* kb = lds + cur * AT_KBYTES + r32 * (AT_KSTR * 2) + hi * 16;
        f32x16 p0, p1;
        { const float nm = -mref;
#pragma unroll
          for (int r = 0; r < 16; ++r) { p0[r] = nm; p1[r] = nm; } }
#pragma unroll
        for (int d0 = 0; d0 < 4; ++d0) {
            const bf16x8 a0 = *(const LAS bf16x8*)(kb + d0 * 32), a1 = *(const LAS bf16x8*)(kb + 32 * (AT_KSTR * 2) + d0 * 32);
            p0 = __builtin_amdgcn_mfma_f32_32x32x16_bf16(a0, qf[d0], p0, 0, 0, 0);
            p1 = __builtin_amdgcn_mfma_f32_32x32x16_bf16(a1, qf[d0], p1, 0, 0, 0);
        }
        float mx = __builtin_fmaxf(__builtin_fmaxf(p0[0], p1[0]), p0[1]);
        mx = __builtin_fmaxf(__builtin_fmaxf(mx, p1[1]), p0[2]);
#pragma unroll
        for (int r = 2; r < 14; r += 2) { mx = __builtin_fmaxf(__builtin_fmaxf(mx, p1[r]), p0[r + 1]); mx = __builtin_fmaxf(__builtin_fmaxf(mx, p1[r + 1]), p0[r + 2]); }
        mx = __builtin_fmaxf(__builtin_fmaxf(mx, p1[14]), p0[15]); mx = __builtin_fmaxf(mx, p1[15]);
        mx = __builtin_fmaxf(mx, __shfl_xor(mx, 32));
        if (__builtin_expect(__any(mx > 8.0f), 0)) {
            const float dl = __builtin_fmaxf(mx, 0.f), f = __builtin_amdgcn_exp2f(-dl);
            mref += dl; lrun *= f;
#pragma unroll
            for (int r = 0; r < 16; ++r) { p0[r] -= dl; p1[r] -= dl; o0[r] *= f; o1[r] *= f; }
        }
        f32x2 ls2 = {0.f, 0.f};
#pragma unroll
        for (int r = 0; r < 16; r += 2) {
            p0[r] = __builtin_amdgcn_exp2f(p0[r]); p0[r + 1] = __builtin_amdgcn_exp2f(p0[r + 1]); p1[r] = __builtin_amdgcn_exp2f(p1[r]); p1[r + 1] = __builtin_amdgcn_exp2f(p1[r + 1]);
            ls2 += (f32x2){p0[r], p0[r + 1]}; ls2 += (f32x2){p1[r], p1[r + 1]};
        }
        lrun += ls2.x + ls2.y;
        bf16x8 pf[4];
        { u32x4 w;
          w.x = cvt_pk_bf16(p0[0], p0[1]); w.y = cvt_pk_bf16(p0[2], p0[3]); w.z = cvt_pk_bf16(p0[4], p0[5]); w.w = cvt_pk_bf16(p0[6], p0[7]); pf[0] = __builtin_bit_cast(bf16x8, w);
          w.x = cvt_pk_bf16(p0[8], p0[9]); w.y = cvt_pk_bf16(p0[10], p0[11]); w.z = cvt_pk_bf16(p0[12], p0[13]); w.w = cvt_pk_bf16(p0[14], p0[15]); pf[1] = __builtin_bit_cast(bf16x8, w);
          w.x = cvt_pk_bf16(p1[0], p1[1]); w.y = cvt_pk_bf16(p1[2], p1[3]); w.z = cvt_pk_bf16(p1[4], p1[5]); w.w = cvt_pk_bf16(p1[6], p1[7]); pf[2] = __builtin_bit_cast(bf16x8, w);
          w.x = cvt_pk_bf16(p1[8], p1[9]); w.y = cvt_pk_bf16(p1[10], p1[11]); w.z = cvt_pk_bf16(p1[12], p1[13]); w.w = cvt_pk_bf16(p1[14], p1[15]); pf[3] = __builtin_bit_cast(bf16x8, w); }
        const LAS unsigned char* vb = lds + 2 * AT_KBYTES + cur * AT_VBYTES + r32 * (AT_VSTR * 2) + hi * 8;
#pragma unroll
        for (int s = 0; s < 4; ++s) {
            const int koff = ((s >> 1) * 32 + (s & 1) * 16) * 2;
            const u32x2 l0 = *(const LAS u32x2*)(vb + koff), h0 = *(const LAS u32x2*)(vb + koff + 16);
            const u32x2 l1 = *(const LAS u32x2*)(vb + 32 * (AT_VSTR * 2) + koff), h1 = *(const LAS u32x2*)(vb + 32 * (AT_VSTR * 2) + koff + 16);
            const bf16x8 a0 = __builtin_bit_cast(bf16x8, (u32x4){l0.x, l0.y, h0.x, h0.y}), a1 = __builtin_bit_cast(bf16x8, (u32x4){l1.x, l1.y, h1.x, h1.y});
            o0 = __builtin_amdgcn_mfma_f32_32x32x16_bf16(a0, pf[s], o0, 0, 0, 0);
            o1 = __builtin_amdgcn_mfma_f32_32x32x16_bf16(a1, pf[s], o1, 0, 0, 0);
        }
}
__device__ __forceinline__ void attn_unit(LAS unsigned char* lds, bf16_t* C2, bf16_t* Odummy, int b, int kvh, int qb) {
    int tid = threadIdx.x; asm volatile("" : "+v"(tid));
    const int lane = tid & 63, r32 = lane & 31, hi = lane >> 5, wid = __builtin_amdgcn_readfirstlane(tid >> 6);
    const int g = wid & 3, th = wid >> 2, head = kvh * 4 + g;
    const size_t rowbase = (size_t)b * SEQ;
    const int tok0 = qb * 128 + th * 64;
    bf16_t* qrowA = C2 + (rowbase + tok0 + r32) * LD_C2 + 1536 + head * 64;
    bf16_t* qrowB = qrowA + (size_t)32 * LD_C2;
    bf16x8 qfA[4], qfB[4];
#pragma unroll
    for (int d0 = 0; d0 < 4; ++d0) { qfA[d0] = *(const bf16x8*)(qrowA + d0 * 16 + hi * 8); qfB[d0] = *(const bf16x8*)(qrowB + d0 * 16 + hi * 8); }
    const int srow = tid >> 3, sch = tid & 7;
    const bf16_t* ksrc = C2 + (rowbase + srow) * LD_C2 + 2048 + kvh * 64 + sch * 8;
    const bf16_t* vsrc = C2 + (rowbase + (tid & 63)) * LD_C2 + 2176 + kvh * 64 + (tid >> 6) * 8;
    LAS unsigned char* kdst = lds + srow * (AT_KSTR * 2) + sch * 16;
    LAS unsigned char* vdst = lds + 2 * AT_KBYTES + (8 * (tid >> 6)) * (AT_VSTR * 2) + (tid & 63) * 2;
    u32x4 kregA = *(const u32x4*)ksrc, vregA = *(const u32x4*)vsrc, kregB, vregB;
    *(LAS u32x4*)kdst = kregA; vt_write(vdst, vregA);
    kregA = *(const u32x4*)(ksrc + (size_t)64 * LD_C2); vregA = *(const u32x4*)(vsrc + (size_t)64 * LD_C2);
    __syncthreads();
    f32x16 oA0 = {}, oA1 = {}, oB0 = {}, oB1 = {};
    float mrefA = 0.f, lrunA = 0.f, mrefB = 0.f, lrunB = 0.f;
#define AT_STEP(kt, cur, KW, VW, KL, VL) { \
        if ((kt) + 2 < SEQ / 64) { KL = *(const u32x4*)(ksrc + (size_t)((kt) + 2) * 64 * LD_C2); VL = *(const u32x4*)(vsrc + (size_t)((kt) + 2) * 64 * LD_C2); } \
        attn_tile(lds, cur, r32, hi, qfA, mrefA, lrunA, oA0, oA1); \
        __builtin_amdgcn_sched_barrier(0); \
        attn_tile(lds, cur, r32, hi, qfB, mrefB, lrunB, oB0, oB1); \
        __builtin_amdgcn_sched_barrier(0); \
        if ((kt) + 1 < SEQ / 64) { *(LAS u32x4*)(kdst + ((cur) ^ 1) * AT_KBYTES) = KW; vt_write(vdst + ((cur) ^ 1) * AT_VBYTES, VW); } \
        __syncthreads(); }
    for (int kt = 0; kt < SEQ / 64; kt += 2) {
        AT_STEP(kt, 0, kregA, vregA, kregB, vregB);
        AT_STEP(kt + 1, 1, kregB, vregB, kregA, vregA);
    }
#undef AT_STEP
#pragma unroll
    for (int blk = 0; blk < 2; ++blk) {
        float lr = blk ? lrunB : lrunA; lr += __shfl_xor(lr, 32);
        const float rl = __builtin_amdgcn_rcpf(lr);
        const f32x16& o0 = blk ? oB0 : oA0; const f32x16& o1 = blk ? oB1 : oA1;
        bf16_t* qrow = blk ? qrowB : qrowA;
        bf16_t* orow = Odummy ? Odummy + (rowbase + tok0 + 32 * blk + r32) * 512 + head * 64 : qrow;
#pragma unroll
        for (int g4 = 0; g4 < 4; ++g4) {
            u32x2 w0, w1;
            w0.x = cvt_pk_bf16(o0[4 * g4] * rl, o0[4 * g4 + 1] * rl); w0.y = cvt_pk_bf16(o0[4 * g4 + 2] * rl, o0[4 * g4 + 3] * rl);
            w1.x = cvt_pk_bf16(o1[4 * g4] * rl, o1[4 * g4 + 1] * rl); w1.y = cvt_pk_bf16(o1[4 * g4 + 2] * rl, o1[4 * g4 + 3] * rl);
            *(u32x2*)(orow + 8 * g4 + 4 * hi) = w0; *(u32x2*)(orow + 32 + 8 * g4 + 4 * hi) = w1;
        }
    }
}

__device__ __forceinline__ void conv_item(bf16_t* C2, const float* cvw, const float* cvb, int idx) {
    const int m = idx >> 6, c0 = (idx & 63) * 8, t = m & 4095;
    bf16_t* rp = C2 + (size_t)m * LD_C2 + c0;
    const bf16_t* rpp = (t > 0) ? rp - LD_C2 : rp; const bf16_t* rpn = (t < SEQ - 1) ? rp + LD_C2 : rp;
    const float fp = (t > 0) ? 1.f : 0.f, fn = (t < SEQ - 1) ? 1.f : 0.f;
    float bg[8], c[8], x[8], a[8], bq[8], a2[8], b2[8], o[8];
    unpack8(*(const u32x4*)rp, bg); unpack8(*(const u32x4*)(rp + 512), c); unpack8(*(const u32x4*)(rp + 1024), x);
    unpack8(*(const u32x4*)(rpp + 512), a); unpack8(*(const u32x4*)(rpp + 1024), bq); unpack8(*(const u32x4*)(rpn + 512), a2); unpack8(*(const u32x4*)(rpn + 1024), b2);
#pragma unroll
    for (int j = 0; j < 8; ++j) o[j] = bg[j] * (cvb[c0 + j] + cvw[c0 + j] * (a[j] * bq[j] * fp) + cvw[512 + c0 + j] * (c[j] * x[j]) + cvw[1024 + c0 + j] * (a2[j] * b2[j] * fn));
    *(u32x4*)rp = pack8(o);
}
constexpr int SC_CH = 32;
constexpr int SC_ARR = SC_CH * 64;
constexpr int SC_R = 0, SC_W = 1, SC_KD = 2, SC_V = 3, SC_KK = 4, SC_KKA = 5, SC_ZK = 6, SC_NARR = 7;
constexpr int SC_SLOT = SC_NARR * SC_ARR;
constexpr int SC_TAB = 2 * SC_SLOT;
struct ScanW { const float *mu_prev, *mu_next, *w0, *a0, *k_k, *k_a, *r_k; const bf16_t *w2t, *a2t; };

__device__ __forceinline__ void scan_produce(LAS float* sl, LAS float* tab, const bf16_t* RWC, bf16_t* SG, float* SB, const ScanW& sw, const float* mu_gd_p, const float* mu_gd_n,
                                             int b, int h, int dir, int chunk, int sub, int lane) {
    asm volatile("" : "+v"(lane));
    const int tok = lane & 15, q = lane >> 4;
    const int tokidx = 16 * sub + tok;
    const int sc = chunk * SC_CH + tokidx;
    const int t = dir ? (SEQ - 1 - sc) : sc;
    const bf16_t* rp = RWC + ((size_t)b * SEQ + t) * LD_RWC;
    const bool hasp = t > 0, hasn = t < SEQ - 1;
    const bf16_t* rpp = hasp ? rp - LD_RWC : rp;
    const bf16_t* rpn = hasn ? rp + LD_RWC : rp;
    const float fp = hasp ? 1.f : 0.f, fn = hasn ? 1.f : 0.f;
    u32x4 Lc[6], Lp[6], Ln[6];
#pragma unroll
    for (int G = 0; G < 3; ++G)
#pragma unroll
        for (int hf = 0; hf < 2; ++hf) { const int cb = G * 512 + h * 64 + 16 * q + 8 * hf;
            Lc[2 * G + hf] = *(const u32x4*)(rp + cb); Lp[2 * G + hf] = *(const u32x4*)(rpp + cb); Ln[2 * G + hf] = *(const u32x4*)(rpn + cb); }
    u32x4 Mc[5], Mp[5], Mn[5];
#pragma unroll
    for (int i = 0; i < 5; ++i) { const int cb = (i < 4) ? (1536 + (i >> 1) * 128 + dir * 64 + 32 * (i & 1) + 8 * q) : (1792 + 8 * (2 * h + dir));
        Mc[i] = *(const u32x4*)(rp + cb); Mp[i] = *(const u32x4*)(rpp + cb); Mn[i] = *(const u32x4*)(rpn + cb); }
    float zk[16];
#pragma unroll
    for (int G = 0; G < 3; ++G) {
        float z[16];
#pragma unroll
        for (int hf = 0; hf < 2; ++hf) {
            float c[8], p[8], n[8];
            unpack8(Lc[2 * G + hf], c); unpack8(Lp[2 * G + hf], p); unpack8(Ln[2 * G + hf], n);
            const LAS float* mp = tab + G * 64 + 16 * q + 8 * hf; const LAS float* mn = mp + 320;
#pragma unroll
            for (int j = 0; j < 8; ++j) z[8 * hf + j] = c[j] + mp[j] * (p[j] * fp - c[j]) + mn[j] * (n[j] * fn - c[j]);
        }
        LAS float* dst = sl + (G == 0 ? SC_R : (G == 1 ? SC_ZK : SC_V)) * SC_ARR + tokidx * 64 + 16 * q;
#pragma unroll
        for (int j4 = 0; j4 < 4; ++j4) *(LAS f32x4*)(dst + 4 * j4) = (f32x4){z[4 * j4], z[4 * j4 + 1], z[4 * j4 + 2], z[4 * j4 + 3]};
        if (G == 1) {
#pragma unroll
            for (int j = 0; j < 16; ++j) zk[j] = z[j];
        }
    }
    {
        const LAS float* kkt = tab + 640 + 16 * q;
        float kr[16], ss = 0.f;
#pragma unroll
        for (int j = 0; j < 16; ++j) { kr[j] = zk[j] * kkt[j]; ss += kr[j] * kr[j]; }
        ss += __shfl_xor(ss, 16); ss += __shfl_xor(ss, 32);
        const float inv = 1.f / fmaxf(sqrtf(ss), 1e-12f);
        LAS float* dst = sl + SC_KK * SC_ARR + tokidx * 64 + 16 * q;
#pragma unroll
        for (int j4 = 0; j4 < 4; ++j4) *(LAS f32x4*)(dst + 4 * j4) = (f32x4){kr[4 * j4] * inv, kr[4 * j4 + 1] * inv, kr[4 * j4 + 2] * inv, kr[4 * j4 + 3] * inv};
    }
    bf16x8 Awd[2], Aad[2];
#pragma unroll
    for (int i = 0; i < 4; ++i) {
        const int G = 3 + (i >> 1), ks = i & 1;
        float c[8], p[8], n[8], z[8];
        unpack8(Mc[i], c); unpack8(Mp[i], p); unpack8(Mn[i], n);
        const LAS float* mp = tab + G * 64 + 32 * ks + 8 * q; const LAS float* mn = mp + 320;
#pragma unroll
        for (int j = 0; j < 8; ++j) { z[j] = c[j] + mp[j] * (p[j] * fp - c[j]) + mn[j] * (n[j] * fn - c[j]); if (G == 3) z[j] = tanh_f(z[j]); }
        const bf16x8 fr8 = __builtin_bit_cast(bf16x8, pack8(z));
        if (G == 3) Awd[ks] = fr8; else Aad[ks] = fr8;
    }
    if (q == 0) {
        const int cg8 = 8 * (2 * h + dir);
        float c[8], p[8], n[8], z[8];
        unpack8(Mc[4], c); unpack8(Mp[4], p); unpack8(Mn[4], n);
#pragma unroll
        for (int j = 0; j < 8; ++j) z[j] = sigmoid_f(c[j] + mu_gd_p[cg8 + j] * (p[j] * fp - c[j]) + mu_gd_n[cg8 + j] * (n[j] * fn - c[j]));
        *(u32x4*)(SG + ((size_t)b * SEQ + t) * 256 + cg8) = pack8(z);
    }
    asm volatile("s_waitcnt lgkmcnt(0)" ::: "memory");
    f32x4 aw[4], aa[4];
    float w0r[4], a0r[4], kar[4], rkr[4];
#pragma unroll
    for (int nb = 0; nb < 4; ++nb) {
        const int c = h * 64 + 16 * nb + (lane & 15);
        const bf16_t* wp = sw.w2t + ((size_t)(dir * 512 + c)) * 64 + 8 * (lane >> 4); const bf16_t* ap = sw.a2t + ((size_t)(dir * 512 + c)) * 64 + 8 * (lane >> 4);
        const bf16x8 bw0 = *(const bf16x8*)wp, bw1 = *(const bf16x8*)(wp + 32), ba0 = *(const bf16x8*)ap, ba1 = *(const bf16x8*)(ap + 32);
        w0r[nb] = sw.w0[dir * 512 + c]; a0r[nb] = sw.a0[dir * 512 + c]; kar[nb] = sw.k_a[c]; rkr[nb] = sw.r_k[c];
        aw[nb] = __builtin_amdgcn_mfma_f32_16x16x32_bf16(Awd[0], bw0, (f32x4){0.f, 0.f, 0.f, 0.f}, 0, 0, 0);
        aw[nb] = __builtin_amdgcn_mfma_f32_16x16x32_bf16(Awd[1], bw1, aw[nb], 0, 0, 0);
        aa[nb] = __builtin_amdgcn_mfma_f32_16x16x32_bf16(Aad[0], ba0, (f32x4){0.f, 0.f, 0.f, 0.f}, 0, 0, 0);
        aa[nb] = __builtin_amdgcn_mfma_f32_16x16x32_bf16(Aad[1], ba1, aa[nb], 0, 0, 0);
    }
    float bon[4] = {0.f, 0.f, 0.f, 0.f};
#pragma unroll
    for (int nb = 0; nb < 4; ++nb)
#pragma unroll
        for (int rg = 0; rg < 4; ++rg) {
            const int ti = 16 * sub + 4 * q + rg, c = 16 * nb + (lane & 15), o = ti * 64 + c;
            const float dec = trans_settle(__builtin_amdgcn_exp2f(-0.6065306597126334f * LOG2E * sigmoid_f(aw[nb][rg] + w0r[nb])));
            const float a = sigmoid_f(aa[nb][rg] + a0r[nb]);
            const float zkv = sl[SC_ZK * SC_ARR + o], kkv = sl[SC_KK * SC_ARR + o], rv = sl[SC_R * SC_ARR + o];
            const float kd = zkv * (1.f + (a - 1.f) * kar[nb]);
            sl[SC_W * SC_ARR + o] = dec; sl[SC_KD * SC_ARR + o] = kd; sl[SC_KKA * SC_ARR + o] = kkv * a;
            bon[rg] += rv * kd * rkr[nb];
        }
#pragma unroll
    for (int rg = 0; rg < 4; ++rg) {
        const float s = red16(bon[rg]);
        if ((lane & 15) == 0) { const int sc2 = chunk * SC_CH + 16 * sub + 4 * q + rg; const int t2 = dir ? (SEQ - 1 - sc2) : sc2;
            SB[((size_t)dir * T + (size_t)b * SEQ + t2) * 8 + h] = s; }
    }
}

__device__ __forceinline__ void scan_unit(LAS unsigned char* lds, const bf16_t* RWC, bf16_t* YF, bf16_t* YB, bf16_t* SG, float* SB, const ScanW& sw, int b, int h, int dir,
                                          bf16_t* C2cv, const float* cvw, const float* cvb, int unit) {
    int tid = threadIdx.x; asm volatile("" : "+v"(tid));
    const int lane = tid & 63, wid = __builtin_amdgcn_readfirstlane(tid >> 6);
    LAS float* fl = (LAS float*)lds;
    LAS float* tab = fl + SC_TAB;
    for (int i = tid; i < 704; i += 512) {
        float v;
        if (i < 640) { const int pn = i / 320, r = i % 320, G = r / 64, ch = r % 64;
            const int col = (G < 3) ? (G * 512 + h * 64 + ch) : (1536 + (G - 3) * 128 + dir * 64 + ch);
            v = (pn ? sw.mu_next : sw.mu_prev)[col]; }
        else v = sw.k_k[h * 64 + (i - 640)];
        tab[i] = v;
    }
    __syncthreads();
    if (wid >= 4 && wid < 6) scan_produce(fl, tab, RWC, SG, SB, sw, sw.mu_prev + 1792, sw.mu_next + 1792, b, h, dir, 0, wid - 4, lane);
    __syncthreads();
    const int vp = tid >> 3, kq = tid & 7;
    f32x2 S0[4], S1[4];
#pragma unroll
    for (int i = 0; i < 4; ++i) { S0[i] = (f32x2){0.f, 0.f}; S1[i] = (f32x2){0.f, 0.f}; }
    bf16_t* Y = dir ? YB : YF;
    for (int ch = 0; ch < SEQ / SC_CH; ++ch) {
        LAS float* sl = fl + (ch & 1) * SC_SLOT;
        if (wid < 4) {
            const LAS float* base = sl + 8 * kq;
            const LAS float* vbase = sl + SC_V * SC_ARR + 2 * vp;
            f32x4 nkk0, nkk1, nw0, nw1, nka0, nka1, nkd0, nkd1, nr0, nr1; f32x2 nvv;
#define SC_LOAD(s_) do { const LAS float* p_ = base + (s_) * 64; \
                nkk0 = *(const LAS f32x4*)(p_ + SC_KK * SC_ARR); nkk1 = *(const LAS f32x4*)(p_ + SC_KK * SC_ARR + 4); \
                nw0 = *(const LAS f32x4*)(p_ + SC_W * SC_ARR); nw1 = *(const LAS f32x4*)(p_ + SC_W * SC_ARR + 4); \
                nka0 = *(const LAS f32x4*)(p_ + SC_KKA * SC_ARR); nka1 = *(const LAS f32x4*)(p_ + SC_KKA * SC_ARR + 4); \
                nkd0 = *(const LAS f32x4*)(p_ + SC_KD * SC_ARR); nkd1 = *(const LAS f32x4*)(p_ + SC_KD * SC_ARR + 4); \
                nr0 = *(const LAS f32x4*)(p_ + SC_R * SC_ARR); nr1 = *(const LAS f32x4*)(p_ + SC_R * SC_ARR + 4); \
                nvv = *(const LAS f32x2*)(vbase + (s_) * 64); } while (0)
            SC_LOAD(0);
#pragma unroll 1
            for (int s = 0; s < SC_CH; ++s) {
                f32x2 kk[4], w[4], ka[4], kd[4], r[4];
                kk[0] = nkk0.xy; kk[1] = nkk0.zw; kk[2] = nkk1.xy; kk[3] = nkk1.zw;
                w[0] = nw0.xy; w[1] = nw0.zw; w[2] = nw1.xy; w[3] = nw1.zw;
                ka[0] = nka0.xy; ka[1] = nka0.zw; ka[2] = nka1.xy; ka[3] = nka1.zw;
                kd[0] = nkd0.xy; kd[1] = nkd0.zw; kd[2] = nkd1.xy; kd[3] = nkd1.zw;
                r[0] = nr0.xy; r[1] = nr0.zw; r[2] = nr1.xy; r[3] = nr1.zw;
                const f32x2 vv = nvv;
                SC_LOAD((s + 1) & (SC_CH - 1));
                f32x2 t0 = S0[0] * kk[0], t1 = S1[0] * kk[0];
#pragma unroll
                for (int i = 1; i < 4; ++i) { t0 = S0[i] * kk[i] + t0; t1 = S1[i] * kk[i] + t1; }
                const float sa0 = red8(t0.x + t0.y), sa1 = red8(t1.x + t1.y);
                const f32x2 n0 = (f32x2){-sa0, -sa0}, n1 = (f32x2){-sa1, -sa1}, v0 = (f32x2){vv.x, vv.x}, v1 = (f32x2){vv.y, vv.y};
                f32x2 y0 = (f32x2){0.f, 0.f}, y1 = (f32x2){0.f, 0.f};
#pragma unroll
                for (int i = 0; i < 4; ++i) {
                    S0[i] = S0[i] * w[i] + (v0 * kd[i] + n0 * ka[i]);
                    S1[i] = S1[i] * w[i] + (v1 * kd[i] + n1 * ka[i]);
                    y0 = S0[i] * r[i] + y0; y1 = S1[i] * r[i] + y1;
                }
                const float ys0 = red8(y0.x + y0.y), ys1 = red8(y1.x + y1.y);
                if (kq == 0) { const int sc = ch * SC_CH + s; const int t = dir ? (SEQ - 1 - sc) : sc;
                    *(unsigned*)(Y + ((size_t)b * SEQ + t) * 512 + h * 64 + 2 * vp) = cvt_pk_bf16(ys0, ys1); }
            }
#undef SC_LOAD
        } else if (wid < 6) {
            if (ch + 1 < SEQ / SC_CH) scan_produce(fl + ((ch + 1) & 1) * SC_SLOT, tab, RWC, SG, SB, sw, sw.mu_prev + 1792, sw.mu_next + 1792, b, h, dir, ch + 1, wid - 4, lane);
        } else {
            conv_item(C2cv, cvw, cvb, unit * 16384 + ch * 128 + (tid - 384));
        }
        __syncthreads();
    }
}


#define XB_TMO      128
#define XB_XCNT(j)  (256  + 64 * (j))
#define XB_XSUB(j)  (1280 + 64 * (j))
#define XB_XGEN(j)  (2304 + 64 * (j))
#define XB_TOP      3328
#define XB_TOPGEN   3392
#define XB_SPIN_CAP (1u << 22)
__device__ __forceinline__ unsigned xb_ld(unsigned* p)              { return __hip_atomic_load(p, __ATOMIC_RELAXED, __HIP_MEMORY_SCOPE_AGENT); }
__device__ __forceinline__ unsigned xb_add(unsigned* p, unsigned v) { return __hip_atomic_fetch_add(p, v, __ATOMIC_RELAXED, __HIP_MEMORY_SCOPE_AGENT); }
__device__ __forceinline__ unsigned xb_xcc_id() { return (unsigned)__builtin_amdgcn_s_getreg((3 << 11) | 20) & 0xFu; }
#define XB_SPIN(cond, bar) do { unsigned _sp = 0; while (cond) { __builtin_amdgcn_s_sleep(1); \
    if ((++_sp & 255u) == 0u) { if (xb_ld(&(bar)[XB_TMO])) break; if (_sp > XB_SPIN_CAP) { atomicAdd(&(bar)[XB_TMO], 1u); break; } } } } while (0)
struct XcdBarrier { unsigned* bar; unsigned x; volatile LAS unsigned* st; };
__device__ __forceinline__ XcdBarrier xcd_barrier_post(unsigned* bar, volatile LAS unsigned* st) {
    XcdBarrier b; b.bar = bar; b.x = xb_xcc_id(); b.st = st;
    if (threadIdx.x == 0) (void)xb_add(&bar[XB_XCNT(b.x)], 1u);
    return b;
}
__device__ __forceinline__ void xcd_barrier_complete(unsigned* bar, unsigned x, unsigned& nloc, unsigned& nx) {
    const unsigned G = gridDim.x * gridDim.y * gridDim.z;
    unsigned sum, cnt, mine, sp = 0u;
    for (;;) {
        sum = 0u; cnt = 0u; mine = 0u;
#pragma unroll
        for (unsigned j = 0; j < 16; ++j) { const unsigned c = xb_ld(&bar[XB_XCNT(j)]); sum += c; cnt += (c > 0u) ? 1u : 0u; mine = (j == x) ? c : mine; }
        if (sum == G) break;
        __builtin_amdgcn_s_sleep(1);
        if ((++sp & 255u) == 0u) { if (xb_ld(&bar[XB_TMO])) break; if (sp > XB_SPIN_CAP) { atomicAdd(&bar[XB_TMO], 1u); break; } }
    }
    nloc = mine > 0u ? mine : 1u; nx = cnt > 0u ? cnt : 1u;
}
__device__ __forceinline__ void xcd_barrier(const XcdBarrier& b) {
    asm volatile("s_waitcnt vmcnt(0)" ::: "memory");
    __syncthreads();
    if (threadIdx.x == 0) {
        unsigned* bar = b.bar;
        __builtin_amdgcn_s_waitcnt(0);
        unsigned nloc = b.st[0], nx = b.st[1];
        if (nloc == 0u) { xcd_barrier_complete(bar, b.x, nloc, nx); b.st[0] = nloc; b.st[1] = nx; }
        const unsigned old = xb_add(&bar[XB_XSUB(b.x)], 1u);
        const unsigned gen = old / nloc;
        if (old + 1u == (gen + 1u) * nloc) {
            __builtin_amdgcn_fence(__ATOMIC_RELEASE, "agent");
            asm volatile("s_waitcnt vmcnt(0)" ::: "memory");
            const unsigned og = xb_add(&bar[XB_TOP], 1u);
            const unsigned tg = og / nx;
            if (og + 1u == (tg + 1u) * nx) xb_add(&bar[XB_TOPGEN], 1u);
            else XB_SPIN(xb_ld(&bar[XB_TOPGEN]) == tg, bar);
            __builtin_amdgcn_fence(__ATOMIC_ACQUIRE, "agent");
            xb_add(&bar[XB_XGEN(b.x)], 1u);
            asm volatile("s_waitcnt vmcnt(0)" ::: "memory");
        } else {
            XB_SPIN(xb_ld(&bar[XB_XGEN(b.x)]) == gen, bar);
            __builtin_amdgcn_fence(__ATOMIC_ACQUIRE, "agent");
            asm volatile("s_waitcnt vmcnt(0)" ::: "memory");
        }
    }
    __syncthreads();
}

#ifdef MK_DBG_STOP
#define DBG_STOP(k) do { if ((k) == MK_DBG_STOP && l == 0) { dbg_dump(p, ws0, bx * 512 + (int)threadIdx.x, G * 512); return; } } while (0)
__device__ __noinline__ void dbg_dump(const Params& p, unsigned char* ws, int gtid, int NGT) {
    const bf16_t* rwc = (const bf16_t*)(ws + WS_RWC); const bf16_t* c2 = (const bf16_t*)(ws + WS_C2); const bf16_t* yf = (const bf16_t*)(ws + WS_YF); const bf16_t* yb = (const bf16_t*)(ws + WS_YB);
    const bf16_t* sg = (const bf16_t*)(ws + WS_SG); const float* sb = (const float*)(ws + WS_SB); const bf16_t* hb = (const bf16_t*)(ws + WS_H);
    for (size_t i = gtid; i < (size_t)T * 1024; i += NGT) {
        const size_t m = i >> 10; const int c = (int)(i & 1023);
        float v = 0.f;
#if MK_DBG_WHAT == 0
        v = bflo(rwc[m * 2048 + 2 * c]) + bflo(rwc[m * 2048 + 2 * c + 1]);
#elif MK_DBG_WHAT == 1
        v = bflo(c2[m * 2304 + 2 * c]) + bflo(c2[m * 2304 + 2 * c + 1]) + (c < 256 ? bflo(c2[m * 2304 + 2048 + c]) : 0.f);
#elif MK_DBG_WHAT == 2
        v = (c < 512 ? bflo(yf[m * 512 + c]) : bflo(yb[m * 512 + c - 512]));
#elif MK_DBG_WHAT == 3
        v = (c < 256 ? bflo(sg[m * 256 + c]) : (c < 272 ? sb[((c - 256) >> 3) * (size_t)T * 8 + m * 8 + (c & 7)] : bflo(hb[m * 1024 + c])));
#elif MK_DBG_WHAT == 6
        v = bflo(((const bf16_t*)(ws + WS_WIN))[(size_t)(4352 + (m % 3072)) * 1024 + c]) + bflo(hb[m * 1024 + c]);
#elif MK_DBG_WHAT == 5
        v = bflo(((const bf16_t*)(ws + WS_GT))[m * 1024 + c]);
#elif MK_DBG_WHAT == 4
        v = bflo(rwc[(size_t)T * 1024 + m * 1024 + c]);
#endif
        p.out[i] = v;
    }
}
#else
#define DBG_STOP(k) do { } while (0)
#endif

#define L1_REFRESH() do { asm volatile("s_waitcnt vmcnt(0)" ::: "memory"); __builtin_amdgcn_fence(__ATOMIC_ACQUIRE, "agent"); asm volatile("s_waitcnt vmcnt(0)" ::: "memory"); } while (0)
#define PHASE_IDS() int tid = threadIdx.x; asm volatile("" : "+v"(tid)); const int lane = tid & 63, wave = __builtin_amdgcn_readfirstlane(tid >> 6); const int gw = vcu * 8 + wave, gtid = bx * 512 + tid; (void)lane; (void)gw; (void)gtid
#define Win_t ((bf16_t*)(ws + WS_WIN))
#define Wbr_t ((bf16_t*)(ws + WS_WBR))
#define Wout_t ((bf16_t*)(ws + WS_WOUT))
#define W1_t ((bf16_t*)(ws + WS_W1))
#define W2_t ((bf16_t*)(ws + WS_W2))
#define w2t ((bf16_t*)(ws + WS_W2T))
#define a2t ((bf16_t*)(ws + WS_A2T))
#define g2t ((bf16_t*)(ws + WS_G2T))
#define Hb ((bf16_t*)(ws + WS_H))
#define RWC ((bf16_t*)(ws + WS_RWC))
#define C2 ((bf16_t*)(ws + WS_C2))
#define YF ((bf16_t*)(ws + WS_YF))
#define YB ((bf16_t*)(ws + WS_YB))
#define SG ((bf16_t*)(ws + WS_SG))
#define VT ((bf16_t*)(ws + WS_VT))
#define SB ((float*)(ws + WS_SB))
#define Gt ((bf16_t*)(ws + WS_GT))
#define Mg ((bf16_t*)(ws + WS_MRG))
#define Ub ((bf16_t*)(ws + WS_U))
__global__ void __launch_bounds__(512, 2) fwd_megakernel(Params p) {
    extern __shared__ __attribute__((aligned(16))) unsigned char lds_raw[];
    LAS unsigned char* lds = (LAS unsigned char*)lds_raw;
    cg::grid_group grid = cg::this_grid();
    volatile LAS unsigned* misc = (volatile LAS unsigned*)(lds + 133120);
    if (threadIdx.x < 16) misc[threadIdx.x] = 0u;
    __syncthreads();
    XcdBarrier xbar = xcd_barrier_post((unsigned*)(p.ws + 65536), misc);
    grid.sync();
    const int G = gridDim.x, bx = blockIdx.x;
    const int vcu = (G % 8 == 0) ? (bx % 8) * (G / 8) + bx / 8 : bx;
    const int NGW = G * 8, NGT = G * 512;
    float* X = p.out;

    for (int l = 0; l < DEPTH; ++l) {
        const float* xin = (l == 0) ? p.in[0] : X;
        unsigned char* ws0 = p.ws; asm volatile("" : "+s"(ws0));
        GAS unsigned char* ws = (GAS unsigned char*)ws0;
        if (PHMASK & (1u << 0)) {
            PHASE_IDS();
            LAS float* scr = (LAS float*)(lds + wave * 8448);
            const float* w_in = p.in[2] + (size_t)l * D_MODEL * IN_COLS;
            const float* w_br = p.in[19] + (size_t)l * 3 * 512 * D_MODEL;
            const float* w_out = p.in[20] + (size_t)l * D_MODEL * D_MODEL;
            const float* w_m1 = p.in[22] + (size_t)l * D_MODEL * D_FF;
            const float* w_m2 = p.in[23] + (size_t)l * D_FF * D_MODEL;
            const float* rw_w2 = p.in[6] + (size_t)l * 2 * 64 * 512;
            const float* rw_a2 = p.in[8] + (size_t)l * 2 * 64 * 512;
            const float* rw_g2 = p.in[9] + (size_t)l * 128 * 512;
            constexpr int I_IN = 232 * 16, I_BR = 3 * 8 * 32, I_OUT = 16 * 32, I_M1 = 16 * 128, I_M2 = 64 * 32, I_L = 32, I_G = 32;
            constexpr int NITEMS = I_IN + I_BR + I_OUT + I_M1 + I_M2 + 2 * I_L + I_G;
            for (int it = gw; it < NITEMS; it += NGW) {
                int r = it;
                if (r < I_IN) { const int db = r % 232, kb = r / 232; int src;
                    if (db < 60) src = 32 * db;
                    else if (db < 64) {
                        const int c = lane & 7;
#pragma unroll
                        for (int j = 0; j < 4; ++j) { const int n = (lane >> 3) + 8 * j; *(u32x4*)(Win_t + (size_t)(32 * db + n) * D_MODEL + 64 * kb + 8 * c) = (u32x4){0u, 0u, 0u, 0u}; }
                        continue; }
                    else if (db < 112) src = 1920 + 32 * (db - 64);
                    else if (db < 136) { const int pp = 32 * (db - 112), tile = pp >> 8, c = pp & 255, bj = c >> 7, wc = (c & 127) >> 5; src = 3456 + tile * 256 + 64 * wc + 32 * bj; }
                    else src = 4224 + 32 * (db - 136);
                    transpose_item(w_in, IN_COLS, 64 * kb, src, Win_t, D_MODEL, 32 * db, scr, lane); continue; }
                r -= I_IN;
                if (r < I_BR) { const int bb = r / 256, q = r % 256, kb = q / 32, nb = q % 32;
                    transpose_item(w_br + (size_t)bb * 512 * D_MODEL, D_MODEL, 64 * kb, 32 * nb, Wbr_t + (size_t)bb * D_MODEL * 512, 512, 32 * nb, scr, lane); continue; }
                r -= I_BR;
                if (r < I_OUT) { transpose_item(w_out, D_MODEL, 64 * (r / 32), 32 * (r % 32), Wout_t, D_MODEL, 32 * (r % 32), scr, lane); continue; }
                r -= I_OUT;
                if (r < I_M1) { transpose_item(w_m1, D_FF, 64 * (r / 128), 32 * (r % 128), W1_t, D_MODEL, 32 * (r % 128), scr, lane); continue; }
                r -= I_M1;
                if (r < I_M2) { transpose_item(w_m2, D_MODEL, 64 * (r / 32), 32 * (r % 32), W2_t, D_FF, 32 * (r % 32), scr, lane); continue; }
                r -= I_M2;
                if (r < I_L) { const int dd = r / 16, nb = r % 16; transpose_item(rw_w2 + (size_t)dd * 64 * 512, 512, 0, 32 * nb, w2t + (size_t)dd * 512 * 64, 64, 32 * nb, scr, lane); continue; }
                r -= I_L;
                if (r < I_L) { const int dd = r / 16, nb = r % 16; transpose_item(rw_a2 + (size_t)dd * 64 * 512, 512, 0, 32 * nb, a2t + (size_t)dd * 512 * 64, 64, 32 * nb, scr, lane); continue; }
                r -= I_L;
                { const int kb = r / 16, nb = r % 16; transpose_item(rw_g2, 512, 64 * kb, 32 * nb, g2t, 256, 32 * nb, scr, lane); }
            }
            for (int i = gtid; i < 512 * 16; i += NGT) *(u32x4*)(g2t + (size_t)(i >> 4) * 256 + 128 + 8 * (i & 15)) = (u32x4){0u, 0u, 0u, 0u};
            if (l == 0) for (int i = gtid; i < T * 16; i += NGT) *(u32x4*)(SG + (size_t)(i >> 4) * 256 + 128 + 8 * (i & 15)) = (u32x4){0u, 0u, 0u, 0u};
            const float* g1 = p.in[1] + (size_t)l * D_MODEL;
            if (T % (2 * NGW) == 0) { for (int m = gw; m < T; m += 2 * NGW) rms_row2(xin + (size_t)m * D_MODEL, xin + (size_t)(m + NGW) * D_MODEL, g1, Hb + (size_t)m * D_MODEL, Hb + (size_t)(m + NGW) * D_MODEL, lane); }
            else { for (int m = gw; m < T; m += NGW) rms_row(xin + (size_t)m * D_MODEL, g1, Hb + (size_t)m * D_MODEL, lane); }
        }
        xcd_barrier(xbar);
        DBG_STOP(1);
        if (PHMASK & (1u << 1)) {
            pg8::StaticOrder S;
#ifndef SKIP_P2A
            { pg8::Gemm g{Hb, Win_t, T, 3584, D_MODEL, D_MODEL}; S.init(T, 3584, G, bx);
              pg8::EpiStore<0> E{RWC, LD_RWC, C2, LD_C2, 8}; pg8::gemm_phase(lds, g, S, E); }
#endif
#ifndef SKIP_P2B
            { pg8::Gemm g{Hb, Win_t + (size_t)3584 * D_MODEL, T, 768, D_MODEL, D_MODEL}; S.init(T, 768, G, bx);
              pg8::EpiAttn E{C2, VT, p.in[17] + l * 64, p.in[18] + l * 64}; pg8::gemm_phase(lds, g, S, E); }
#endif
        }
        xcd_barrier(xbar);
        DBG_STOP(2);
        if (PHMASK & (1u << 2)) {
            PHASE_IDS();
            const float* cvw = p.in[15] + (size_t)l * 3 * 512; const float* cvb = p.in[16] + (size_t)l * 512;
            ScanW sw{p.in[3] + (size_t)l * RW_COLS, p.in[4] + (size_t)l * RW_COLS, p.in[5] + (size_t)l * 1024, p.in[7] + (size_t)l * 1024,
                     p.in[10] + (size_t)l * 512, p.in[11] + (size_t)l * 512, p.in[12] + (size_t)l * 512, w2t, a2t};
#ifndef SKIP_SCAN
#ifdef MK_DUP_SCAN
            for (int u = vcu; u < 256; u += G) { scan_unit(lds, RWC, YF, YB, SG, SB, sw, u >> 4, (u >> 1) & 7, u & 1, C2, cvw, cvb, u); __syncthreads(); }
#endif
            for (int u = vcu; u < 256; u += G) { scan_unit(lds, RWC, YF, YB, SG, SB, sw, u >> 4, (u >> 1) & 7, u & 1, C2, cvw, cvb, u); __syncthreads(); }
#endif
#ifndef SKIP_ATTN
#ifdef MK_DUP_ATTN
            for (int u = vcu; u < 1024; u += G) { attn_unit(lds, C2, (bf16_t*)(ws + 892 * MiB), u >> 6, (u >> 5) & 1, u & 31); }
#endif
            for (int u = vcu; u < 1024; u += G) { attn_unit(lds, C2, nullptr, u >> 6, (u >> 5) & 1, u & 31); }
#endif
        }
        xcd_barrier(xbar);
        DBG_STOP(3);
        if (PHMASK & (1u << 3)) {
            PHASE_IDS();
            const float* mup = p.in[3] + (size_t)l * RW_COLS + 1024; const float* mun = p.in[4] + (size_t)l * RW_COLS + 1024;
            const float* lng = p.in[13] + (size_t)l * 512; const float* lnb = p.in[14] + (size_t)l * 512;
            for (int m = gw; m < T; m += NGW) {
                const int t = m & 4095, c0 = 8 * lane, hh = lane >> 3;
                float yf[8], yb[8], vc[8], vpv[8], vn[8], y[8];
                unpack8(*(const u32x4*)(YF + (size_t)m * 512 + c0), yf); unpack8(*(const u32x4*)(YB + (size_t)m * 512 + c0), yb);
                const bf16_t* rp = RWC + (size_t)m * LD_RWC + 1024 + c0;
                unpack8(*(const u32x4*)rp, vc);
                if (t > 0) unpack8(*(const u32x4*)(rp - LD_RWC), vpv); else {
#pragma unroll
                    for (int j = 0; j < 8; ++j) vpv[j] = 0.f; }
                if (t < SEQ - 1) unpack8(*(const u32x4*)(rp + LD_RWC), vn); else {
#pragma unroll
                    for (int j = 0; j < 8; ++j) vn[j] = 0.f; }
                float s = 0.f;
#pragma unroll
                for (int j = 0; j < 8; ++j) { y[j] = yf[j] + yb[j]; s += y[j]; }
                const float mean = red8(s) * (1.f / 64.f);
                float q = 0.f;
#pragma unroll
                for (int j = 0; j < 8; ++j) { y[j] -= mean; q += y[j] * y[j]; }
                const float rstd = __builtin_amdgcn_rsqf(red8(q) * (1.f / 64.f) + 64e-5f);
                const float bs = 0.5f * (SB[(size_t)m * 8 + hh] + SB[((size_t)T + m) * 8 + hh]);
                float o[8];
#pragma unroll
                for (int j = 0; j < 8; ++j) { const float zv = vc[j] + mup[c0 + j] * (vpv[j] - vc[j]) + mun[c0 + j] * (vn[j] - vc[j]);
                    o[j] = y[j] * rstd * lng[c0 + j] + lnb[c0 + j] + bs * zv; }
                *(u32x4*)(YF + (size_t)m * 512 + c0) = pack8(o);
            }
        }
        xcd_barrier(xbar);
        DBG_STOP(4);
        if (PHMASK & (1u << 4)) {
            pg8::StaticOrder S; pg8::Gemm g{SG, g2t, T, 512, 256, 256}; S.init(T, 512, G, bx);
            pg8::EpiMulInPlace E{YF, 512}; pg8::gemm_phase(lds, g, S, E);
        }
        xcd_barrier(xbar);
        DBG_STOP(5);
        if (PHMASK & (1u << 5)) {
            pg8::StaticOrder S; S.init(T, 1024, G, bx);
            const bf16_t* Wg = Win_t + (size_t)4352 * D_MODEL;
            if (P4_CALLS >= 1)
            { pg8::Gemm g{Hb, Wg, T, 1024, D_MODEL, D_MODEL}; pg8::EpiStore<MK_GATE_ACT> E{Gt, D_MODEL, Gt, D_MODEL, 1 << 20}; pg8::gemm_phase(lds, g, S, E); }
            L1_REFRESH();
            if (P4_CALLS >= 2)
            { pg8::Gemm g{YF, Wbr_t, T, 1024, 512, 512}; pg8::EpiBranch<true> E{Gt, Mg}; pg8::gemm_phase(lds, g, S, E); }
            if (P4_CALLS >= 3)
            { pg8::Gemm g{Hb, Wg + (size_t)1024 * D_MODEL, T, 1024, D_MODEL, D_MODEL}; pg8::EpiStore<1> E{Gt, D_MODEL, Gt, D_MODEL, 1 << 20}; pg8::gemm_phase(lds, g, S, E); }
            L1_REFRESH();
            if (P4_CALLS >= 4)
            { pg8::Gemm g{C2, Wbr_t + (size_t)1024 * 512, T, 1024, 512, LD_C2}; pg8::EpiBranch<false> E{Gt, Mg}; pg8::gemm_phase(lds, g, S, E); }
            if (P4_CALLS >= 5)
            { pg8::Gemm g{Hb, Wg + (size_t)2048 * D_MODEL, T, 1024, D_MODEL, D_MODEL}; pg8::EpiStore<1> E{Gt, D_MODEL, Gt, D_MODEL, 1 << 20}; pg8::gemm_phase(lds, g, S, E); }
            L1_REFRESH();
            if (P4_CALLS >= 6)
            { pg8::Gemm g{C2 + 1536, Wbr_t + (size_t)2048 * 512, T, 1024, 512, LD_C2}; pg8::EpiBranch<false> E{Gt, Mg}; pg8::gemm_phase(lds, g, S, E); }
        }
        xcd_barrier(xbar);
        DBG_STOP(6);
        if (PHMASK & (1u << 6)) {
            pg8::StaticOrder S; S.init(T, 1024, G, bx);
            pg8::Gemm g{Mg, Wout_t, T, 1024, D_MODEL, D_MODEL}; pg8::EpiResidual E{xin, X}; pg8::gemm_phase(lds, g, S, E);
        }
        xcd_barrier(xbar);
        DBG_STOP(7);
        if (PHMASK & (1u << 7)) {
            PHASE_IDS();
            const float* g2 = p.in[21] + (size_t)l * D_MODEL;
            if (T % (2 * NGW) == 0) { for (int m = gw; m < T; m += 2 * NGW) rms_row2(X + (size_t)m * D_MODEL, X + (size_t)(m + NGW) * D_MODEL, g2, Hb + (size_t)m * D_MODEL, Hb + (size_t)(m + NGW) * D_MODEL, lane); }
            else { for (int m = gw; m < T; m += NGW) rms_row(X + (size_t)m * D_MODEL, g2, Hb + (size_t)m * D_MODEL, lane); }
        }
        xcd_barrier(xbar);
        DBG_STOP(8);
        if (PHMASK & (1u << 8)) {
            pg8::StaticOrder S; S.init(T, D_FF, G, bx);
            pg8::Gemm g{Hb, W1_t, T, D_FF, D_MODEL, D_MODEL}; pg8::EpiStore<2> E{Ub, D_FF, Ub, D_FF, 1 << 20}; pg8::gemm_phase(lds, g, S, E);
#ifdef MK_DUP_P7
            pg8::gemm_phase(lds, g, S, E);
#endif
        }
        xcd_barrier(xbar);
        DBG_STOP(9);
        if (PHMASK & (1u << 9)) {
            pg8::StaticOrder S; S.init(T, 1024, G, bx);
            pg8::Gemm g{Ub, W2_t, T, 1024, D_FF, D_FF}; pg8::EpiResidual E{X, X}; pg8::gemm_phase(lds, g, S, E);
        }
        xcd_barrier(xbar);
        DBG_STOP(10);
    }
}

extern "C" void kernel_launch(void* const* d_in, const int* in_sizes, int n_in, void* d_out, int out_size, void* d_ws, size_t ws_size, hipStream_t stream) {
    static int grid = 0;
    if (grid == 0) {
        if (n_in != 24 || out_size != T * D_MODEL || ws_size < WS_END) { fprintf(stderr, "kernel_launch: unexpected shapes (n_in %d out %d ws %zu)\n", n_in, out_size, ws_size); grid = -1; return; }
        int dev = 0, cus = 0, per_cu = 0;
        hipGetDevice(&dev);
        hipDeviceGetAttribute(&cus, hipDeviceAttributeMultiprocessorCount, dev);
        hipFuncSetAttribute((const void*)fwd_megakernel, hipFuncAttributeMaxDynamicSharedMemorySize, LDS_BYTES);
        hipOccupancyMaxActiveBlocksPerMultiprocessor(&per_cu, (const void*)fwd_megakernel, 512, LDS_BYTES);
        if (per_cu < 1) { fprintf(stderr, "kernel_launch: occupancy query says %d blocks per CU\n", per_cu); per_cu = 1; }
        (void)hipGetLastError();
        grid = cus;
    }
    if (grid < 0) return;
    if (hipMemsetAsync(d_ws, 0, 1u << 20, stream) != hipSuccess) { fprintf(stderr, "kernel_launch: memset failed\n"); return; }
    Params p{};
    for (int i = 0; i < 24; ++i) p.in[i] = (const float*)d_in[i];
    p.out = (float*)d_out; p.ws = (unsigned char*)d_ws;
    void* args[] = {&p};
    hipError_t e = hipLaunchCooperativeKernel((const void*)fwd_megakernel, dim3(grid), dim3(512), args, LDS_BYTES, stream);
    if (e != hipSuccess) fprintf(stderr, "cooperative launch failed: %s (grid %d)\n", hipGetErrorString(e), grid);
}
```

```cpp
#include <hip/hip_runtime.h>
#include <hip/hip_cooperative_groups.h>
#include <cstdio>
#include <cstdint>
namespace cg = cooperative_groups;

#define LAS __attribute__((address_space(3)))
#define GAS __attribute__((address_space(1)))
typedef unsigned short bf16_t;
typedef short bf16x8 __attribute__((ext_vector_type(8)));
typedef short bf16x4 __attribute__((ext_vector_type(4)));
typedef float f32x2 __attribute__((ext_vector_type(2)));
typedef float f32x4 __attribute__((ext_vector_type(4)));
typedef float f32x16 __attribute__((ext_vector_type(16)));
typedef unsigned u32x2 __attribute__((ext_vector_type(2)));
typedef unsigned u32x4 __attribute__((ext_vector_type(4)));

constexpr int D_MODEL = 1024, BATCH = 16, SEQ = 4096, DEPTH = 4, D_FF = 4096;
constexpr int T = BATCH * SEQ;
constexpr int IN_COLS = 7296, RW_COLS = 1920;
constexpr int NWIN = 7424;
constexpr int LD_RWC = 2048, LD_C2 = 2304;
constexpr float LOG2E = 1.4426950408889634f;

constexpr size_t MiB = 1u << 20;
constexpr size_t WS_WIN = 2 * MiB, WS_WBR = 17 * MiB, WS_WOUT = 20 * MiB, WS_W1 = 22 * MiB, WS_W2 = 30 * MiB;
constexpr size_t WS_W2T = 38 * MiB, WS_A2T = 38 * MiB + 131072, WS_G2T = 38 * MiB + 262144;
constexpr size_t WS_H = 40 * MiB, WS_RWC = 168 * MiB, WS_C2 = 424 * MiB, WS_YF = 712 * MiB, WS_YB = 776 * MiB;
constexpr size_t WS_SG = 840 * MiB, WS_VT = 872 * MiB, WS_SB = 888 * MiB, WS_END = 892 * MiB;
#ifdef MK_GT_FRESH
constexpr size_t WS_GT = 892 * MiB;
#else
constexpr size_t WS_GT = WS_RWC;
#endif
constexpr size_t WS_MRG = WS_RWC + 128 * MiB, WS_U = WS_RWC;

#ifndef MK_GATE_ACT
#define MK_GATE_ACT 1
#endif
#ifndef MK_P4_CALLS
#define MK_P4_CALLS 6
#endif
constexpr int P4_CALLS = MK_P4_CALLS;
#ifndef MK_PHMASK
#define MK_PHMASK 0xffffffffu
#endif
constexpr unsigned PHMASK = MK_PHMASK;
constexpr int LDS_BYTES = 135168;

typedef __bf16 bf16x2_t __attribute__((ext_vector_type(2)));
__device__ __forceinline__ unsigned cvt_pk_bf16(float lo, float hi) { const f32x2 v = {lo, hi}; const bf16x2_t b = __builtin_convertvector(v, bf16x2_t); return __builtin_bit_cast(unsigned, b); }
__device__ __forceinline__ bf16_t f2bf(float f) { return (bf16_t)(cvt_pk_bf16(f, 0.f) & 0xffffu); }
__device__ __forceinline__ float bflo(unsigned u) { return __builtin_bit_cast(float, u << 16); }
__device__ __forceinline__ float bfhi(unsigned u) { return __builtin_bit_cast(float, u & 0xffff0000u); }
__device__ __forceinline__ void unpack8(const u32x4 v, float* f) { f[0] = bflo(v.x); f[1] = bfhi(v.x); f[2] = bflo(v.y); f[3] = bfhi(v.y); f[4] = bflo(v.z); f[5] = bfhi(v.z); f[6] = bflo(v.w); f[7] = bfhi(v.w); }
__device__ __forceinline__ u32x4 pack8(const float* f) { u32x4 w; w.x = cvt_pk_bf16(f[0], f[1]); w.y = cvt_pk_bf16(f[2], f[3]); w.z = cvt_pk_bf16(f[4], f[5]); w.w = cvt_pk_bf16(f[6], f[7]); return w; }
__device__ __forceinline__ float trans_settle(float x) { float r; asm volatile("s_nop 1\n\tv_mov_b32 %0, %1" : "=v"(r) : "v"(x)); return r; }
__device__ __forceinline__ float sigmoid_f(float x) { return __builtin_amdgcn_rcpf(1.f + __builtin_amdgcn_exp2f(-LOG2E * x)); }
__device__ __forceinline__ float tanh_f(float x) { return 1.f - 2.f * __builtin_amdgcn_rcpf(1.f + __builtin_amdgcn_exp2f(2.f * LOG2E * x)); }
__device__ __forceinline__ float wave_sum(float v) {
#pragma unroll
    for (int o = 1; o < 64; o <<= 1) v += __shfl_xor(v, o);
    return v;
}
template <int CTRL> __device__ __forceinline__ float dpp_f(float x) { return __builtin_bit_cast(float, __builtin_amdgcn_update_dpp(0, __builtin_bit_cast(int, x), CTRL, 0xf, 0xf, true)); }
__device__ __forceinline__ float red8(float x) { x += dpp_f<0xB1>(x); x += dpp_f<0x4E>(x); x += dpp_f<0x141>(x); return x; }
__device__ __forceinline__ float red16(float x) { x = red8(x); x += dpp_f<0x140>(x); return x; }

namespace pg8 {
constexpr int BM = 256, BK = 64, HALF = 128, HTB = HALF * BK * 2, STAGE_BYTES = 8 * HTB, NXCD = 8, WGM = 8;
__host__ __device__ __forceinline__ int lds_byte(int r, int c) { const int st = (r >> 4) * 2 + (c >> 5), rr = r & 15, cc = c & 31, ob = rr * 64 + cc * 2; return st * 1024 + (ob ^ (((ob >> 9) & 1) << 5)); }
__host__ __device__ __forceinline__ void stage_rc(int b, int& R, int& C) { const int st = b / 1024, sb = b % 1024, swz = sb ^ (((sb >> 9) & 1) << 5); R = (st >> 1) * 16 + swz / 64; C = (st & 1) * 32 + (swz % 64) / 2; }
__host__ __device__ __forceinline__ int perm32(int rho) { const int n = rho >> 4, i = rho & 15; return 8 * (i >> 2) + 4 * n + (i & 3); }

struct Unit { int pm, pn; };
struct Gemm { const bf16_t* A; const bf16_t* Bt; int M, N, K, lda; };

struct StaticOrder {
    int nM, nN, nwg, G, c;
    __device__ void init(int M, int N, int G_, int c_) { nM = M / BM; nN = N / BM; nwg = nM * nN; G = G_; c = c_; }
    __device__ bool next(int i, Unit& u) const {
        const long L = (long)i * G + c; if (L >= nwg) return false;
        int wgid = (int)L; { const int q = nwg / NXCD, r = nwg % NXCD, xcd = wgid % NXCD, off = wgid / NXCD; wgid = (xcd < r ? xcd * (q + 1) : r * (q + 1) + (xcd - r) * q) + off; }
        const int nig = WGM * nN, gid = wgid / nig, fm = gid * WGM, gsz = (nM - fm) < WGM ? (nM - fm) : WGM;
        u.pm = fm + ((wgid % nig) % gsz); u.pn = (wgid % nig) / gsz; return true;
    }
};

template <class Epi>
__device__ __forceinline__ void gemm_phase(LAS unsigned char* lds, const Gemm g, const StaticOrder& S, const Epi& E) {
    int tid = threadIdx.x; asm volatile("" : "+v"(tid));
    const int wid = __builtin_amdgcn_readfirstlane(tid >> 6), lane = tid & 63, wr = wid >> 2, wc = wid & 3, fr = lane & 15, fq = lane >> 4;
    const int K = g.K, nt = K / BK, lda = g.lda;
    unsigned voffA[2], voffB[2];
#pragma unroll
    for (int i = 0; i < 2; ++i) { int R, C; stage_rc(tid * 16 + i * 8192, R, C); const int Rb = Epi::PERM ? ((R & ~31) + perm32(R & 31)) : R;
        voffA[i] = (unsigned)(R * lda + C) * 2u; voffB[i] = (unsigned)(Rb * K + C) * 2u; }
    const size_t kstep = (size_t)(BK * 2);
    const size_t hstepA = (size_t)HALF * lda * 2, hstepB = (size_t)HALF * K * 2;
    const size_t tstepA = 2 * hstepA, tstepB = 2 * hstepB;
    const unsigned ldsw = (unsigned)wid * 1024u;
    const int aoff = lds_byte(wr * 64 + fr, fq * 8), boff = lds_byte(wc * 32 + fr, fq * 8);
#define PG8_SA(b, h) (((b) * 2 + (h)) * HTB)
#define PG8_SB(b, h) ((4 + (b) * 2 + (h)) * HTB)
#define PG8_STAGE(bufoff, gbase, voff) do { _Pragma("unroll") for (int _i = 0; _i < 2; ++_i) \
        __builtin_amdgcn_global_load_lds((const unsigned*)((const char*)(gbase) + (voff)[_i]), (LAS unsigned*)(lds + (bufoff) + ldsw + _i * 8192), 16, 0, 0); } while (0)
#define PG8_LDA(dst, b, h) do { _Pragma("unroll") for (int m = 0; m < 4; ++m) _Pragma("unroll") for (int k = 0; k < 2; ++k) dst[m][k] = *(const LAS bf16x8*)(lds + PG8_SA(b, h) + aoff + m * 2048 + k * 1024); } while (0)
#define PG8_LDB(dst, b, h) do { _Pragma("unroll") for (int n = 0; n < 2; ++n) _Pragma("unroll") for (int k = 0; k < 2; ++k) dst[n][k] = *(const LAS bf16x8*)(lds + PG8_SB(b, h) + boff + n * 2048 + k * 1024); } while (0)
#define PG8_MMA(ai, bj, At, Bt) do { __builtin_amdgcn_s_setprio(1); _Pragma("unroll") for (int m = 0; m < 4; ++m) _Pragma("unroll") for (int n = 0; n < 2; ++n) _Pragma("unroll") for (int k = 0; k < 2; ++k) \
        acc[ai][bj][m][n] = __builtin_amdgcn_mfma_f32_16x16x32_bf16(Bt[n][k], At[m][k], acc[ai][bj][m][n], 0, 0, 0); __builtin_amdgcn_s_setprio(0); } while (0)
#define PG8_WAIT_V(n) asm volatile("s_waitcnt vmcnt(" #n ")" ::: "memory")
#define PG8_WAIT_L(n) asm volatile("s_waitcnt lgkmcnt(" #n ")" ::: "memory")
#define PG8_BAR __builtin_amdgcn_s_barrier()
#define PG8_SCHED __builtin_amdgcn_sched_barrier(0)
    Unit cur, nxt; int ui = 0;
    if (!S.next(0, cur)) return;
    f32x4 acc[2][2][4][2];
#pragma unroll
    for (int a = 0; a < 2; ++a)
#pragma unroll
        for (int b = 0; b < 2; ++b)
#pragma unroll
            for (int m = 0; m < 4; ++m)
#pragma unroll
                for (int n = 0; n < 2; ++n) acc[a][b][m][n] = (f32x4){0.f, 0.f, 0.f, 0.f};
    bf16x8 At[4][2], B0[2][2], B1[2][2];
    const char* cA = (const char*)g.A + (size_t)cur.pm * tstepA; const char* cB = (const char*)g.Bt + (size_t)cur.pn * tstepB;
    PG8_STAGE(PG8_SB(0, 0), cB, voffB); PG8_STAGE(PG8_SB(0, 1), cB + hstepB, voffB); PG8_STAGE(PG8_SA(0, 0), cA, voffA); PG8_STAGE(PG8_SA(0, 1), cA + hstepA, voffA);
    if (wr == 1) PG8_BAR;
    PG8_WAIT_V(2); PG8_BAR;
    PG8_STAGE(PG8_SB(1, 0), cB + kstep, voffB); PG8_STAGE(PG8_SA(1, 0), cA + kstep, voffA); PG8_STAGE(PG8_SB(1, 1), cB + hstepB + kstep, voffB);
    PG8_WAIT_V(6); PG8_BAR;
    for (;;) {
        const bool has_next = S.next(ui + 1, nxt);
        const char* nA = has_next ? (const char*)g.A + (size_t)nxt.pm * tstepA : cA; const char* nB = has_next ? (const char*)g.Bt + (size_t)nxt.pn * tstepB : cB;
#pragma nounroll
        for (int t = 0; t < nt; t += 2) {
            const bool last = (t == nt - 2);
            const char* a1 = cA + (size_t)(t + 1) * kstep;
            const char* a2 = last ? nA : cA + (size_t)(t + 2) * kstep; const char* b2 = last ? nB : cB + (size_t)(t + 2) * kstep;
            const char* a3 = a2 + kstep; const char* b3 = b2 + kstep;
            PG8_LDB(B0, 0, 0); PG8_LDB(B1, 0, 1); PG8_SCHED; PG8_LDA(At, 0, 0); PG8_STAGE(PG8_SA(1, 1), a1 + hstepA, voffA);
            PG8_WAIT_V(8); PG8_WAIT_L(0); PG8_BAR; PG8_MMA(0, 0, At, B0); PG8_MMA(0, 1, At, B1); PG8_BAR; PG8_SCHED;
            PG8_LDA(At, 0, 1); PG8_STAGE(PG8_SB(0, 0), b2, voffB); PG8_STAGE(PG8_SB(0, 1), b2 + hstepB, voffB); PG8_STAGE(PG8_SA(0, 0), a2, voffA);
            PG8_WAIT_V(8); PG8_WAIT_L(0); PG8_BAR; PG8_MMA(1, 0, At, B0); PG8_MMA(1, 1, At, B1); PG8_BAR; PG8_SCHED;
            PG8_LDB(B0, 1, 0); PG8_LDB(B1, 1, 1); PG8_SCHED; PG8_LDA(At, 1, 0); PG8_STAGE(PG8_SA(0, 1), a2 + hstepA, voffA);
            PG8_WAIT_V(8); PG8_WAIT_L(0); PG8_BAR; PG8_MMA(0, 0, At, B0); PG8_MMA(0, 1, At, B1); PG8_BAR; PG8_SCHED;
            PG8_LDA(At, 1, 1); PG8_STAGE(PG8_SB(1, 0), b3, voffB); PG8_STAGE(PG8_SB(1, 1), b3 + hstepB, voffB); PG8_STAGE(PG8_SA(1, 0), a3, voffA);
            PG8_WAIT_V(8); PG8_WAIT_L(0); PG8_BAR; PG8_MMA(1, 0, At, B0); PG8_MMA(1, 1, At, B1); PG8_BAR; PG8_SCHED;
        }
        if (wr == 0) PG8_BAR;
        E(acc, cur, wr, wc, fr, fq);
        if (!has_next) break;
#pragma unroll
        for (int a = 0; a < 2; ++a)
#pragma unroll
            for (int b = 0; b < 2; ++b)
#pragma unroll
                for (int m = 0; m < 4; ++m)
#pragma unroll
                    for (int n = 0; n < 2; ++n) acc[a][b][m][n] = (f32x4){0.f, 0.f, 0.f, 0.f};
        cur = nxt; cA = nA; cB = nB; ++ui;
        if (wr == 1) PG8_BAR;
    }
    PG8_WAIT_V(0);
    PG8_BAR;
#undef PG8_SA
#undef PG8_SB
#undef PG8_STAGE
#undef PG8_LDA
#undef PG8_LDB
#undef PG8_MMA
#undef PG8_WAIT_V
#undef PG8_WAIT_L
#undef PG8_BAR
#undef PG8_SCHED
}

#define EPI_FENCE() do { asm volatile("" ::: "memory"); __builtin_amdgcn_sched_barrier(0); } while (0)
template <int ACT> struct EpiStore {
    static constexpr bool PERM = true;
    bf16_t* O0; int ld0; bf16_t* O1; int ld1; int pn_split;
    __device__ __forceinline__ void operator()(const f32x4 (&acc)[2][2][4][2], const Unit& u, int wr, int wc, int fr, int fq) const {
        bf16_t* base; int ld, colt;
        if (u.pn < pn_split) { base = O0; ld = ld0; colt = u.pn * BM; } else { base = O1; ld = ld1; colt = (u.pn - pn_split) * BM; }
        const int row0 = u.pm * BM + wr * 64 + fr, col0 = colt + wc * 32 + 8 * fq;
#pragma unroll
        for (int ai = 0; ai < 2; ++ai)
#pragma unroll
            for (int m = 0; m < 4; ++m) { bf16_t* rowp = base + (size_t)(row0 + ai * HALF + m * 16) * ld + col0;
#pragma unroll
                for (int bj = 0; bj < 2; ++bj) { float v[8];
#pragma unroll
                    for (int j = 0; j < 4; ++j) { v[j] = acc[ai][bj][m][0][j]; v[4 + j] = acc[ai][bj][m][1][j]; }
#pragma unroll
                    for (int j = 0; j < 8; ++j) { if (ACT == 1) v[j] = sigmoid_f(v[j]); if (ACT == 2) { const float r = fmaxf(v[j], 0.f); v[j] = r * r; } }
                    *(u32x4*)(rowp + bj * HALF) = pack8(v); }
                EPI_FENCE(); }
    }
};
struct EpiResidual {
    static constexpr bool PERM = false;
    const float* xin; float* xout;
    __device__ __forceinline__ void operator()(const f32x4 (&acc)[2][2][4][2], const Unit& u, int wr, int wc, int fr, int fq) const {
        const int row0 = u.pm * BM + wr * 64 + fr, col0 = u.pn * BM + wc * 32 + 4 * fq;
#pragma unroll
        for (int ai = 0; ai < 2; ++ai)
#pragma unroll
            for (int m = 0; m < 4; ++m) { const size_t off = (size_t)(row0 + ai * HALF + m * 16) * D_MODEL + col0;
#pragma unroll
                for (int bj = 0; bj < 2; ++bj)
#pragma unroll
                    for (int n = 0; n < 2; ++n) { const f32x4 b = *(const f32x4*)(xin + off + bj * HALF + n * 16); *(f32x4*)(xout + off + bj * HALF + n * 16) = b + acc[ai][bj][m][n]; } }
    }
};
struct EpiMulInPlace {
    static constexpr bool PERM = true;
    bf16_t* Y; int ld;
    __device__ __forceinline__ void operator()(const f32x4 (&acc)[2][2][4][2], const Unit& u, int wr, int wc, int fr, int fq) const {
        const int row0 = u.pm * BM + wr * 64 + fr, col0 = u.pn * BM + wc * 32 + 8 * fq;
#pragma unroll
        for (int ai = 0; ai < 2; ++ai)
#pragma unroll
            for (int m = 0; m < 4; ++m) { bf16_t* rowp = Y + (size_t)(row0 + ai * HALF + m * 16) * ld + col0;
#pragma unroll
                for (int bj = 0; bj < 2; ++bj) { float y[8]; unpack8(*(const u32x4*)(rowp + bj * HALF), y);
#pragma unroll
                    for (int j = 0; j < 4; ++j) { y[j] *= acc[ai][bj][m][0][j]; y[4 + j] *= acc[ai][bj][m][1][j]; }
                    *(u32x4*)(rowp + bj * HALF) = pack8(y); }
                EPI_FENCE(); }
    }
};
template <bool FIRST> struct EpiBranch {
    static constexpr bool PERM = true;
    const bf16_t* Gt; bf16_t* Mg;
    __device__ __forceinline__ void operator()(const f32x4 (&acc)[2][2][4][2], const Unit& u, int wr, int wc, int fr, int fq) const {
        const int row0 = u.pm * BM + wr * 64 + fr, col0 = u.pn * BM + wc * 32 + 8 * fq;
#pragma unroll
        for (int ai = 0; ai < 2; ++ai) {
            u32x4 gq[4][2], mq[4][2];
#pragma unroll
            for (int m = 0; m < 4; ++m) { const size_t off = (size_t)(row0 + ai * HALF + m * 16) * D_MODEL + col0;
#pragma unroll
                for (int bj = 0; bj < 2; ++bj) { gq[m][bj] = *(const u32x4*)(Gt + off + bj * HALF); if (!FIRST) mq[m][bj] = *(const u32x4*)(Mg + off + bj * HALF); } }
#pragma unroll
            for (int m = 0; m < 4; ++m) { const size_t off = (size_t)(row0 + ai * HALF + m * 16) * D_MODEL + col0;
#pragma unroll
                for (int bj = 0; bj < 2; ++bj) { float gt[8], o[8]; unpack8(gq[m][bj], gt);
                    if (FIRST) {
#pragma unroll
                        for (int j = 0; j < 8; ++j) o[j] = 0.f;
                    } else unpack8(mq[m][bj], o);
#pragma unroll
                    for (int j = 0; j < 4; ++j) { o[j] += gt[j] * acc[ai][bj][m][0][j]; o[4 + j] += gt[4 + j] * acc[ai][bj][m][1][j]; }
                    *(u32x4*)(Mg + off + bj * HALF) = pack8(o); } }
            EPI_FENCE(); }
    }
};
struct EpiAttn {
    static constexpr bool PERM = false;
    bf16_t* C2; bf16_t* VT; const float* qg; const float* kg;
    __device__ __forceinline__ void operator()(const f32x4 (&acc)[2][2][4][2], const Unit& u, int wr, int wc, int fr, int fq) const {
        if (u.pn == 2 && wc >= 2) {
#pragma unroll
            for (int ai = 0; ai < 2; ++ai)
#pragma unroll
                for (int m = 0; m < 4; ++m) { const int row = u.pm * BM + ai * HALF + wr * 64 + m * 16 + fr;
                    bf16_t* rowp = C2 + (size_t)row * LD_C2 + 2048 + wc * 64 + 4 * fq;
#pragma unroll
                    for (int bj = 0; bj < 2; ++bj)
#pragma unroll
                        for (int n = 0; n < 2; ++n) { const f32x4 x = acc[ai][bj][m][n]; u32x2 w; w.x = cvt_pk_bf16(x[0], x[1]); w.y = cvt_pk_bf16(x[2], x[3]); *(u32x2*)(rowp + 32 * bj + 16 * n) = w; }
                    EPI_FENCE(); }
        } else {
            const bool isK = (u.pn == 2);
            int opq = 0; asm volatile("" : "+v"(opq));
            fq += opq; fr += opq;
            const float* gp = isK ? kg : qg;
            const int colbase = isK ? (2048 + wc * 64) : (1536 + (u.pn * 4 + wc) * 64);
            const float sc = isK ? 1.f : 0.125f * LOG2E;
            float gv[2][2][4], invf[4];
#pragma unroll
            for (int bj = 0; bj < 2; ++bj)
#pragma unroll
                for (int n = 0; n < 2; ++n)
#pragma unroll
                    for (int j = 0; j < 4; ++j) gv[bj][n][j] = gp[32 * bj + 16 * n + 4 * fq + j] * sc;
#pragma unroll
            for (int j = 0; j < 4; ++j) invf[j] = __builtin_amdgcn_exp2f(-(float)(4 * fq + j) * (13.287712379549449f / 16.f));
#pragma unroll
            for (int ai = 0; ai < 2; ++ai)
#pragma unroll
                for (int m = 0; m < 4; ++m) { const int row = u.pm * BM + ai * HALF + wr * 64 + m * 16 + fr; const int t = row & 4095;
                    float ss = 0.f;
#pragma unroll
                    for (int bj = 0; bj < 2; ++bj)
#pragma unroll
                        for (int n = 0; n < 2; ++n) { const f32x4 x = acc[ai][bj][m][n]; ss += (x[0] * x[0] + x[1] * x[1]) + (x[2] * x[2] + x[3] * x[3]); }
                    ss += __shfl_xor(ss, 16); ss += __shfl_xor(ss, 32);
                    const float rinv = __builtin_amdgcn_rsqf(ss * (1.f / 64.f) + 1e-6f);
                    bf16_t* rowp = C2 + (size_t)row * LD_C2 + colbase + 4 * fq;
#pragma unroll
                    for (int bj = 0; bj < 2; ++bj) { const float pos = (float)(bj ? (t & 63) : (t >> 6)); float o1[4], o2[4];
#pragma unroll
                        for (int j = 0; j < 4; ++j) { const float ang = pos * invf[j], c = __cosf(ang), s = __sinf(ang);
                            const float x1 = acc[ai][bj][m][0][j] * rinv * gv[bj][0][j], x2 = acc[ai][bj][m][1][j] * rinv * gv[bj][1][j];
                            o1[j] = x1 * c - x2 * s; o2[j] = x2 * c + x1 * s; }
                        u32x2 w1, w2; w1.x = cvt_pk_bf16(o1[0], o1[1]); w1.y = cvt_pk_bf16(o1[2], o1[3]); w2.x = cvt_pk_bf16(o2[0], o2[1]); w2.y = cvt_pk_bf16(o2[2], o2[3]);
                        *(u32x2*)(rowp + 32 * bj) = w1; *(u32x2*)(rowp + 32 * bj + 16) = w2; }
                    EPI_FENCE(); }
        }
    }
};
}

struct Params { const float* in[24]; float* out; unsigned char* ws; };

__device__ __forceinline__ void transpose_item(const float* W, int ldw, int k0, int n_src, bf16_t* WT, int ldt, int dst_row0, LAS float* scr, int lane) {
#pragma unroll 8
    for (int i = 0; i < 32; ++i) { const int kk = 2 * i + (lane >> 5); scr[kk * 33 + (lane & 31)] = W[(size_t)(k0 + kk) * ldw + n_src + (lane & 31)]; }
    asm volatile("s_waitcnt lgkmcnt(0)" ::: "memory");
    const int c = lane & 7;
#pragma unroll
    for (int j = 0; j < 4; ++j) { const int n = (lane >> 3) + 8 * j; const LAS float* s = scr + (8 * c) * 33 + n;
        u32x4 o; o.x = cvt_pk_bf16(s[0 * 33], s[1 * 33]); o.y = cvt_pk_bf16(s[2 * 33], s[3 * 33]); o.z = cvt_pk_bf16(s[4 * 33], s[5 * 33]); o.w = cvt_pk_bf16(s[6 * 33], s[7 * 33]);
        *(u32x4*)(WT + (size_t)(dst_row0 + n) * ldt + k0 + 8 * c) = o; }
    asm volatile("s_waitcnt lgkmcnt(0)" ::: "memory");
}
__device__ __forceinline__ void rms_row2(const float* xrow0, const float* xrow1, const float* g, bf16_t* orow0, bf16_t* orow1, int lane) {
    const f32x4* xr0 = (const f32x4*)xrow0 + lane; const f32x4* xr1 = (const f32x4*)xrow1 + lane; const f32x4* gr = (const f32x4*)g + lane;
    f32x4 v0[4], v1[4]; float s0 = 0.f, s1 = 0.f;
#pragma unroll
    for (int j = 0; j < 4; ++j) { v0[j] = xr0[64 * j]; v1[j] = xr1[64 * j]; }
#pragma unroll
    for (int j = 0; j < 4; ++j) { s0 += (v0[j].x * v0[j].x + v0[j].y * v0[j].y) + (v0[j].z * v0[j].z + v0[j].w * v0[j].w); s1 += (v1[j].x * v1[j].x + v1[j].y * v1[j].y) + (v1[j].z * v1[j].z + v1[j].w * v1[j].w); }
    const float inv0 = __builtin_amdgcn_rsqf(wave_sum(s0) * (1.f / D_MODEL) + 1e-6f), inv1 = __builtin_amdgcn_rsqf(wave_sum(s1) * (1.f / D_MODEL) + 1e-6f);
    u32x2* o0 = (u32x2*)orow0 + lane; u32x2* o1 = (u32x2*)orow1 + lane;
#pragma unroll
    for (int j = 0; j < 4; ++j) { const f32x4 gg = gr[64 * j]; u32x2 w;
        w.x = cvt_pk_bf16(v0[j].x * inv0 * gg.x, v0[j].y * inv0 * gg.y); w.y = cvt_pk_bf16(v0[j].z * inv0 * gg.z, v0[j].w * inv0 * gg.w); o0[64 * j] = w;
        w.x = cvt_pk_bf16(v1[j].x * inv1 * gg.x, v1[j].y * inv1 * gg.y); w.y = cvt_pk_bf16(v1[j].z * inv1 * gg.z, v1[j].w * inv1 * gg.w); o1[64 * j] = w; }
}
__device__ __forceinline__ void rms_row(const float* xrow, const float* g, bf16_t* orow, int lane) {
    const f32x4* xr = (const f32x4*)xrow + lane; const f32x4* gr = (const f32x4*)g + lane;
    f32x4 v[4]; float s = 0.f;
#pragma unroll
    for (int j = 0; j < 4; ++j) { v[j] = xr[64 * j]; s += (v[j].x * v[j].x + v[j].y * v[j].y) + (v[j].z * v[j].z + v[j].w * v[j].w); }
    const float inv = __builtin_amdgcn_rsqf(wave_sum(s) * (1.f / D_MODEL) + 1e-6f);
    u32x2* o8 = (u32x2*)orow + lane;
#pragma unroll
    for (int j = 0; j < 4; ++j) { const f32x4 gg = gr[64 * j]; u32x2 w; w.x = cvt_pk_bf16(v[j].x * inv * gg.x, v[j].y * inv * gg.y); w.y = cvt_pk_bf16(v[j].z * inv * gg.z, v[j].w * inv * gg.w); o8[64 * j] = w; }
}

constexpr int AT_KSTR = 72, AT_VSTR = 68;
constexpr int AT_KBYTES = 64 * AT_KSTR * 2, AT_VBYTES = 64 * AT_VSTR * 2;
__device__ __forceinline__ void vt_write(LAS unsigned char* p, const u32x4 v) {
    *(LAS unsigned short*)(p + 0 * (AT_VSTR * 2)) = (unsigned short)(v.x & 0xffffu); *(LAS unsigned short*)(p + 1 * (AT_VSTR * 2)) = (unsigned short)(v.x >> 16);
    *(LAS unsigned short*)(p + 2 * (AT_VSTR * 2)) = (unsigned short)(v.y & 0xffffu); *(LAS unsigned short*)(p + 3 * (AT_VSTR * 2)) = (unsigned short)(v.y >> 16);
    *(LAS unsigned short*)(p + 4 * (AT_VSTR * 2)) = (unsigned short)(v.z & 0xffffu); *(LAS unsigned short*)(p + 5 * (AT_VSTR * 2)) = (unsigned short)(v.z >> 16);
    *(LAS unsigned short*)(p + 6 * (AT_VSTR * 2)) = (unsigned short)(v.w & 0xffffu); *(LAS unsigned short*)(p + 7 * (AT_VSTR * 2)) = (unsigned short)(v.w >> 16);
}
__device__ __forceinline__ void attn_tile(LAS unsigned char* lds, int cur, int r32, int hi, const bf16x8 (&qf)[4], float& mref, float& lrun, f32x16& o0, f32x16& o1) {
        const LAS unsigned char* kb = lds + cur * AT_KBYTES + r32 * (AT_KSTR * 2) + hi * 16;
        f32x16 p0, p1;
        { const float nm = -mref;
#pragma unroll
          for (int r = 0; r < 16; ++r) { p0[r] = nm; p1[r] = nm; } }
#pragma unroll
        for (int d0 = 0; d0 < 4; ++d0) {
            const bf16x8 a0 = *(const LAS bf16x8*)(kb + d0 * 32), a1 = *(const LAS bf16x8*)(kb + 32 * (AT_KSTR * 2) + d0 * 32);
            p0 = __builtin_amdgcn_mfma_f32_32x32x16_bf16(a0, qf[d0], p0, 0, 0, 0);
            p1 = __builtin_amdgcn_mfma_f32_32x32x16_bf16(a1, qf[d0], p1, 0, 0, 0);
        }
        float mx = __builtin_fmaxf(__builtin_fmaxf(p0[0], p1[0]), p0[1]);
        mx = __builtin_fmaxf(__builtin_fmaxf(mx, p1[1]), p0[2]);
#pragma unroll
        for (int r = 2; r < 14; r += 2) { mx = __builtin_fmaxf(__builtin_fmaxf(mx, p1[r]), p0[r + 1]); mx = __builtin_fmaxf(__builtin_fmaxf(mx, p1[r + 1]), p0[r + 2]); }
        mx = __builtin_fmaxf(__builtin_fmaxf(mx, p1[14]), p0[15]); mx = __builtin_fmaxf(mx, p1[15]);
        mx = __builtin_fmaxf(mx, __shfl_xor(mx, 32));
        if (__builtin_expect(__any(mx > 8.0f), 0)) {
            const float dl = __builtin_fmaxf(mx, 0.f), f = __builtin_amdgcn_exp2f(-dl);
            mref += dl; lrun *= f;
#pragma unroll
            for (int r = 0; r < 16; ++r) { p0[r] -= dl; p1[r] -= dl; o0[r] *= f; o1[r] *= f; }
        }
        f32x2 ls2 = {0.f, 0.f};
#pragma unroll
        for (int r = 0; r < 16; r += 2) {
            p0[r] = __builtin_amdgcn_exp2f(p0[r]); p0[r + 1] = __builtin_amdgcn_exp2f(p0[r + 1]); p1[r] = __builtin_amdgcn_exp2f(p1[r]); p1[r + 1] = __builtin_amdgcn_exp2f(p1[r + 1]);
            ls2 += (f32x2){p0[r], p0[r + 1]}; ls2 += (f32x2){p1[r], p1[r + 1]};
        }
        lrun += ls2.x + ls2.y;
        bf16x8 pf[4];
        { u32x4 w;
          w.x = cvt_pk_bf16(p0[0], p0[1]); w.y = cvt_pk_bf16(p0[2], p0[3]); w.z = cvt_pk_bf16(p0[4], p0[5]); w.w = cvt_pk_bf16(p0[6], p0[7]); pf[0] = __builtin_bit_cast(bf16x8, w);
          w.x = cvt_pk_bf16(p0[8], p0[9]); w.y = cvt_pk_bf16(p0[10], p0[11]); w.z = cvt_pk_bf16(p0[12], p0[13]); w.w = cvt_pk_bf16(p0[14], p0[15]); pf[1] = __builtin_bit_cast(bf16x8, w);
          w.x = cvt_pk_bf16(p1[0], p1[1]); w.y = cvt_pk_bf16(p1[2], p1[3]); w.z = cvt_pk_bf16(p1[4], p1[5]); w.w = cvt_pk_bf16(p1[6], p1[7]); pf[2] = __builtin_bit_cast(bf16x8, w);
          w.x = cvt_pk_bf16(p1[8], p1[9]); w.y = cvt_pk_bf16(p1[10], p1[11]); w.z = cvt_pk_bf16(p1[12], p1[13]); w.w = cvt_pk_bf16(p1[14], p1[15]); pf[3] = __builtin_bit_cast(bf16x8, w); }
        const LAS unsigned char* vb = lds + 2 * AT_KBYTES + cur * AT_VBYTES + r32 * (AT_VSTR * 2) + hi * 8;
#pragma unroll
        for (int s = 0; s < 4; ++s) {
            const int koff = ((s >> 1) * 32 + (s & 1) * 16) * 2;
            const u32x2 l0 = *(const LAS u32x2*)(vb + koff), h0 = *(const LAS u32x2*)(vb + koff + 16);
            const u32x2 l1 = *(const LAS u32x2*)(vb + 32 * (AT_VSTR * 2) + koff), h1 = *(const LAS u32x2*)(vb + 32 * (AT_VSTR * 2) + koff + 16);
            const bf16x8 a0 = __builtin_bit_cast(bf16x8, (u32x4){l0.x, l0.y, h0.x, h0.y}), a1 = __builtin_bit_cast(bf16x8, (u32x4){l1.x, l1.y, h1.x, h1.y});
            o0 = __builtin_amdgcn_mfma_f32_32x32x16_bf16(a0, pf[s], o0, 0, 0, 0);
            o1 = __builtin_amdgcn_mfma_f32_32x32x16_bf16(a1, pf[s], o1, 0, 0, 0);
        }
}
__device__ __forceinline__ void attn_unit(LAS unsigned char* lds, bf16_t* C2, bf16_t* Odummy, int b, int kvh, int qb) {
    int tid = threadIdx.x; asm volatile("" : "+v"(tid));
    const int lane = tid & 63, r32 = lane & 31, hi = lane >> 5, wid = __builtin_amdgcn_readfirstlane(tid >> 6);
    const int g = wid & 3, th = wid >> 2, head = kvh * 4 + g;
    const size_t rowbase = (size_t)b * SEQ;
    const int tok0 = qb * 128 + th * 64;
    bf16_t* qrowA = C2 + (rowbase + tok0 + r32) * LD_C2 + 1536 + head * 64;
    bf16_t* qrowB = qrowA + (size_t)32 * LD_C2;
    bf16x8 qfA[4], qfB[4];
#pragma unroll
    for (int d0 = 0; d0 < 4; ++d0) { qfA[d0] = *(const bf16x8*)(qrowA + d0 * 16 + hi * 8); qfB[d0] = *(const bf16x8*)(qrowB + d0 * 16 + hi * 8); }
    const int srow = tid >> 3, sch = tid & 7;
    const bf16_t* ksrc = C2 + (rowbase + srow) * LD_C2 + 2048 + kvh * 64 + sch * 8;
    const bf16_t* vsrc = ksrc + 128;
    LAS unsigned char* kdst = lds + srow * (AT_KSTR * 2) + sch * 16;
    LAS unsigned char* vdst = lds + 2 * AT_KBYTES + (8 * sch) * (AT_VSTR * 2) + srow * 2;
    u32x4 kregA = *(const u32x4*)ksrc, vregA = *(const u32x4*)vsrc, kregB, vregB;
    *(LAS u32x4*)kdst = kregA; vt_write(vdst, vregA);
    kregA = *(const u32x4*)(ksrc + (size_t)64 * LD_C2); vregA = *(const u32x4*)(vsrc + (size_t)64 * LD_C2);
    __syncthreads();
    f32x16 oA0 = {}, oA1 = {}, oB0 = {}, oB1 = {};
    float mrefA = 0.f, lrunA = 0.f, mrefB = 0.f, lrunB = 0.f;
#define AT_STEP(kt, cur, KW, VW, KL, VL) { \
        if ((kt) + 2 < SEQ / 64) { KL = *(const u32x4*)(ksrc + (size_t)((kt) + 2) * 64 * LD_C2); VL = *(const u32x4*)(vsrc + (size_t)((kt) + 2) * 64 * LD_C2); } \
        attn_tile(lds, cur, r32, hi, qfA, mrefA, lrunA, oA0, oA1); \
        __builtin_amdgcn_sched_barrier(0); \
        attn_tile(lds, cur, r32, hi, qfB, mrefB, lrunB, oB0, oB1); \
        __builtin_amdgcn_sched_barrier(0); \
        if ((kt) + 1 < SEQ / 64) { *(LAS u32x4*)(kdst + ((cur) ^ 1) * AT_KBYTES) = KW; vt_write(vdst + ((cur) ^ 1) * AT_VBYTES, VW); } \
        __syncthreads(); }
    for (int kt = 0; kt < SEQ / 64; kt += 2) {
        AT_STEP(kt, 0, kregA, vregA, kregB, vregB);
        AT_STEP(kt + 1, 1, kregB, vregB, kregA, vregA);
    }
#undef AT_STEP
#pragma unroll
    for (int blk = 0; blk < 2; ++blk) {
        float lr = blk ? lrunB : lrunA; lr += __shfl_xor(lr, 32);
        const float rl = __builtin_amdgcn_rcpf(lr);
        const f32x16& o0 = blk ? oB0 : oA0; const f32x16& o1 = blk ? oB1 : oA1;
        bf16_t* qrow = blk ? qrowB : qrowA;
        bf16_t* orow = Odummy ? Odummy + (rowbase + tok0 + 32 * blk + r32) * 512 + head * 64 : qrow;
#pragma unroll
        for (int g4 = 0; g4 < 4; ++g4) {
            u32x2 w0, w1;
            w0.x = cvt_pk_bf16(o0[4 * g4] * rl, o0[4 * g4 + 1] * rl); w0.y = cvt_pk_bf16(o0[4 * g4 + 2] * rl, o0[4 * g4 + 3] * rl);
            w1.x = cvt_pk_bf16(o1[4 * g4] * rl, o1[4 * g4 + 1] * rl); w1.y = cvt_pk_bf16(o1[4 * g4 + 2] * rl, o1[4 * g4 + 3] * rl);
            *(u32x2*)(orow + 8 * g4 + 4 * hi) = w0; *(u32x2*)(orow + 32 + 8 * g4 + 4 * hi) = w1;
        }
    }
}

__device__ __forceinline__ void conv_item(bf16_t* C2, const float* cvw, const float* cvb, int idx) {
    const int m = idx >> 6, c0 = (idx & 63) * 8, t = m & 4095;
    bf16_t* rp = C2 + (size_t)m * LD_C2 + c0;
    const bf16_t* rpp = (t > 0) ? rp - LD_C2 : rp; const bf16_t* rpn = (t < SEQ - 1) ? rp + LD_C2 : rp;
    const float fp = (t > 0) ? 1.f : 0.f, fn = (t < SEQ - 1) ? 1.f : 0.f;
    float bg[8], c[8], x[8], a[8], bq[8], a2[8], b2[8], o[8];
    unpack8(*(const u32x4*)rp, bg); unpack8(*(const u32x4*)(rp + 512), c); unpack8(*(const u32x4*)(rp + 1024), x);
    unpack8(*(const u32x4*)(rpp + 512), a); unpack8(*(const u32x4*)(rpp + 1024), bq); unpack8(*(const u32x4*)(rpn + 512), a2); unpack8(*(const u32x4*)(rpn + 1024), b2);
#pragma unroll
    for (int j = 0; j < 8; ++j) o[j] = bg[j] * (cvb[c0 + j] + cvw[c0 + j] * (a[j] * bq[j] * fp) + cvw[512 + c0 + j] * (c[j] * x[j]) + cvw[1024 + c0 + j] * (a2[j] * b2[j] * fn));
    *(u32x4*)rp = pack8(o);
}
constexpr int SC_CH = 32;
constexpr int SC_ARR = SC_CH * 64;
constexpr int SC_R = 0, SC_W = 1, SC_KD = 2, SC_V = 3, SC_KK = 4, SC_KKA = 5, SC_ZK = 6, SC_NARR = 7;
constexpr int SC_SLOT = SC_NARR * SC_ARR;
constexpr int SC_TAB = 2 * SC_SLOT;
struct ScanW { const float *mu_prev, *mu_next, *w0, *a0, *k_k, *k_a, *r_k; const bf16_t *w2t, *a2t; };

__device__ __forceinline__ void scan_produce(LAS float* sl, LAS float* tab, const bf16_t* RWC, bf16_t* SG, float* SB, const ScanW& sw, const float* mu_gd_p, const float* mu_gd_n,
                                             int b, int h, int dir, int chunk, int sub, int lane) {
    asm volatile("" : "+v"(lane));
    const int tok = lane & 15, q = lane >> 4;
    const int tokidx = 16 * sub + tok;
    const int sc = chunk * SC_CH + tokidx;
    const int t = dir ? (SEQ - 1 - sc) : sc;
    const bf16_t* rp = RWC + ((size_t)b * SEQ + t) * LD_RWC;
    const bool hasp = t > 0, hasn = t < SEQ - 1;
    const bf16_t* rpp = hasp ? rp - LD_RWC : rp;
    const bf16_t* rpn = hasn ? rp + LD_RWC : rp;
    const float fp = hasp ? 1.f : 0.f, fn = hasn ? 1.f : 0.f;
    u32x4 Lc[6], Lp[6], Ln[6];
#pragma unroll
    for (int G = 0; G < 3; ++G)
#pragma unroll
        for (int hf = 0; hf < 2; ++hf) { const int cb = G * 512 + h * 64 + 16 * q + 8 * hf;
            Lc[2 * G + hf] = *(const u32x4*)(rp + cb); Lp[2 * G + hf] = *(const u32x4*)(rpp + cb); Ln[2 * G + hf] = *(const u32x4*)(rpn + cb); }
    u32x4 Mc[5], Mp[5], Mn[5];
#pragma unroll
    for (int i = 0; i < 5; ++i) { const int cb = (i < 4) ? (1536 + (i >> 1) * 128 + dir * 64 + 32 * (i & 1) + 8 * q) : (1792 + 8 * (2 * h + dir));
        Mc[i] = *(const u32x4*)(rp + cb); Mp[i] = *(const u32x4*)(rpp + cb); Mn[i] = *(const u32x4*)(rpn + cb); }
    float zk[16];
#pragma unroll
    for (int G = 0; G < 3; ++G) {
        float z[16];
#pragma unroll
        for (int hf = 0; hf < 2; ++hf) {
            float c[8], p[8], n[8];
            unpack8(Lc[2 * G + hf], c); unpack8(Lp[2 * G + hf], p); unpack8(Ln[2 * G + hf], n);
            const LAS float* mp = tab + G * 64 + 16 * q + 8 * hf; const LAS float* mn = mp + 320;
#pragma unroll
            for (int j = 0; j < 8; ++j) z[8 * hf + j] = c[j] + mp[j] * (p[j] * fp - c[j]) + mn[j] * (n[j] * fn - c[j]);
        }
        LAS float* dst = sl + (G == 0 ? SC_R : (G == 1 ? SC_ZK : SC_V)) * SC_ARR + tokidx * 64 + 16 * q;
#pragma unroll
        for (int j4 = 0; j4 < 4; ++j4) *(LAS f32x4*)(dst + 4 * j4) = (f32x4){z[4 * j4], z[4 * j4 + 1], z[4 * j4 + 2], z[4 * j4 + 3]};
        if (G == 1) {
#pragma unroll
            for (int j = 0; j < 16; ++j) zk[j] = z[j];
        }
    }
    {
        const LAS float* kkt = tab + 640 + 16 * q;
        float kr[16], ss = 0.f;
#pragma unroll
        for (int j = 0; j < 16; ++j) { kr[j] = zk[j] * kkt[j]; ss += kr[j] * kr[j]; }
        ss += __shfl_xor(ss, 16); ss += __shfl_xor(ss, 32);
        const float inv = 1.f / fmaxf(sqrtf(ss), 1e-12f);
        LAS float* dst = sl + SC_KK * SC_ARR + tokidx * 64 + 16 * q;
#pragma unroll
        for (int j4 = 0; j4 < 4; ++j4) *(LAS f32x4*)(dst + 4 * j4) = (f32x4){kr[4 * j4] * inv, kr[4 * j4 + 1] * inv, kr[4 * j4 + 2] * inv, kr[4 * j4 + 3] * inv};
    }
    bf16x8 Awd[2], Aad[2];
#pragma unroll
    for (int i = 0; i < 4; ++i) {
        const int G = 3 + (i >> 1), ks = i & 1;
        float c[8], p[8], n[8], z[8];
        unpack8(Mc[i], c); unpack8(Mp[i], p); unpack8(Mn[i], n);
        const LAS float* mp = tab + G * 64 + 32 * ks + 8 * q; const LAS float* mn = mp + 320;
#pragma unroll
        for (int j = 0; j < 8; ++j) { z[j] = c[j] + mp[j] * (p[j] * fp - c[j]) + mn[j] * (n[j] * fn - c[j]); if (G == 3) z[j] = tanh_f(z[j]); }
        const bf16x8 fr8 = __builtin_bit_cast(bf16x8, pack8(z));
        if (G == 3) Awd[ks] = fr8; else Aad[ks] = fr8;
    }
    if (q == 0) {
        const int cg8 = 8 * (2 * h + dir);
        float c[8], p[8], n[8], z[8];
        unpack8(Mc[4], c); unpack8(Mp[4], p); unpack8(Mn[4], n);
#pragma unroll
        for (int j = 0; j < 8; ++j) z[j] = sigmoid_f(c[j] + mu_gd_p[cg8 + j] * (p[j] * fp - c[j]) + mu_gd_n[cg8 + j] * (n[j] * fn - c[j]));
        *(u32x4*)(SG + ((size_t)b * SEQ + t) * 256 + cg8) = pack8(z);
    }
    asm volatile("s_waitcnt lgkmcnt(0)" ::: "memory");
    f32x4 aw[4], aa[4];
    float w0r[4], a0r[4], kar[4], rkr[4];
#pragma unroll
    for (int nb = 0; nb < 4; ++nb) {
        const int c = h * 64 + 16 * nb + (lane & 15);
        const bf16_t* wp = sw.w2t + ((size_t)(dir * 512 + c)) * 64 + 8 * (lane >> 4); const bf16_t* ap = sw.a2t + ((size_t)(dir * 512 + c)) * 64 + 8 * (lane >> 4);
        const bf16x8 bw0 = *(const bf16x8*)wp, bw1 = *(const bf16x8*)(wp + 32), ba0 = *(const bf16x8*)ap, ba1 = *(const bf16x8*)(ap + 32);
        w0r[nb] = sw.w0[dir * 512 + c]; a0r[nb] = sw.a0[dir * 512 + c]; kar[nb] = sw.k_a[c]; rkr[nb] = sw.r_k[c];
        aw[nb] = __builtin_amdgcn_mfma_f32_16x16x32_bf16(Awd[0], bw0, (f32x4){0.f, 0.f, 0.f, 0.f}, 0, 0, 0);
        aw[nb] = __builtin_amdgcn_mfma_f32_16x16x32_bf16(Awd[1], bw1, aw[nb], 0, 0, 0);
        aa[nb] = __builtin_amdgcn_mfma_f32_16x16x32_bf16(Aad[0], ba0, (f32x4){0.f, 0.f, 0.f, 0.f}, 0, 0, 0);
        aa[nb] = __builtin_amdgcn_mfma_f32_16x16x32_bf16(Aad[1], ba1, aa[nb], 0, 0, 0);
    }
    float bon[4] = {0.f, 0.f, 0.f, 0.f};
#pragma unroll
    for (int nb = 0; nb < 4; ++nb)
#pragma unroll
        for (int rg = 0; rg < 4; ++rg) {
            const int ti = 16 * sub + 4 * q + rg, c = 16 * nb + (lane & 15), o = ti * 64 + c;
            const float dec = trans_settle(__builtin_amdgcn_exp2f(-0.6065306597126334f * LOG2E * sigmoid_f(aw[nb][rg] + w0r[nb])));
            const float a = sigmoid_f(aa[nb][rg] + a0r[nb]);
            const float zkv = sl[SC_ZK * SC_ARR + o], kkv = sl[SC_KK * SC_ARR + o], rv = sl[SC_R * SC_ARR + o];
            const float kd = zkv * (1.f + (a - 1.f) * kar[nb]);
            sl[SC_W * SC_ARR + o] = dec; sl[SC_KD * SC_ARR + o] = kd; sl[SC_KKA * SC_ARR + o] = kkv * a;
            bon[rg] += rv * kd * rkr[nb];
        }
#pragma unroll
    for (int rg = 0; rg < 4; ++rg) {
        const float s = red16(bon[rg]);
        if ((lane & 15) == 0) { const int sc2 = chunk * SC_CH + 16 * sub + 4 * q + rg; const int t2 = dir ? (SEQ - 1 - sc2) : sc2;
            SB[((size_t)dir * T + (size_t)b * SEQ + t2) * 8 + h] = s; }
    }
}

__device__ __forceinline__ void scan_unit(LAS unsigned char* lds, const bf16_t* RWC, bf16_t* YF, bf16_t* YB, bf16_t* SG, float* SB, const ScanW& sw, int b, int h, int dir,
                                          bf16_t* C2cv, const float* cvw, const float* cvb, int unit) {
    int tid = threadIdx.x; asm volatile("" : "+v"(tid));
    const int lane = tid & 63, wid = __builtin_amdgcn_readfirstlane(tid >> 6);
    LAS float* fl = (LAS float*)lds;
    LAS float* tab = fl + SC_TAB;
    for (int i = tid; i < 704; i += 512) {
        float v;
        if (i < 640) { const int pn = i / 320, r = i % 320, G = r / 64, ch = r % 64;
            const int col = (G < 3) ? (G * 512 + h * 64 + ch) : (1536 + (G - 3) * 128 + dir * 64 + ch);
            v = (pn ? sw.mu_next : sw.mu_prev)[col]; }
        else v = sw.k_k[h * 64 + (i - 640)];
        tab[i] = v;
    }
    __syncthreads();
    if (wid >= 4 && wid < 6) scan_produce(fl, tab, RWC, SG, SB, sw, sw.mu_prev + 1792, sw.mu_next + 1792, b, h, dir, 0, wid - 4, lane);
    __syncthreads();
    const int vp = tid >> 3, kq = tid & 7;
    f32x2 S0[4], S1[4];
#pragma unroll
    for (int i = 0; i < 4; ++i) { S0[i] = (f32x2){0.f, 0.f}; S1[i] = (f32x2){0.f, 0.f}; }
    bf16_t* Y = dir ? YB : YF;
    for (int ch = 0; ch < SEQ / SC_CH; ++ch) {
        LAS float* sl = fl + (ch & 1) * SC_SLOT;
        if (wid < 4) {
            const LAS float* base = sl + 8 * kq;
            const LAS float* vbase = sl + SC_V * SC_ARR + 2 * vp;
            f32x4 nkk0, nkk1, nw0, nw1, nka0, nka1, nkd0, nkd1, nr0, nr1; f32x2 nvv;
#define SC_LOAD(s_) do { const LAS float* p_ = base + (s_) * 64; \
                nkk0 = *(const LAS f32x4*)(p_ + SC_KK * SC_ARR); nkk1 = *(const LAS f32x4*)(p_ + SC_KK * SC_ARR + 4); \
                nw0 = *(const LAS f32x4*)(p_ + SC_W * SC_ARR); nw1 = *(const LAS f32x4*)(p_ + SC_W * SC_ARR + 4); \
                nka0 = *(const LAS f32x4*)(p_ + SC_KKA * SC_ARR); nka1 = *(const LAS f32x4*)(p_ + SC_KKA * SC_ARR + 4); \
                nkd0 = *(const LAS f32x4*)(p_ + SC_KD * SC_ARR); nkd1 = *(const LAS f32x4*)(p_ + SC_KD * SC_ARR + 4); \
                nr0 = *(const LAS f32x4*)(p_ + SC_R * SC_ARR); nr1 = *(const LAS f32x4*)(p_ + SC_R * SC_ARR + 4); \
                nvv = *(const LAS f32x2*)(vbase + (s_) * 64); } while (0)
            SC_LOAD(0);
#pragma unroll 2
            for (int s = 0; s < SC_CH; ++s) {
                f32x2 kk[4], w[4], ka[4], kd[4], r[4];
                kk[0] = nkk0.xy; kk[1] = nkk0.zw; kk[2] = nkk1.xy; kk[3] = nkk1.zw;
                w[0] = nw0.xy; w[1] = nw0.zw; w[2] = nw1.xy; w[3] = nw1.zw;
                ka[0] = nka0.xy; ka[1] = nka0.zw; ka[2] = nka1.xy; ka[3] = nka1.zw;
                kd[0] = nkd0.xy; kd[1] = nkd0.zw; kd[2] = nkd1.xy; kd[3] = nkd1.zw;
                r[0] = nr0.xy; r[1] = nr0.zw; r[2] = nr1.xy; r[3] = nr1.zw;
                const f32x2 vv = nvv;
                SC_LOAD((s + 1) & (SC_CH - 1));
                f32x2 t0 = S0[0] * kk[0], t1 = S1[0] * kk[0];
#pragma unroll
                for (int i = 1; i < 4; ++i) { t0 = S0[i] * kk[i] + t0; t1 = S1[i] * kk[i] + t1; }
                const float sa0 = red8(t0.x + t0.y), sa1 = red8(t1.x + t1.y);
                const f32x2 n0 = (f32x2){-sa0, -sa0}, n1 = (f32x2){-sa1, -sa1}, v0 = (f32x2){vv.x, vv.x}, v1 = (f32x2){vv.y, vv.y};
                f32x2 y0 = (f32x2){0.f, 0.f}, y1 = (f32x2){0.f, 0.f};
#pragma unroll
                for (int i = 0; i < 4; ++i) {
                    S0[i] = S0[i] * w[i] + (v0 * kd[i] + n0 * ka[i]);
                    S1[i] = S1[i] * w[i] + (v1 * kd[i] + n1 * ka[i]);
                    y0 = S0[i] * r[i] + y0; y1 = S1[i] * r[i] + y1;
                }
                float yp0 = y0.x + y0.y, yp1 = y1.x + y1.y; asm volatile("" : "+v"(yp0));
                const float ys0 = red8(yp0), ys1 = red8(yp1);
                if (kq == 0) { const int sc = ch * SC_CH + s; const int t = dir ? (SEQ - 1 - sc) : sc;
                    *(unsigned*)(Y + ((size_t)b * SEQ + t) * 512 + h * 64 + 2 * vp) = cvt_pk_bf16(ys0, ys1); }
            }
#undef SC_LOAD
        } else if (wid < 6) {
            if (ch + 1 < SEQ / SC_CH) scan_produce(fl + ((ch + 1) & 1) * SC_SLOT, tab, RWC, SG, SB, sw, sw.mu_prev + 1792, sw.mu_next + 1792, b, h, dir, ch + 1, wid - 4, lane);
        } else {
            conv_item(C2cv, cvw, cvb, unit * 16384 + ch * 128 + (tid - 384));
        }
        __syncthreads();
    }
}


#define XB_TMO      128
#define XB_XCNT(j)  (256  + 64 * (j))
#define XB_XSUB(j)  (1280 + 64 * (j))
#define XB_XGEN(j)  (2304 + 64 * (j))
#define XB_TOP      3328
#define XB_TOPGEN   3392
#define XB_SPIN_CAP (1u << 22)
__device__ __forceinline__ unsigned xb_ld(unsigned* p)              { return __hip_atomic_load(p, __ATOMIC_RELAXED, __HIP_MEMORY_SCOPE_AGENT); }
__device__ __forceinline__ unsigned xb_add(unsigned* p, unsigned v) { return __hip_atomic_fetch_add(p, v, __ATOMIC_RELAXED, __HIP_MEMORY_SCOPE_AGENT); }
__device__ __forceinline__ unsigned xb_xcc_id() { return (unsigned)__builtin_amdgcn_s_getreg((3 << 11) | 20) & 0xFu; }
#define XB_SPIN(cond, bar) do { unsigned _sp = 0; while (cond) { __builtin_amdgcn_s_sleep(1); \
    if ((++_sp & 255u) == 0u) { if (xb_ld(&(bar)[XB_TMO])) break; if (_sp > XB_SPIN_CAP) { atomicAdd(&(bar)[XB_TMO], 1u); break; } } } } while (0)
struct XcdBarrier { unsigned* bar; unsigned x; volatile LAS unsigned* st; };
__device__ __forceinline__ XcdBarrier xcd_barrier_post(unsigned* bar, volatile LAS unsigned* st) {
    XcdBarrier b; b.bar = bar; b.x = xb_xcc_id(); b.st = st;
    if (threadIdx.x == 0) (void)xb_add(&bar[XB_XCNT(b.x)], 1u);
    return b;
}
__device__ __forceinline__ void xcd_barrier_complete(unsigned* bar, unsigned x, unsigned& nloc, unsigned& nx) {
    const unsigned G = gridDim.x * gridDim.y * gridDim.z;
    unsigned sum, cnt, mine, sp = 0u;
    for (;;) {
        sum = 0u; cnt = 0u; mine = 0u;
#pragma unroll
        for (unsigned j = 0; j < 16; ++j) { const unsigned c = xb_ld(&bar[XB_XCNT(j)]); sum += c; cnt += (c > 0u) ? 1u : 0u; mine = (j == x) ? c : mine; }
        if (sum == G) break;
        __builtin_amdgcn_s_sleep(1);
        if ((++sp & 255u) == 0u) { if (xb_ld(&bar[XB_TMO])) break; if (sp > XB_SPIN_CAP) { atomicAdd(&bar[XB_TMO], 1u); break; } }
    }
    nloc = mine > 0u ? mine : 1u; nx = cnt > 0u ? cnt : 1u;
}
__device__ __forceinline__ void xcd_barrier(const XcdBarrier& b) {
    asm volatile("s_waitcnt vmcnt(0)" ::: "memory");
    __syncthreads();
    if (threadIdx.x == 0) {
        unsigned* bar = b.bar;
        __builtin_amdgcn_s_waitcnt(0);
        unsigned nloc = b.st[0], nx = b.st[1];
        if (nloc == 0u) { xcd_barrier_complete(bar, b.x, nloc, nx); b.st[0] = nloc; b.st[1] = nx; }
        const unsigned old = xb_add(&bar[XB_XSUB(b.x)], 1u);
        const unsigned gen = old / nloc;
        if (old + 1u == (gen + 1u) * nloc) {
            __builtin_amdgcn_fence(__ATOMIC_RELEASE, "agent");
            asm volatile("s_waitcnt vmcnt(0)" ::: "memory");
            const unsigned og = xb_add(&bar[XB_TOP], 1u);
            const unsigned tg = og / nx;
            if (og + 1u == (tg + 1u) * nx) xb_add(&bar[XB_TOPGEN], 1u);
            else XB_SPIN(xb_ld(&bar[XB_TOPGEN]) == tg, bar);
            __builtin_amdgcn_fence(__ATOMIC_ACQUIRE, "agent");
            xb_add(&bar[XB_XGEN(b.x)], 1u);
            asm volatile("s_waitcnt vmcnt(0)" ::: "memory");
        } else {
            XB_SPIN(xb_ld(&bar[XB_XGEN(b.x)]) == gen, bar);
            __builtin_amdgcn_fence(__ATOMIC_ACQUIRE, "agent");
            asm volatile("s_waitcnt vmcnt(0)" ::: "memory");
        }
    }
    __syncthreads();
}

#ifdef MK_DBG_STOP
#define DBG_STOP(k) do { if ((k) == MK_DBG_STOP && l == 0) { dbg_dump(p, ws0, bx * 512 + (int)threadIdx.x, G * 512); return; } } while (0)
__device__ __noinline__ void dbg_dump(const Params& p, unsigned char* ws, int gtid, int NGT) {
    const bf16_t* rwc = (const bf16_t*)(ws + WS_RWC); const bf16_t* c2 = (const bf16_t*)(ws + WS_C2); const bf16_t* yf = (const bf16_t*)(ws + WS_YF); const bf16_t* yb = (const bf16_t*)(ws + WS_YB);
    const bf16_t* sg = (const bf16_t*)(ws + WS_SG); const float* sb = (const float*)(ws + WS_SB); const bf16_t* hb = (const bf16_t*)(ws + WS_H);
    for (size_t i = gtid; i < (size_t)T * 1024; i += NGT) {
        const size_t m = i >> 10; const int c = (int)(i & 1023);
        float v = 0.f;
#if MK_DBG_WHAT == 0
        v = bflo(rwc[m * 2048 + 2 * c]) + bflo(rwc[m * 2048 + 2 * c + 1]);
#elif MK_DBG_WHAT == 1
        v = bflo(c2[m * 2304 + 2 * c]) + bflo(c2[m * 2304 + 2 * c + 1]) + (c < 256 ? bflo(c2[m * 2304 + 2048 + c]) : 0.f);
#elif MK_DBG_WHAT == 2
        v = (c < 512 ? bflo(yf[m * 512 + c]) : bflo(yb[m * 512 + c - 512]));
#elif MK_DBG_WHAT == 3
        v = (c < 256 ? bflo(sg[m * 256 + c]) : (c < 272 ? sb[((c - 256) >> 3) * (size_t)T * 8 + m * 8 + (c & 7)] : bflo(hb[m * 1024 + c])));
#elif MK_DBG_WHAT == 6
        v = bflo(((const bf16_t*)(ws + WS_WIN))[(size_t)(4352 + (m % 3072)) * 1024 + c]) + bflo(hb[m * 1024 + c]);
#elif MK_DBG_WHAT == 5
        v = bflo(((const bf16_t*)(ws + WS_GT))[m * 1024 + c]);
#elif MK_DBG_WHAT == 4
        v = bflo(rwc[(size_t)T * 1024 + m * 1024 + c]);
#endif
        p.out[i] = v;
    }
}
#else
#define DBG_STOP(k) do { } while (0)
#endif

#define L1_REFRESH() do { asm volatile("s_waitcnt vmcnt(0)" ::: "memory"); __builtin_amdgcn_fence(__ATOMIC_ACQUIRE, "agent"); asm volatile("s_waitcnt vmcnt(0)" ::: "memory"); } while (0)
#define PHASE_IDS() int tid = threadIdx.x; asm volatile("" : "+v"(tid)); const int lane = tid & 63, wave = __builtin_amdgcn_readfirstlane(tid >> 6); const int gw = vcu * 8 + wave, gtid = bx * 512 + tid; (void)lane; (void)gw; (void)gtid
#define Win_t ((bf16_t*)(ws + WS_WIN))
#define Wbr_t ((bf16_t*)(ws + WS_WBR))
#define Wout_t ((bf16_t*)(ws + WS_WOUT))
#define W1_t ((bf16_t*)(ws + WS_W1))
#define W2_t ((bf16_t*)(ws + WS_W2))
#define w2t ((bf16_t*)(ws + WS_W2T))
#define a2t ((bf16_t*)(ws + WS_A2T))
#define g2t ((bf16_t*)(ws + WS_G2T))
#define Hb ((bf16_t*)(ws + WS_H))
#define RWC ((bf16_t*)(ws + WS_RWC))
#define C2 ((bf16_t*)(ws + WS_C2))
#define YF ((bf16_t*)(ws + WS_YF))
#define YB ((bf16_t*)(ws + WS_YB))
#define SG ((bf16_t*)(ws + WS_SG))
#define VT ((bf16_t*)(ws + WS_VT))
#define SB ((float*)(ws + WS_SB))
#define Gt ((bf16_t*)(ws + WS_GT))
#define Mg ((bf16_t*)(ws + WS_MRG))
#define Ub ((bf16_t*)(ws + WS_U))
__global__ void __launch_bounds__(512, 2) fwd_megakernel(Params p) {
    extern __shared__ __attribute__((aligned(16))) unsigned char lds_raw[];
    LAS unsigned char* lds = (LAS unsigned char*)lds_raw;
    cg::grid_group grid = cg::this_grid();
    volatile LAS unsigned* misc = (volatile LAS unsigned*)(lds + 133120);
    if (threadIdx.x < 16) misc[threadIdx.x] = 0u;
    __syncthreads();
    XcdBarrier xbar = xcd_barrier_post((unsigned*)(p.ws + 65536), misc);
    grid.sync();
    const int G = gridDim.x, bx = blockIdx.x;
    const int vcu = (G % 8 == 0) ? (bx % 8) * (G / 8) + bx / 8 : bx;
    const int NGW = G * 8, NGT = G * 512;
    float* X = p.out;

    for (int l = 0; l < DEPTH; ++l) {
        const float* xin = (l == 0) ? p.in[0] : X;
        unsigned char* ws0 = p.ws; asm volatile("" : "+s"(ws0));
        GAS unsigned char* ws = (GAS unsigned char*)ws0;
        if (PHMASK & (1u << 0)) {
            PHASE_IDS();
            LAS float* scr = (LAS float*)(lds + wave * 8448);
            const float* w_in = p.in[2] + (size_t)l * D_MODEL * IN_COLS;
            const float* w_br = p.in[19] + (size_t)l * 3 * 512 * D_MODEL;
            const float* w_out = p.in[20] + (size_t)l * D_MODEL * D_MODEL;
            const float* w_m1 = p.in[22] + (size_t)l * D_MODEL * D_FF;
            const float* w_m2 = p.in[23] + (size_t)l * D_FF * D_MODEL;
            const float* rw_w2 = p.in[6] + (size_t)l * 2 * 64 * 512;
            const float* rw_a2 = p.in[8] + (size_t)l * 2 * 64 * 512;
            const float* rw_g2 = p.in[9] + (size_t)l * 128 * 512;
            constexpr int I_IN = 232 * 16, I_BR = 3 * 8 * 32, I_OUT = 16 * 32, I_M1 = 16 * 128, I_M2 = 64 * 32, I_L = 32, I_G = 32;
            constexpr int NITEMS = I_IN + I_BR + I_OUT + I_M1 + I_M2 + 2 * I_L + I_G;
            for (int it = gw; it < NITEMS; it += NGW) {
                int r = it;
                if (r < I_IN) { const int db = r % 232, kb = r / 232; int src;
                    if (db < 60) src = 32 * db;
                    else if (db < 64) {
                        const int c = lane & 7;
#pragma unroll
                        for (int j = 0; j < 4; ++j) { const int n = (lane >> 3) + 8 * j; *(u32x4*)(Win_t + (size_t)(32 * db + n) * D_MODEL + 64 * kb + 8 * c) = (u32x4){0u, 0u, 0u, 0u}; }
                        continue; }
                    else if (db < 112) src = 1920 + 32 * (db - 64);
                    else if (db < 136) { const int pp = 32 * (db - 112), tile = pp >> 8, c = pp & 255, bj = c >> 7, wc = (c & 127) >> 5; src = 3456 + tile * 256 + 64 * wc + 32 * bj; }
                    else src = 4224 + 32 * (db - 136);
                    transpose_item(w_in, IN_COLS, 64 * kb, src, Win_t, D_MODEL, 32 * db, scr, lane); continue; }
                r -= I_IN;
                if (r < I_BR) { const int bb = r / 256, q = r % 256, kb = q / 32, nb = q % 32;
                    transpose_item(w_br + (size_t)bb * 512 * D_MODEL, D_MODEL, 64 * kb, 32 * nb, Wbr_t + (size_t)bb * D_MODEL * 512, 512, 32 * nb, scr, lane); continue; }
                r -= I_BR;
                if (r < I_OUT) { transpose_item(w_out, D_MODEL, 64 * (r / 32), 32 * (r % 32), Wout_t, D_MODEL, 32 * (r % 32), scr, lane); continue; }
                r -= I_OUT;
                if (r < I_M1) { transpose_item(w_m1, D_FF, 64 * (r / 128), 32 * (r % 128), W1_t, D_MODEL, 32 * (r % 128), scr, lane); continue; }
                r -= I_M1;
                if (r < I_M2) { transpose_item(w_m2, D_MODEL, 64 * (r / 32), 32 * (r % 32), W2_t, D_FF, 32 * (r % 32), scr, lane); continue; }
                r -= I_M2;
                if (r < I_L) { const int dd = r / 16, nb = r % 16; transpose_item(rw_w2 + (size_t)dd * 64 * 512, 512, 0, 32 * nb, w2t + (size_t)dd * 512 * 64, 64, 32 * nb, scr, lane); continue; }
                r -= I_L;
                if (r < I_L) { const int dd = r / 16, nb = r % 16; transpose_item(rw_a2 + (size_t)dd * 64 * 512, 512, 0, 32 * nb, a2t + (size_t)dd * 512 * 64, 64, 32 * nb, scr, lane); continue; }
                r -= I_L;
                { const int kb = r / 16, nb = r % 16; transpose_item(rw_g2, 512, 64 * kb, 32 * nb, g2t, 256, 32 * nb, scr, lane); }
            }
            for (int i = gtid; i < 512 * 16; i += NGT) *(u32x4*)(g2t + (size_t)(i >> 4) * 256 + 128 + 8 * (i & 15)) = (u32x4){0u, 0u, 0u, 0u};
            if (l == 0) for (int i = gtid; i < T * 16; i += NGT) *(u32x4*)(SG + (size_t)(i >> 4) * 256 + 128 + 8 * (i & 15)) = (u32x4){0u, 0u, 0u, 0u};
            const float* g1 = p.in[1] + (size_t)l * D_MODEL;
            if (T % (2 * NGW) == 0) { for (int m = gw; m < T; m += 2 * NGW) rms_row2(xin + (size_t)m * D_MODEL, xin + (size_t)(m + NGW) * D_MODEL, g1, Hb + (size_t)m * D_MODEL, Hb + (size_t)(m + NGW) * D_MODEL, lane); }
            else { for (int m = gw; m < T; m += NGW) rms_row(xin + (size_t)m * D_MODEL, g1, Hb + (size_t)m * D_MODEL, lane); }
        }
        xcd_barrier(xbar);
        DBG_STOP(1);
        if (PHMASK & (1u << 1)) {
            pg8::StaticOrder S;
#ifndef SKIP_P2A
            { pg8::Gemm g{Hb, Win_t, T, 3584, D_MODEL, D_MODEL}; S.init(T, 3584, G, bx);
              pg8::EpiStore<0> E{RWC, LD_RWC, C2, LD_C2, 8}; pg8::gemm_phase(lds, g, S, E); }
#endif
#ifndef SKIP_P2B
            { pg8::Gemm g{Hb, Win_t + (size_t)3584 * D_MODEL, T, 768, D_MODEL, D_MODEL}; S.init(T, 768, G, bx);
              pg8::EpiAttn E{C2, VT, p.in[17] + l * 64, p.in[18] + l * 64}; pg8::gemm_phase(lds, g, S, E); }
#endif
        }
        xcd_barrier(xbar);
        DBG_STOP(2);
        if (PHMASK & (1u << 2)) {
            PHASE_IDS();
            const float* cvw = p.in[15] + (size_t)l * 3 * 512; const float* cvb = p.in[16] + (size_t)l * 512;
            ScanW sw{p.in[3] + (size_t)l * RW_COLS, p.in[4] + (size_t)l * RW_COLS, p.in[5] + (size_t)l * 1024, p.in[7] + (size_t)l * 1024,
                     p.in[10] + (size_t)l * 512, p.in[11] + (size_t)l * 512, p.in[12] + (size_t)l * 512, w2t, a2t};
#ifndef SKIP_SCAN
#ifdef MK_DUP_SCAN
            for (int u = vcu; u < 256; u += G) { scan_unit(lds, RWC, YF, YB, SG, SB, sw, u >> 4, (u >> 1) & 7, u & 1, C2, cvw, cvb, u); __syncthreads(); }
#endif
            for (int u = vcu; u < 256; u += G) { scan_unit(lds, RWC, YF, YB, SG, SB, sw, u >> 4, (u >> 1) & 7, u & 1, C2, cvw, cvb, u); __syncthreads(); }
#endif
#ifndef SKIP_ATTN
#ifdef MK_DUP_ATTN
            for (int u = vcu; u < 1024; u += G) { attn_unit(lds, C2, (bf16_t*)(ws + 892 * MiB), u >> 6, (u >> 5) & 1, u & 31); }
#endif
            for (int u = vcu; u < 1024; u += G) { attn_unit(lds, C2, nullptr, u >> 6, (u >> 5) & 1, u & 31); }
#endif
        }
        xcd_barrier(xbar);
        DBG_STOP(3);
        if (PHMASK & (1u << 3)) {
            PHASE_IDS();
            const float* mup = p.in[3] + (size_t)l * RW_COLS + 1024; const float* mun = p.in[4] + (size_t)l * RW_COLS + 1024;
            const float* lng = p.in[13] + (size_t)l * 512; const float* lnb = p.in[14] + (size_t)l * 512;
            for (int m = gw; m < T; m += NGW) {
                const int t = m & 4095, c0 = 8 * lane, hh = lane >> 3;
                float yf[8], yb[8], vc[8], vpv[8], vn[8], y[8];
                unpack8(*(const u32x4*)(YF + (size_t)m * 512 + c0), yf); unpack8(*(const u32x4*)(YB + (size_t)m * 512 + c0), yb);
                const bf16_t* rp = RWC + (size_t)m * LD_RWC + 1024 + c0;
                unpack8(*(const u32x4*)rp, vc);
                if (t > 0) unpack8(*(const u32x4*)(rp - LD_RWC), vpv); else {
#pragma unroll
                    for (int j = 0; j < 8; ++j) vpv[j] = 0.f; }
                if (t < SEQ - 1) unpack8(*(const u32x4*)(rp + LD_RWC), vn); else {
#pragma unroll
                    for (int j = 0; j < 8; ++j) vn[j] = 0.f; }
                float s = 0.f;
#pragma unroll
                for (int j = 0; j < 8; ++j) { y[j] = yf[j] + yb[j]; s += y[j]; }
                const float mean = red8(s) * (1.f / 64.f);
                float q = 0.f;
#pragma unroll
                for (int j = 0; j < 8; ++j) { y[j] -= mean; q += y[j] * y[j]; }
                const float rstd = __builtin_amdgcn_rsqf(red8(q) * (1.f / 64.f) + 64e-5f);
                const float bs = 0.5f * (SB[(size_t)m * 8 + hh] + SB[((size_t)T + m) * 8 + hh]);
                float o[8];
#pragma unroll
                for (int j = 0; j < 8; ++j) { const float zv = vc[j] + mup[c0 + j] * (vpv[j] - vc[j]) + mun[c0 + j] * (vn[j] - vc[j]);
                    o[j] = y[j] * rstd * lng[c0 + j] + lnb[c0 + j] + bs * zv; }
                *(u32x4*)(YF + (size_t)m * 512 + c0) = pack8(o);
            }
        }
        xcd_barrier(xbar);
        DBG_STOP(4);
        if (PHMASK & (1u << 4)) {
            pg8::StaticOrder S; pg8::Gemm g{SG, g2t, T, 512, 256, 256}; S.init(T, 512, G, bx);
            pg8::EpiMulInPlace E{YF, 512}; pg8::gemm_phase(lds, g, S, E);
        }
        xcd_barrier(xbar);
        DBG_STOP(5);
        if (PHMASK & (1u << 5)) {
            pg8::StaticOrder S; S.init(T, 1024, G, bx);
            const bf16_t* Wg = Win_t + (size_t)4352 * D_MODEL;
            if (P4_CALLS >= 1)
            { pg8::Gemm g{Hb, Wg, T, 1024, D_MODEL, D_MODEL}; pg8::EpiStore<MK_GATE_ACT> E{Gt, D_MODEL, Gt, D_MODEL, 1 << 20}; pg8::gemm_phase(lds, g, S, E); }
            L1_REFRESH();
            if (P4_CALLS >= 2)
            { pg8::Gemm g{YF, Wbr_t, T, 1024, 512, 512}; pg8::EpiBranch<true> E{Gt, Mg}; pg8::gemm_phase(lds, g, S, E); }
            if (P4_CALLS >= 3)
            { pg8::Gemm g{Hb, Wg + (size_t)1024 * D_MODEL, T, 1024, D_MODEL, D_MODEL}; pg8::EpiStore<1> E{Gt, D_MODEL, Gt, D_MODEL, 1 << 20}; pg8::gemm_phase(lds, g, S, E); }
            L1_REFRESH();
            if (P4_CALLS >= 4)
            { pg8::Gemm g{C2, Wbr_t + (size_t)1024 * 512, T, 1024, 512, LD_C2}; pg8::EpiBranch<false> E{Gt, Mg}; pg8::gemm_phase(lds, g, S, E); }
            if (P4_CALLS >= 5)
            { pg8::Gemm g{Hb, Wg + (size_t)2048 * D_MODEL, T, 1024, D_MODEL, D_MODEL}; pg8::EpiStore<1> E{Gt, D_MODEL, Gt, D_MODEL, 1 << 20}; pg8::gemm_phase(lds, g, S, E); }
            L1_REFRESH();
            if (P4_CALLS >= 6)
            { pg8::Gemm g{C2 + 1536, Wbr_t + (size_t)2048 * 512, T, 1024, 512, LD_C2}; pg8::EpiBranch<false> E{Gt, Mg}; pg8::gemm_phase(lds, g, S, E); }
        }
        xcd_barrier(xbar);
        DBG_STOP(6);
        if (PHMASK & (1u << 6)) {
            pg8::StaticOrder S; S.init(T, 1024, G, bx);
            pg8::Gemm g{Mg, Wout_t, T, 1024, D_MODEL, D_MODEL}; pg8::EpiResidual E{xin, X}; pg8::gemm_phase(lds, g, S, E);
        }
        xcd_barrier(xbar);
        DBG_STOP(7);
        if (PHMASK & (1u << 7)) {
            PHASE_IDS();
            const float* g2 = p.in[21] + (size_t)l * D_MODEL;
            if (T % (2 * NGW) == 0) { for (int m = gw; m < T; m += 2 * NGW) rms_row2(X + (size_t)m * D_MODEL, X + (size_t)(m + NGW) * D_MODEL, g2, Hb + (size_t)m * D_MODEL, Hb + (size_t)(m + NGW) * D_MODEL, lane); }
            else { for (int m = gw; m < T; m += NGW) rms_row(X + (size_t)m * D_MODEL, g2, Hb + (size_t)m * D_MODEL, lane); }
        }
        xcd_barrier(xbar);
        DBG_STOP(8);
        if (PHMASK & (1u << 8)) {
            pg8::StaticOrder S; S.init(T, D_FF, G, bx);
            pg8::Gemm g{Hb, W1_t, T, D_FF, D_MODEL, D_MODEL}; pg8::EpiStore<2> E{Ub, D_FF, Ub, D_FF, 1 << 20}; pg8::gemm_phase(lds, g, S, E);
#ifdef MK_DUP_P7
            pg8::gemm_phase(lds, g, S, E);
#endif
        }
        xcd_barrier(xbar);
        DBG_STOP(9);
        if (PHMASK & (1u << 9)) {
            pg8::StaticOrder S; S.init(T, 1024, G, bx);
            pg8::Gemm g{Ub, W2_t, T, 1024, D_FF, D_FF}; pg8::EpiResidual E{X, X}; pg8::gemm_phase(lds, g, S, E);
        }
        xcd_barrier(xbar);
        DBG_STOP(10);
    }
}

extern "C" void kernel_launch(void* const* d_in, const int* in_sizes, int n_in, void* d_out, int out_size, void* d_ws, size_t ws_size, hipStream_t stream) {
    static int grid = 0;
    if (grid == 0) {
        if (n_in != 24 || out_size != T * D_MODEL || ws_size < WS_END) { fprintf(stderr, "kernel_launch: unexpected shapes (n_in %d out %d ws %zu)\n", n_in, out_size, ws_size); grid = -1; return; }
        int dev = 0, cus = 0, per_cu = 0;
        hipGetDevice(&dev);
        hipDeviceGetAttribute(&cus, hipDeviceAttributeMultiprocessorCount, dev);
        hipFuncSetAttribute((const void*)fwd_megakernel, hipFuncAttributeMaxDynamicSharedMemorySize, LDS_BYTES);
        hipOccupancyMaxActiveBlocksPerMultiprocessor(&per_cu, (const void*)fwd_megakernel, 512, LDS_BYTES);
        if (per_cu < 1) { fprintf(stderr, "kernel_launch: occupancy query says %d blocks per CU\n", per_cu); per_cu = 1; }
        (void)hipGetLastError();
        grid = cus;
    }
    if (grid < 0) return;
    if (hipMemsetAsync(d_ws, 0, 1u << 20, stream) != hipSuccess) { fprintf(stderr, "kernel_launch: memset failed\n"); return; }
    Params p{};
    for (int i = 0; i < 24; ++i) p.in[i] = (const float*)d_in[i];
    p.out = (float*)d_out; p.ws = (unsigned char*)d_ws;
    void* args[] = {&p};
    hipError_t e = hipLaunchCooperativeKernel((const void*)fwd_megakernel, dim3(grid), dim3(512), args, LDS_BYTES, stream);
    if (e != hipSuccess) fprintf(stderr, "cooperative launch failed: %s (grid %d)\n", hipGetErrorString(e), grid);
}
```

```cpp
#include <hip/hip_runtime.h>
#include <hip/hip_cooperative_groups.h>
#include <cstdio>
#include <cstdint>
namespace cg = cooperative_groups;

#define LAS __attribute__((address_space(3)))
#define GAS __attribute__((address_space(1)))
typedef unsigned short bf16_t;
typedef short bf16x8 __attribute__((ext_vector_type(8)));
typedef short bf16x4 __attribute__((ext_vector_type(4)));
typedef float f32x2 __attribute__((ext_vector_type(2)));
typedef float f32x4 __attribute__((ext_vector_type(4)));
typedef float f32x16 __attribute__((ext_vector_type(16)));
typedef unsigned u32x2 __attribute__((ext_vector_type(2)));
typedef unsigned u32x4 __attribute__((ext_vector_type(4)));

constexpr int D_MODEL = 1024, BATCH = 16, SEQ = 4096, DEPTH = 4, D_FF = 4096;
constexpr int T = BATCH * SEQ;
constexpr int IN_COLS = 7296, RW_COLS = 1920;
constexpr int NWIN = 7424;
constexpr int LD_RWC = 2048, LD_C2 = 2304;
constexpr float LOG2E = 1.4426950408889634f;

constexpr size_t MiB = 1u << 20;
constexpr size_t WS_WIN = 2 * MiB, WS_WBR = 17 * MiB, WS_WOUT = 20 * MiB, WS_W1 = 22 * MiB, WS_W2 = 30 * MiB;
constexpr size_t WS_W2T = 38 * MiB, WS_A2T = 38 * MiB + 131072, WS_G2T = 38 * MiB + 262144;
constexpr size_t WS_H = 40 * MiB, WS_RWC = 168 * MiB, WS_C2 = 424 * MiB, WS_YF = 712 * MiB, WS_YB = 776 * MiB;
constexpr size_t WS_SG = 840 * MiB, WS_VT = 872 * MiB, WS_SB = 888 * MiB, WS_END = 892 * MiB;
#ifdef MK_GT_FRESH
constexpr size_t WS_GT = 892 * MiB;
#else
constexpr size_t WS_GT = WS_RWC;
#endif
constexpr size_t WS_MRG = WS_RWC + 128 * MiB, WS_U = WS_RWC;

#ifndef MK_GATE_ACT
#define MK_GATE_ACT 1
#endif
#ifndef MK_P4_CALLS
#define MK_P4_CALLS 6
#endif
constexpr int P4_CALLS = MK_P4_CALLS;
#ifndef MK_PHMASK
#define MK_PHMASK 0xffffffffu
#endif
constexpr unsigned PHMASK = MK_PHMASK;
constexpr int LDS_BYTES = 140288;

typedef __bf16 bf16x2_t __attribute__((ext_vector_type(2)));
__device__ __forceinline__ unsigned cvt_pk_bf16(float lo, float hi) { const f32x2 v = {lo, hi}; const bf16x2_t b = __builtin_convertvector(v, bf16x2_t); return __builtin_bit_cast(unsigned, b); }
__device__ __forceinline__ bf16_t f2bf(float f) { return (bf16_t)(cvt_pk_bf16(f, 0.f) & 0xffffu); }
__device__ __forceinline__ float bflo(unsigned u) { return __builtin_bit_cast(float, u << 16); }
__device__ __forceinline__ float bfhi(unsigned u) { return __builtin_bit_cast(float, u & 0xffff0000u); }
__device__ __forceinline__ void unpack8(const u32x4 v, float* f) { f[0] = bflo(v.x); f[1] = bfhi(v.x); f[2] = bflo(v.y); f[3] = bfhi(v.y); f[4] = bflo(v.z); f[5] = bfhi(v.z); f[6] = bflo(v.w); f[7] = bfhi(v.w); }
__device__ __forceinline__ u32x4 pack8(const float* f) { u32x4 w; w.x = cvt_pk_bf16(f[0], f[1]); w.y = cvt_pk_bf16(f[2], f[3]); w.z = cvt_pk_bf16(f[4], f[5]); w.w = cvt_pk_bf16(f[6], f[7]); return w; }
__device__ __forceinline__ float trans_settle(float x) { float r; asm volatile("s_nop 1\n\tv_mov_b32 %0, %1" : "=v"(r) : "v"(x)); return r; }
__device__ __forceinline__ float sigmoid_f(float x) { return __builtin_amdgcn_rcpf(1.f + __builtin_amdgcn_exp2f(-LOG2E * x)); }
__device__ __forceinline__ float tanh_f(float x) { return 1.f - 2.f * __builtin_amdgcn_rcpf(1.f + __builtin_amdgcn_exp2f(2.f * LOG2E * x)); }
__device__ __forceinline__ float wave_sum(float v) {
#pragma unroll
    for (int o = 1; o < 64; o <<= 1) v += __shfl_xor(v, o);
    return v;
}
template <int CTRL> __device__ __forceinline__ float dpp_f(float x) { return __builtin_bit_cast(float, __builtin_amdgcn_update_dpp(0, __builtin_bit_cast(int, x), CTRL, 0xf, 0xf, true)); }
__device__ __forceinline__ float red8(float x) { x += dpp_f<0xB1>(x); x += dpp_f<0x4E>(x); x += dpp_f<0x141>(x); return x; }
__device__ __forceinline__ float red16(float x) { x = red8(x); x += dpp_f<0x140>(x); return x; }

namespace pg8 {
constexpr int BM = 256, BK = 64, HALF = 128, HTB = HALF * BK * 2, STAGE_BYTES = 8 * HTB, NXCD = 8, WGM = 8;
__host__ __device__ __forceinline__ int lds_byte(int r, int c) { const int st = (r >> 4) * 2 + (c >> 5), rr = r & 15, cc = c & 31, ob = rr * 64 + cc * 2; return st * 1024 + (ob ^ (((ob >> 9) & 1) << 5)); }
__host__ __device__ __forceinline__ void stage_rc(int b, int& R, int& C) { const int st = b / 1024, sb = b % 1024, swz = sb ^ (((sb >> 9) & 1) << 5); R = (st >> 1) * 16 + swz / 64; C = (st & 1) * 32 + (swz % 64) / 2; }
__host__ __device__ __forceinline__ int perm32(int rho) { const int n = rho >> 4, i = rho & 15; return 8 * (i >> 2) + 4 * n + (i & 3); }

struct Unit { int pm, pn; };
struct Gemm { const bf16_t* A; const bf16_t* Bt; int M, N, K, lda; };

struct StaticOrder {
    int nM, nN, nwg, G, c;
    __device__ void init(int M, int N, int G_, int c_) { nM = M / BM; nN = N / BM; nwg = nM * nN; G = G_; c = c_; }
    __device__ bool next(int i, Unit& u) const {
        const long L = (long)i * G + c; if (L >= nwg) return false;
        int wgid = (int)L; { const int q = nwg / NXCD, r = nwg % NXCD, xcd = wgid % NXCD, off = wgid / NXCD; wgid = (xcd < r ? xcd * (q + 1) : r * (q + 1) + (xcd - r) * q) + off; }
        const int nig = WGM * nN, gid = wgid / nig, fm = gid * WGM, gsz = (nM - fm) < WGM ? (nM - fm) : WGM;
        u.pm = fm + ((wgid % nig) % gsz); u.pn = (wgid % nig) / gsz; return true;
    }
};

template <class Epi>
__device__ __forceinline__ void gemm_phase(LAS unsigned char* lds, const Gemm g, const StaticOrder& S, const Epi& E) {
    int tid = threadIdx.x; asm volatile("" : "+v"(tid));
    const int wid = __builtin_amdgcn_readfirstlane(tid >> 6), lane = tid & 63, wr = wid >> 2, wc = wid & 3, fr = lane & 15, fq = lane >> 4;
    const int K = g.K, nt = K / BK, lda = g.lda;
    unsigned voffA[2], voffB[2];
#pragma unroll
    for (int i = 0; i < 2; ++i) { int R, C; stage_rc(tid * 16 + i * 8192, R, C); const int Rb = Epi::PERM ? ((R & ~31) + perm32(R & 31)) : R;
        voffA[i] = (unsigned)(R * lda + C) * 2u; voffB[i] = (unsigned)(Rb * K + C) * 2u; }
    const size_t kstep = (size_t)(BK * 2);
    const size_t hstepA = (size_t)HALF * lda * 2, hstepB = (size_t)HALF * K * 2;
    const size_t tstepA = 2 * hstepA, tstepB = 2 * hstepB;
    const unsigned ldsw = (unsigned)wid * 1024u;
    const int aoff = lds_byte(wr * 64 + fr, fq * 8), boff = lds_byte(wc * 32 + fr, fq * 8);
#define PG8_SA(b, h) (((b) * 2 + (h)) * HTB)
#define PG8_SB(b, h) ((4 + (b) * 2 + (h)) * HTB)
#define PG8_STAGE(bufoff, gbase, voff) do { _Pragma("unroll") for (int _i = 0; _i < 2; ++_i) \
        __builtin_amdgcn_global_load_lds((const unsigned*)((const char*)(gbase) + (voff)[_i]), (LAS unsigned*)(lds + (bufoff) + ldsw + _i * 8192), 16, 0, 0); } while (0)
#define PG8_LDA(dst, b, h) do { _Pragma("unroll") for (int m = 0; m < 4; ++m) _Pragma("unroll") for (int k = 0; k < 2; ++k) dst[m][k] = *(const LAS bf16x8*)(lds + PG8_SA(b, h) + aoff + m * 2048 + k * 1024); } while (0)
#define PG8_LDB(dst, b, h) do { _Pragma("unroll") for (int n = 0; n < 2; ++n) _Pragma("unroll") for (int k = 0; k < 2; ++k) dst[n][k] = *(const LAS bf16x8*)(lds + PG8_SB(b, h) + boff + n * 2048 + k * 1024); } while (0)
#define PG8_MMA(ai, bj, At, Bt) do { __builtin_amdgcn_s_setprio(1); _Pragma("unroll") for (int m = 0; m < 4; ++m) _Pragma("unroll") for (int n = 0; n < 2; ++n) _Pragma("unroll") for (int k = 0; k < 2; ++k) \
        acc[ai][bj][m][n] = __builtin_amdgcn_mfma_f32_16x16x32_bf16(Bt[n][k], At[m][k], acc[ai][bj][m][n], 0, 0, 0); __builtin_amdgcn_s_setprio(0); } while (0)
#define PG8_WAIT_V(n) asm volatile("s_waitcnt vmcnt(" #n ")" ::: "memory")
#define PG8_WAIT_L(n) asm volatile("s_waitcnt lgkmcnt(" #n ")" ::: "memory")
#define PG8_BAR __builtin_amdgcn_s_barrier()
#define PG8_SCHED __builtin_amdgcn_sched_barrier(0)
    Unit cur, nxt; int ui = 0;
    if (!S.next(0, cur)) return;
    f32x4 acc[2][2][4][2];
#pragma unroll
    for (int a = 0; a < 2; ++a)
#pragma unroll
        for (int b = 0; b < 2; ++b)
#pragma unroll
            for (int m = 0; m < 4; ++m)
#pragma unroll
                for (int n = 0; n < 2; ++n) acc[a][b][m][n] = (f32x4){0.f, 0.f, 0.f, 0.f};
    bf16x8 At[4][2], B0[2][2], B1[2][2];
    const char* cA = (const char*)g.A + (size_t)cur.pm * tstepA; const char* cB = (const char*)g.Bt + (size_t)cur.pn * tstepB;
    PG8_STAGE(PG8_SB(0, 0), cB, voffB); PG8_STAGE(PG8_SB(0, 1), cB + hstepB, voffB); PG8_STAGE(PG8_SA(0, 0), cA, voffA); PG8_STAGE(PG8_SA(0, 1), cA + hstepA, voffA);
    if (wr == 1) PG8_BAR;
    PG8_WAIT_V(2); PG8_BAR;
    PG8_STAGE(PG8_SB(1, 0), cB + kstep, voffB); PG8_STAGE(PG8_SA(1, 0), cA + kstep, voffA); PG8_STAGE(PG8_SB(1, 1), cB + hstepB + kstep, voffB);
    PG8_WAIT_V(6); PG8_BAR;
    for (;;) {
        const bool has_next = S.next(ui + 1, nxt);
        const char* nA = has_next ? (const char*)g.A + (size_t)nxt.pm * tstepA : cA; const char* nB = has_next ? (const char*)g.Bt + (size_t)nxt.pn * tstepB : cB;
#pragma nounroll
        for (int t = 0; t < nt; t += 2) {
            const bool last = (t == nt - 2);
            const char* a1 = cA + (size_t)(t + 1) * kstep;
            const char* a2 = last ? nA : cA + (size_t)(t + 2) * kstep; const char* b2 = last ? nB : cB + (size_t)(t + 2) * kstep;
            const char* a3 = a2 + kstep; const char* b3 = b2 + kstep;
            PG8_LDB(B0, 0, 0); PG8_LDB(B1, 0, 1); PG8_SCHED; PG8_LDA(At, 0, 0); PG8_STAGE(PG8_SA(1, 1), a1 + hstepA, voffA);
            PG8_WAIT_V(8); PG8_WAIT_L(0); PG8_BAR; PG8_MMA(0, 0, At, B0); PG8_MMA(0, 1, At, B1); PG8_BAR; PG8_SCHED;
            PG8_LDA(At, 0, 1); PG8_STAGE(PG8_SB(0, 0), b2, voffB); PG8_STAGE(PG8_SB(0, 1), b2 + hstepB, voffB); PG8_STAGE(PG8_SA(0, 0), a2, voffA);
            PG8_WAIT_V(8); PG8_WAIT_L(0); PG8_BAR; PG8_MMA(1, 0, At, B0); PG8_MMA(1, 1, At, B1); PG8_BAR; PG8_SCHED;
            PG8_LDB(B0, 1, 0); PG8_LDB(B1, 1, 1); PG8_SCHED; PG8_LDA(At, 1, 0); PG8_STAGE(PG8_SA(0, 1), a2 + hstepA, voffA);
            PG8_WAIT_V(8); PG8_WAIT_L(0); PG8_BAR; PG8_MMA(0, 0, At, B0); PG8_MMA(0, 1, At, B1); PG8_BAR; PG8_SCHED;
            PG8_LDA(At, 1, 1); PG8_STAGE(PG8_SB(1, 0), b3, voffB); PG8_STAGE(PG8_SB(1, 1), b3 + hstepB, voffB); PG8_STAGE(PG8_SA(1, 0), a3, voffA);
            PG8_WAIT_V(8); PG8_WAIT_L(0); PG8_BAR; PG8_MMA(1, 0, At, B0); PG8_MMA(1, 1, At, B1); PG8_BAR; PG8_SCHED;
        }
        if (wr == 0) PG8_BAR;
        E(acc, cur, wr, wc, fr, fq);
        if (!has_next) break;
#pragma unroll
        for (int a = 0; a < 2; ++a)
#pragma unroll
            for (int b = 0; b < 2; ++b)
#pragma unroll
                for (int m = 0; m < 4; ++m)
#pragma unroll
                    for (int n = 0; n < 2; ++n) acc[a][b][m][n] = (f32x4){0.f, 0.f, 0.f, 0.f};
        cur = nxt; cA = nA; cB = nB; ++ui;
        if (wr == 1) PG8_BAR;
    }
    PG8_WAIT_V(0);
    PG8_BAR;
#undef PG8_SA
#undef PG8_SB
#undef PG8_STAGE
#undef PG8_LDA
#undef PG8_LDB
#undef PG8_MMA
#undef PG8_WAIT_V
#undef PG8_WAIT_L
#undef PG8_BAR
#undef PG8_SCHED
}

#define EPI_FENCE() do { asm volatile("" ::: "memory"); __builtin_amdgcn_sched_barrier(0); } while (0)
template <int ACT> struct EpiStore {
    static constexpr bool PERM = true;
    bf16_t* O0; int ld0; bf16_t* O1; int ld1; int pn_split;
    __device__ __forceinline__ void operator()(const f32x4 (&acc)[2][2][4][2], const Unit& u, int wr, int wc, int fr, int fq) const {
        bf16_t* base; int ld, colt;
        if (u.pn < pn_split) { base = O0; ld = ld0; colt = u.pn * BM; } else { base = O1; ld = ld1; colt = (u.pn - pn_split) * BM; }
        const int row0 = u.pm * BM + wr * 64 + fr, col0 = colt + wc * 32 + 8 * fq;
#pragma unroll
        for (int ai = 0; ai < 2; ++ai)
#pragma unroll
            for (int m = 0; m < 4; ++m) { bf16_t* rowp = base + (size_t)(row0 + ai * HALF + m * 16) * ld + col0;
#pragma unroll
                for (int bj = 0; bj < 2; ++bj) { float v[8];
#pragma unroll
                    for (int j = 0; j < 4; ++j) { v[j] = acc[ai][bj][m][0][j]; v[4 + j] = acc[ai][bj][m][1][j]; }
#pragma unroll
                    for (int j = 0; j < 8; ++j) { if (ACT == 1) v[j] = sigmoid_f(v[j]); if (ACT == 2) { const float r = fmaxf(v[j], 0.f); v[j] = r * r; } }
                    *(u32x4*)(rowp + bj * HALF) = pack8(v); }
                EPI_FENCE(); }
    }
};
struct EpiResidual {
    static constexpr bool PERM = false;
    const float* xin; float* xout;
    __device__ __forceinline__ void operator()(const f32x4 (&acc)[2][2][4][2], const Unit& u, int wr, int wc, int fr, int fq) const {
        const int row0 = u.pm * BM + wr * 64 + fr, col0 = u.pn * BM + wc * 32 + 4 * fq;
#pragma unroll
        for (int ai = 0; ai < 2; ++ai)
#pragma unroll
            for (int m = 0; m < 4; ++m) { const size_t off = (size_t)(row0 + ai * HALF + m * 16) * D_MODEL + col0;
#pragma unroll
                for (int bj = 0; bj < 2; ++bj)
#pragma unroll
                    for (int n = 0; n < 2; ++n) { const f32x4 b = *(const f32x4*)(xin + off + bj * HALF + n * 16); *(f32x4*)(xout + off + bj * HALF + n * 16) = b + acc[ai][bj][m][n]; } }
    }
};
struct EpiMulInPlace {
    static constexpr bool PERM = true;
    bf16_t* Y; int ld;
    __device__ __forceinline__ void operator()(const f32x4 (&acc)[2][2][4][2], const Unit& u, int wr, int wc, int fr, int fq) const {
        const int row0 = u.pm * BM + wr * 64 + fr, col0 = u.pn * BM + wc * 32 + 8 * fq;
#pragma unroll
        for (int ai = 0; ai < 2; ++ai)
#pragma unroll
            for (int m = 0; m < 4; ++m) { bf16_t* rowp = Y + (size_t)(row0 + ai * HALF + m * 16) * ld + col0;
#pragma unroll
                for (int bj = 0; bj < 2; ++bj) { float y[8]; unpack8(*(const u32x4*)(rowp + bj * HALF), y);
#pragma unroll
                    for (int j = 0; j < 4; ++j) { y[j] *= acc[ai][bj][m][0][j]; y[4 + j] *= acc[ai][bj][m][1][j]; }
                    *(u32x4*)(rowp + bj * HALF) = pack8(y); }
                EPI_FENCE(); }
    }
};
template <bool FIRST> struct EpiBranch {
    static constexpr bool PERM = true;
    const bf16_t* Gt; bf16_t* Mg;
    __device__ __forceinline__ void operator()(const f32x4 (&acc)[2][2][4][2], const Unit& u, int wr, int wc, int fr, int fq) const {
        const int row0 = u.pm * BM + wr * 64 + fr, col0 = u.pn * BM + wc * 32 + 8 * fq;
#pragma unroll
        for (int ai = 0; ai < 2; ++ai) {
            u32x4 gq[4][2], mq[4][2];
#pragma unroll
            for (int m = 0; m < 4; ++m) { const size_t off = (size_t)(row0 + ai * HALF + m * 16) * D_MODEL + col0;
#pragma unroll
                for (int bj = 0; bj < 2; ++bj) { gq[m][bj] = *(const u32x4*)(Gt + off + bj * HALF); if (!FIRST) mq[m][bj] = *(const u32x4*)(Mg + off + bj * HALF); } }
#pragma unroll
            for (int m = 0; m < 4; ++m) { const size_t off = (size_t)(row0 + ai * HALF + m * 16) * D_MODEL + col0;
#pragma unroll
                for (int bj = 0; bj < 2; ++bj) { float gt[8], o[8]; unpack8(gq[m][bj], gt);
                    if (FIRST) {
#pragma unroll
                        for (int j = 0; j < 8; ++j) o[j] = 0.f;
                    } else unpack8(mq[m][bj], o);
#pragma unroll
                    for (int j = 0; j < 4; ++j) { o[j] += gt[j] * acc[ai][bj][m][0][j]; o[4 + j] += gt[4 + j] * acc[ai][bj][m][1][j]; }
                    *(u32x4*)(Mg + off + bj * HALF) = pack8(o); } }
            EPI_FENCE(); }
    }
};
struct EpiAttn {
    static constexpr bool PERM = false;
    bf16_t* C2; bf16_t* VT; const float* qg; const float* kg;
    __device__ __forceinline__ void operator()(const f32x4 (&acc)[2][2][4][2], const Unit& u, int wr, int wc, int fr, int fq) const {
        if (u.pn == 2 && wc >= 2) {
#pragma unroll
            for (int ai = 0; ai < 2; ++ai)
#pragma unroll
                for (int m = 0; m < 4; ++m) { const int row = u.pm * BM + ai * HALF + wr * 64 + m * 16 + fr;
                    bf16_t* rowp = C2 + (size_t)row * LD_C2 + 2048 + wc * 64 + 4 * fq;
#pragma unroll
                    for (int bj = 0; bj < 2; ++bj)
#pragma unroll
                        for (int n = 0; n < 2; ++n) { const f32x4 x = acc[ai][bj][m][n]; u32x2 w; w.x = cvt_pk_bf16(x[0], x[1]); w.y = cvt_pk_bf16(x[2], x[3]); *(u32x2*)(rowp + 32 * bj + 16 * n) = w; }
                    EPI_FENCE(); }
        } else {
            const bool isK = (u.pn == 2);
            int opq = 0; asm volatile("" : "+v"(opq));
            fq += opq; fr += opq;
            const float* gp = isK ? kg : qg;
            const int colbase = isK ? (2048 + wc * 64) : (1536 + (u.pn * 4 + wc) * 64);
            const float sc = isK ? 1.f : 0.125f * LOG2E;
            float gv[2][2][4], invf[4];
#pragma unroll
            for (int bj = 0; bj < 2; ++bj)
#pragma unroll
                for (int n = 0; n < 2; ++n)
#pragma unroll
                    for (int j = 0; j < 4; ++j) gv[bj][n][j] = gp[32 * bj + 16 * n + 4 * fq + j] * sc;
#pragma unroll
            for (int j = 0; j < 4; ++j) invf[j] = __builtin_amdgcn_exp2f(-(float)(4 * fq + j) * (13.287712379549449f / 16.f));
#pragma unroll
            for (int ai = 0; ai < 2; ++ai)
#pragma unroll
                for (int m = 0; m < 4; ++m) { const int row = u.pm * BM + ai * HALF + wr * 64 + m * 16 + fr; const int t = row & 4095;
                    float ss = 0.f;
#pragma unroll
                    for (int bj = 0; bj < 2; ++bj)
#pragma unroll
                        for (int n = 0; n < 2; ++n) { const f32x4 x = acc[ai][bj][m][n]; ss += (x[0] * x[0] + x[1] * x[1]) + (x[2] * x[2] + x[3] * x[3]); }
                    ss += __shfl_xor(ss, 16); ss += __shfl_xor(ss, 32);
                    const float rinv = __builtin_amdgcn_rsqf(ss * (1.f / 64.f) + 1e-6f);
                    bf16_t* rowp = C2 + (size_t)row * LD_C2 + colbase + 4 * fq;
#pragma unroll
                    for (int bj = 0; bj < 2; ++bj) { const float pos = (float)(bj ? (t & 63) : (t >> 6)); float o1[4], o2[4];
#pragma unroll
                        for (int j = 0; j < 4; ++j) { const float ang = pos * invf[j], c = __cosf(ang), s = __sinf(ang);
                            const float x1 = acc[ai][bj][m][0][j] * rinv * gv[bj][0][j], x2 = acc[ai][bj][m][1][j] * rinv * gv[bj][1][j];
                            o1[j] = x1 * c - x2 * s; o2[j] = x2 * c + x1 * s; }
                        u32x2 w1, w2; w1.x = cvt_pk_bf16(o1[0], o1[1]); w1.y = cvt_pk_bf16(o1[2], o1[3]); w2.x = cvt_pk_bf16(o2[0], o2[1]); w2.y = cvt_pk_bf16(o2[2], o2[3]);
                        *(u32x2*)(rowp + 32 * bj) = w1; *(u32x2*)(rowp + 32 * bj + 16) = w2; }
                    EPI_FENCE(); }
        }
    }
};
}

struct Params { const float* in[24]; float* out; unsigned char* ws; };

__device__ __forceinline__ void transpose_item(const float* W, int ldw, int k0, int n_src, bf16_t* WT, int ldt, int dst_row0, LAS float* scr, int lane) {
#pragma unroll 8
    for (int i = 0; i < 32; ++i) { const int kk = 2 * i + (lane >> 5); scr[kk * 33 + (lane & 31)] = W[(size_t)(k0 + kk) * ldw + n_src + (lane & 31)]; }
    asm volatile("s_waitcnt lgkmcnt(0)" ::: "memory");
    const int c = lane & 7;
#pragma unroll
    for (int j = 0; j < 4; ++j) { const int n = (lane >> 3) + 8 * j; const LAS float* s = scr + (8 * c) * 33 + n;
        u32x4 o; o.x = cvt_pk_bf16(s[0 * 33], s[1 * 33]); o.y = cvt_pk_bf16(s[2 * 33], s[3 * 33]); o.z = cvt_pk_bf16(s[4 * 33], s[5 * 33]); o.w = cvt_pk_bf16(s[6 * 33], s[7 * 33]);
        *(u32x4*)(WT + (size_t)(dst_row0 + n) * ldt + k0 + 8 * c) = o; }
    asm volatile("s_waitcnt lgkmcnt(0)" ::: "memory");
}
__device__ __forceinline__ void rms_row2(const float* xrow0, const float* xrow1, const float* g, bf16_t* orow0, bf16_t* orow1, int lane) {
    const f32x4* xr0 = (const f32x4*)xrow0 + lane; const f32x4* xr1 = (const f32x4*)xrow1 + lane; const f32x4* gr = (const f32x4*)g + lane;
    f32x4 v0[4], v1[4]; float s0 = 0.f, s1 = 0.f;
#pragma unroll
    for (int j = 0; j < 4; ++j) { v0[j] = xr0[64 * j]; v1[j] = xr1[64 * j]; }
#pragma unroll
    for (int j = 0; j < 4; ++j) { s0 += (v0[j].x * v0[j].x + v0[j].y * v0[j].y) + (v0[j].z * v0[j].z + v0[j].w * v0[j].w); s1 += (v1[j].x * v1[j].x + v1[j].y * v1[j].y) + (v1[j].z * v1[j].z + v1[j].w * v1[j].w); }
    const float inv0 = __builtin_amdgcn_rsqf(wave_sum(s0) * (1.f / D_MODEL) + 1e-6f), inv1 = __builtin_amdgcn_rsqf(wave_sum(s1) * (1.f / D_MODEL) + 1e-6f);
    u32x2* o0 = (u32x2*)orow0 + lane; u32x2* o1 = (u32x2*)orow1 + lane;
#pragma unroll
    for (int j = 0; j < 4; ++j) { const f32x4 gg = gr[64 * j]; u32x2 w;
        w.x = cvt_pk_bf16(v0[j].x * inv0 * gg.x, v0[j].y * inv0 * gg.y); w.y = cvt_pk_bf16(v0[j].z * inv0 * gg.z, v0[j].w * inv0 * gg.w); o0[64 * j] = w;
        w.x = cvt_pk_bf16(v1[j].x * inv1 * gg.x, v1[j].y * inv1 * gg.y); w.y = cvt_pk_bf16(v1[j].z * inv1 * gg.z, v1[j].w * inv1 * gg.w); o1[64 * j] = w; }
}
__device__ __forceinline__ void rms_row(const float* xrow, const float* g, bf16_t* orow, int lane) {
    const f32x4* xr = (const f32x4*)xrow + lane; const f32x4* gr = (const f32x4*)g + lane;
    f32x4 v[4]; float s = 0.f;
#pragma unroll
    for (int j = 0; j < 4; ++j) { v[j] = xr[64 * j]; s += (v[j].x * v[j].x + v[j].y * v[j].y) + (v[j].z * v[j].z + v[j].w * v[j].w); }
    const float inv = __builtin_amdgcn_rsqf(wave_sum(s) * (1.f / D_MODEL) + 1e-6f);
    u32x2* o8 = (u32x2*)orow + lane;
#pragma unroll
    for (int j = 0; j < 4; ++j) { const f32x4 gg = gr[64 * j]; u32x2 w; w.x = cvt_pk_bf16(v[j].x * inv * gg.x, v[j].y * inv * gg.y); w.y = cvt_pk_bf16(v[j].z * inv * gg.z, v[j].w * inv * gg.w); o8[64 * j] = w; }
}

constexpr int AT_KSTR = 72, AT_VSTR = 68;
constexpr int AT_KBYTES = 64 * AT_KSTR * 2, AT_VBYTES = 64 * AT_VSTR * 2;
__device__ __forceinline__ void vt_write(LAS unsigned char* p, const u32x4 v) {
    *(LAS unsigned short*)(p + 0 * (AT_VSTR * 2)) = (unsigned short)(v.x & 0xffffu); *(LAS unsigned short*)(p + 1 * (AT_VSTR * 2)) = (unsigned short)(v.x >> 16);
    *(LAS unsigned short*)(p + 2 * (AT_VSTR * 2)) = (unsigned short)(v.y & 0xffffu); *(LAS unsigned short*)(p + 3 * (AT_VSTR * 2)) = (unsigned short)(v.y >> 16);
    *(LAS unsigned short*)(p + 4 * (AT_VSTR * 2)) = (unsigned short)(v.z & 0xffffu); *(LAS unsigned short*)(p + 5 * (AT_VSTR * 2)) = (unsigned short)(v.z >> 16);
    *(LAS unsigned short*)(p + 6 * (AT_VSTR * 2)) = (unsigned short)(v.w & 0xffffu); *(LAS unsigned short*)(p + 7 * (AT_VSTR * 2)) = (unsigned short)(v.w >> 16);
}
__device__ __forceinline__ void attn_tile(LAS unsigned char* lds, int cur, int r32, int hi, const bf16x8 (&qf)[4], float& mref, float& lrun, f32x16& o0, f32x16& o1) {
        const LAS unsigned char* kb = lds + cur * AT_KBYTES + r32 * (AT_KSTR * 2) + hi * 16;
        f32x16 p0, p1;
        { const float nm = -mref;
#pragma unroll
          for (int r = 0; r < 16; ++r) { p0[r] = nm; p1[r] = nm; } }
#pragma unroll
        for (int d0 = 0; d0 < 4; ++d0) {
            const bf16x8 a0 = *(const LAS bf16x8*)(kb + d0 * 32), a1 = *(const LAS bf16x8*)(kb + 32 * (AT_KSTR * 2) + d0 * 32);
            p0 = __builtin_amdgcn_mfma_f32_32x32x16_bf16(a0, qf[d0], p0, 0, 0, 0);
            p1 = __builtin_amdgcn_mfma_f32_32x32x16_bf16(a1, qf[d0], p1, 0, 0, 0);
        }
        float mx = __builtin_fmaxf(__builtin_fmaxf(p0[0], p1[0]), p0[1]);
        mx = __builtin_fmaxf(__builtin_fmaxf(mx, p1[1]), p0[2]);
#pragma unroll
        for (int r = 2; r < 14; r += 2) { mx = __builtin_fmaxf(__builtin_fmaxf(mx, p1[r]), p0[r + 1]); mx = __builtin_fmaxf(__builtin_fmaxf(mx, p1[r + 1]), p0[r + 2]); }
        mx = __builtin_fmaxf(__builtin_fmaxf(mx, p1[14]), p0[15]); mx = __builtin_fmaxf(mx, p1[15]);
        mx = __builtin_fmaxf(mx, __shfl_xor(mx, 32));
        if (__builtin_expect(__any(mx > 8.0f), 0)) {
            const float dl = __builtin_fmaxf(mx, 0.f), f = __builtin_amdgcn_exp2f(-dl);
            mref += dl; lrun *= f;
#pragma unroll
            for (int r = 0; r < 16; ++r) { p0[r] -= dl; p1[r] -= dl; o0[r] *= f; o1[r] *= f; }
        }
        f32x2 ls2 = {0.f, 0.f};
#pragma unroll
        for (int r = 0; r < 16; r += 2) {
            p0[r] = __builtin_amdgcn_exp2f(p0[r]); p0[r + 1] = __builtin_amdgcn_exp2f(p0[r + 1]); p1[r] = __builtin_amdgcn_exp2f(p1[r]); p1[r + 1] = __builtin_amdgcn_exp2f(p1[r + 1]);
            ls2 += (f32x2){p0[r], p0[r + 1]}; ls2 += (f32x2){p1[r], p1[r + 1]};
        }
        lrun += ls2.x + ls2.y;
        bf16x8 pf[4];
        { u32x4 w;
          w.x = cvt_pk_bf16(p0[0], p0[1]); w.y = cvt_pk_bf16(p0[2], p0[3]); w.z = cvt_pk_bf16(p0[4], p0[5]); w.w = cvt_pk_bf16(p0[6], p0[7]); pf[0] = __builtin_bit_cast(bf16x8, w);
          w.x = cvt_pk_bf16(p0[8], p0[9]); w.y = cvt_pk_bf16(p0[10], p0[11]); w.z = cvt_pk_bf16(p0[12], p0[13]); w.w = cvt_pk_bf16(p0[14], p0[15]); pf[1] = __builtin_bit_cast(bf16x8, w);
          w.x = cvt_pk_bf16(p1[0], p1[1]); w.y = cvt_pk_bf16(p1[2], p1[3]); w.z = cvt_pk_bf16(p1[4], p1[5]); w.w = cvt_pk_bf16(p1[6], p1[7]); pf[2] = __builtin_bit_cast(bf16x8, w);
          w.x = cvt_pk_bf16(p1[8], p1[9]); w.y = cvt_pk_bf16(p1[10], p1[11]); w.z = cvt_pk_bf16(p1[12], p1[13]); w.w = cvt_pk_bf16(p1[14], p1[15]); pf[3] = __builtin_bit_cast(bf16x8, w); }
        const LAS unsigned char* vb = lds + 2 * AT_KBYTES + cur * AT_VBYTES + r32 * (AT_VSTR * 2) + hi * 8;
#pragma unroll
        for (int s = 0; s < 4; ++s) {
            const int koff = ((s >> 1) * 32 + (s & 1) * 16) * 2;
            const u32x2 l0 = *(const LAS u32x2*)(vb + koff), h0 = *(const LAS u32x2*)(vb + koff + 16);
            const u32x2 l1 = *(const LAS u32x2*)(vb + 32 * (AT_VSTR * 2) + koff), h1 = *(const LAS u32x2*)(vb + 32 * (AT_VSTR * 2) + koff + 16);
            const bf16x8 a0 = __builtin_bit_cast(bf16x8, (u32x4){l0.x, l0.y, h0.x, h0.y}), a1 = __builtin_bit_cast(bf16x8, (u32x4){l1.x, l1.y, h1.x, h1.y});
            o0 = __builtin_amdgcn_mfma_f32_32x32x16_bf16(a0, pf[s], o0, 0, 0, 0);
            o1 = __builtin_amdgcn_mfma_f32_32x32x16_bf16(a1, pf[s], o1, 0, 0, 0);
        }
}
__device__ __forceinline__ void attn_unit(LAS unsigned char* lds, bf16_t* C2, bf16_t* Odummy, int b, int kvh, int qb) {
    int tid = threadIdx.x; asm volatile("" : "+v"(tid));
    const int lane = tid & 63, r32 = lane & 31, hi = lane >> 5, wid = __builtin_amdgcn_readfirstlane(tid >> 6);
    const int g = wid & 3, th = wid >> 2, head = kvh * 4 + g;
    const size_t rowbase = (size_t)b * SEQ;
    const int tok0 = qb * 128 + th * 64;
    bf16_t* qrowA = C2 + (rowbase + tok0 + r32) * LD_C2 + 1536 + head * 64;
    bf16_t* qrowB = qrowA + (size_t)32 * LD_C2;
    bf16x8 qfA[4], qfB[4];
#pragma unroll
    for (int d0 = 0; d0 < 4; ++d0) { qfA[d0] = *(const bf16x8*)(qrowA + d0 * 16 + hi * 8); qfB[d0] = *(const bf16x8*)(qrowB + d0 * 16 + hi * 8); }
    const int srow = tid >> 3, sch = tid & 7;
    const bf16_t* ksrc = C2 + (rowbase + srow) * LD_C2 + 2048 + kvh * 64 + sch * 8;
    const bf16_t* vsrc = ksrc + 128;
    LAS unsigned char* kdst = lds + srow * (AT_KSTR * 2) + sch * 16;
    LAS unsigned char* vdst = lds + 2 * AT_KBYTES + (8 * sch) * (AT_VSTR * 2) + srow * 2;
    u32x4 kregA = *(const u32x4*)ksrc, vregA = *(const u32x4*)vsrc, kregB, vregB;
    *(LAS u32x4*)kdst = kregA; vt_write(vdst, vregA);
    kregA = *(const u32x4*)(ksrc + (size_t)64 * LD_C2); vregA = *(const u32x4*)(vsrc + (size_t)64 * LD_C2);
    __syncthreads();
    f32x16 oA0 = {}, oA1 = {}, oB0 = {}, oB1 = {};
    float mrefA = 0.f, lrunA = 0.f, mrefB = 0.f, lrunB = 0.f;
#define AT_STEP(kt, cur, KW, VW, KL, VL) { \
        if ((kt) + 2 < SEQ / 64) { KL = *(const u32x4*)(ksrc + (size_t)((kt) + 2) * 64 * LD_C2); VL = *(const u32x4*)(vsrc + (size_t)((kt) + 2) * 64 * LD_C2); } \
        attn_tile(lds, cur, r32, hi, qfA, mrefA, lrunA, oA0, oA1); \
        __builtin_amdgcn_sched_barrier(0); \
        attn_tile(lds, cur, r32, hi, qfB, mrefB, lrunB, oB0, oB1); \
        __builtin_amdgcn_sched_barrier(0); \
        if ((kt) + 1 < SEQ / 64) { *(LAS u32x4*)(kdst + ((cur) ^ 1) * AT_KBYTES) = KW; vt_write(vdst + ((cur) ^ 1) * AT_VBYTES, VW); } \
        __syncthreads(); }
    for (int kt = 0; kt < SEQ / 64; kt += 2) {
        AT_STEP(kt, 0, kregA, vregA, kregB, vregB);
        AT_STEP(kt + 1, 1, kregB, vregB, kregA, vregA);
    }
#undef AT_STEP
#pragma unroll
    for (int blk = 0; blk < 2; ++blk) {
        float lr = blk ? lrunB : lrunA; lr += __shfl_xor(lr, 32);
        const float rl = __builtin_amdgcn_rcpf(lr);
        const f32x16& o0 = blk ? oB0 : oA0; const f32x16& o1 = blk ? oB1 : oA1;
        bf16_t* qrow = blk ? qrowB : qrowA;
        bf16_t* orow = Odummy ? Odummy + (rowbase + tok0 + 32 * blk + r32) * 512 + head * 64 : qrow;
#pragma unroll
        for (int g4 = 0; g4 < 4; ++g4) {
            u32x2 w0, w1;
            w0.x = cvt_pk_bf16(o0[4 * g4] * rl, o0[4 * g4 + 1] * rl); w0.y = cvt_pk_bf16(o0[4 * g4 + 2] * rl, o0[4 * g4 + 3] * rl);
            w1.x = cvt_pk_bf16(o1[4 * g4] * rl, o1[4 * g4 + 1] * rl); w1.y = cvt_pk_bf16(o1[4 * g4 + 2] * rl, o1[4 * g4 + 3] * rl);
            *(u32x2*)(orow + 8 * g4 + 4 * hi) = w0; *(u32x2*)(orow + 32 + 8 * g4 + 4 * hi) = w1;
        }
    }
}

__device__ __forceinline__ void conv_item(bf16_t* C2, const float* cvw, const float* cvb, int idx) {
    const int m = idx >> 6, c0 = (idx & 63) * 8, t = m & 4095;
    bf16_t* rp = C2 + (size_t)m * LD_C2 + c0;
    const bf16_t* rpp = (t > 0) ? rp - LD_C2 : rp; const bf16_t* rpn = (t < SEQ - 1) ? rp + LD_C2 : rp;
    const float fp = (t > 0) ? 1.f : 0.f, fn = (t < SEQ - 1) ? 1.f : 0.f;
    float bg[8], c[8], x[8], a[8], bq[8], a2[8], b2[8], o[8];
    unpack8(*(const u32x4*)rp, bg); unpack8(*(const u32x4*)(rp + 512), c); unpack8(*(const u32x4*)(rp + 1024), x);
    unpack8(*(const u32x4*)(rpp + 512), a); unpack8(*(const u32x4*)(rpp + 1024), bq); unpack8(*(const u32x4*)(rpn + 512), a2); unpack8(*(const u32x4*)(rpn + 1024), b2);
#pragma unroll
    for (int j = 0; j < 8; ++j) o[j] = bg[j] * (cvb[c0 + j] + cvw[c0 + j] * (a[j] * bq[j] * fp) + cvw[512 + c0 + j] * (c[j] * x[j]) + cvw[1024 + c0 + j] * (a2[j] * b2[j] * fn));
    *(u32x4*)rp = pack8(o);
}
constexpr int SC_CH = 32;
constexpr int SC_ARR = SC_CH * 64;
constexpr int SC_R = 0, SC_W = 1, SC_KD = 2, SC_V = 3, SC_KK = 4, SC_KKA = 5, SC_ZK = 6, SC_NARR = 7;
constexpr int SC_SLOT = SC_NARR * SC_ARR;
constexpr int SC_BW_OFF = 4096, SC_BA_OFF = 4096 + 9216;
constexpr int SC_TAB = 2 * SC_SLOT;
struct ScanW { const float *mu_prev, *mu_next, *w0, *a0, *k_k, *k_a, *r_k; const bf16_t *w2t, *a2t; };

__device__ __forceinline__ void scan_produce(LAS float* sl, LAS float* tab, const bf16_t* RWC, bf16_t* SG, float* SB, const ScanW& sw, const float* mu_gd_p, const float* mu_gd_n,
                                             int b, int h, int dir, int chunk, int sub, int lane) {
    asm volatile("" : "+v"(lane));
    const int tok = lane & 15, q = lane >> 4;
    const int tokidx = 16 * sub + tok;
    const int sc = chunk * SC_CH + tokidx;
    const int t = dir ? (SEQ - 1 - sc) : sc;
    const bf16_t* rp = RWC + ((size_t)b * SEQ + t) * LD_RWC;
    const bool hasp = t > 0, hasn = t < SEQ - 1;
    const bf16_t* rpp = hasp ? rp - LD_RWC : rp;
    const bf16_t* rpn = hasn ? rp + LD_RWC : rp;
    const float fp = hasp ? 1.f : 0.f, fn = hasn ? 1.f : 0.f;
    u32x4 Lc[6], Lp[6], Ln[6];
#pragma unroll
    for (int G = 0; G < 3; ++G)
#pragma unroll
        for (int hf = 0; hf < 2; ++hf) { const int cb = G * 512 + h * 64 + 16 * q + 8 * hf;
            Lc[2 * G + hf] = *(const u32x4*)(rp + cb); Lp[2 * G + hf] = *(const u32x4*)(rpp + cb); Ln[2 * G + hf] = *(const u32x4*)(rpn + cb); }
    u32x4 Mc[5], Mp[5], Mn[5];
#pragma unroll
    for (int i = 0; i < 5; ++i) { const int cb = (i < 4) ? (1536 + (i >> 1) * 128 + dir * 64 + 32 * (i & 1) + 8 * q) : (1792 + 8 * (2 * h + dir));
        Mc[i] = *(const u32x4*)(rp + cb); Mp[i] = *(const u32x4*)(rpp + cb); Mn[i] = *(const u32x4*)(rpn + cb); }
    float zk[16];
#pragma unroll
    for (int G = 0; G < 3; ++G) {
        float z[16];
#pragma unroll
        for (int hf = 0; hf < 2; ++hf) {
            float c[8], p[8], n[8];
            unpack8(Lc[2 * G + hf], c); unpack8(Lp[2 * G + hf], p); unpack8(Ln[2 * G + hf], n);
            const LAS float* mp = tab + G * 64 + 16 * q + 8 * hf; const LAS float* mn = mp + 320;
#pragma unroll
            for (int j = 0; j < 8; ++j) z[8 * hf + j] = c[j] + mp[j] * (p[j] * fp - c[j]) + mn[j] * (n[j] * fn - c[j]);
        }
        LAS float* dst = sl + (G == 0 ? SC_R : (G == 1 ? SC_ZK : SC_V)) * SC_ARR + tokidx * 64 + 16 * q;
#pragma unroll
        for (int j4 = 0; j4 < 4; ++j4) *(LAS f32x4*)(dst + 4 * j4) = (f32x4){z[4 * j4], z[4 * j4 + 1], z[4 * j4 + 2], z[4 * j4 + 3]};
        if (G == 1) {
#pragma unroll
            for (int j = 0; j < 16; ++j) zk[j] = z[j];
        }
    }
    {
        const LAS float* kkt = tab + 640 + 16 * q;
        float kr[16], ss = 0.f;
#pragma unroll
        for (int j = 0; j < 16; ++j) { kr[j] = zk[j] * kkt[j]; ss += kr[j] * kr[j]; }
        ss += __shfl_xor(ss, 16); ss += __shfl_xor(ss, 32);
        const float inv = 1.f / fmaxf(sqrtf(ss), 1e-12f);
        LAS float* dst = sl + SC_KK * SC_ARR + tokidx * 64 + 16 * q;
#pragma unroll
        for (int j4 = 0; j4 < 4; ++j4) *(LAS f32x4*)(dst + 4 * j4) = (f32x4){kr[4 * j4] * inv, kr[4 * j4 + 1] * inv, kr[4 * j4 + 2] * inv, kr[4 * j4 + 3] * inv};
    }
    bf16x8 Awd[2], Aad[2];
#pragma unroll
    for (int i = 0; i < 4; ++i) {
        const int G = 3 + (i >> 1), ks = i & 1;
        float c[8], p[8], n[8], z[8];
        unpack8(Mc[i], c); unpack8(Mp[i], p); unpack8(Mn[i], n);
        const LAS float* mp = tab + G * 64 + 32 * ks + 8 * q; const LAS float* mn = mp + 320;
#pragma unroll
        for (int j = 0; j < 8; ++j) { z[j] = c[j] + mp[j] * (p[j] * fp - c[j]) + mn[j] * (n[j] * fn - c[j]); if (G == 3) z[j] = tanh_f(z[j]); }
        const bf16x8 fr8 = __builtin_bit_cast(bf16x8, pack8(z));
        if (G == 3) Awd[ks] = fr8; else Aad[ks] = fr8;
    }
    if (q == 0) {
        const int cg8 = 8 * (2 * h + dir);
        float c[8], p[8], n[8], z[8];
        unpack8(Mc[4], c); unpack8(Mp[4], p); unpack8(Mn[4], n);
#pragma unroll
        for (int j = 0; j < 8; ++j) z[j] = sigmoid_f(c[j] + tab[704 + j] * (p[j] * fp - c[j]) + tab[712 + j] * (n[j] * fn - c[j]));
        *(u32x4*)(SG + ((size_t)b * SEQ + t) * 256 + cg8) = pack8(z);
    }
    asm volatile("s_waitcnt lgkmcnt(0)" ::: "memory");
    f32x4 aw[4], aa[4];
    float w0r[4], a0r[4], kar[4], rkr[4];
#pragma unroll
    for (int nb = 0; nb < 4; ++nb) {
        const int cl = 16 * nb + (lane & 15);
        const LAS unsigned char* wp = (const LAS unsigned char*)tab + SC_BW_OFF + cl * 144 + 16 * (lane >> 4); const LAS unsigned char* ap = wp + (SC_BA_OFF - SC_BW_OFF);
        const bf16x8 bw0 = *(const LAS bf16x8*)wp, bw1 = *(const LAS bf16x8*)(wp + 64), ba0 = *(const LAS bf16x8*)ap, ba1 = *(const LAS bf16x8*)(ap + 64);
        w0r[nb] = tab[720 + cl]; a0r[nb] = tab[784 + cl]; kar[nb] = tab[848 + cl]; rkr[nb] = tab[912 + cl];
        aw[nb] = __builtin_amdgcn_mfma_f32_16x16x32_bf16(Awd[0], bw0, (f32x4){0.f, 0.f, 0.f, 0.f}, 0, 0, 0);
        aw[nb] = __builtin_amdgcn_mfma_f32_16x16x32_bf16(Awd[1], bw1, aw[nb], 0, 0, 0);
        aa[nb] = __builtin_amdgcn_mfma_f32_16x16x32_bf16(Aad[0], ba0, (f32x4){0.f, 0.f, 0.f, 0.f}, 0, 0, 0);
        aa[nb] = __builtin_amdgcn_mfma_f32_16x16x32_bf16(Aad[1], ba1, aa[nb], 0, 0, 0);
    }
    float bon[4] = {0.f, 0.f, 0.f, 0.f};
#pragma unroll
    for (int nb = 0; nb < 4; ++nb)
#pragma unroll
        for (int rg = 0; rg < 4; ++rg) {
            const int ti = 16 * sub + 4 * q + rg, c = 16 * nb + (lane & 15), o = ti * 64 + c;
            const float dec = trans_settle(__builtin_amdgcn_exp2f(-0.6065306597126334f * LOG2E * sigmoid_f(aw[nb][rg] + w0r[nb])));
            const float a = sigmoid_f(aa[nb][rg] + a0r[nb]);
            const float zkv = sl[SC_ZK * SC_ARR + o], kkv = sl[SC_KK * SC_ARR + o], rv = sl[SC_R * SC_ARR + o];
            const float kd = zkv * (1.f + (a - 1.f) * kar[nb]);
            sl[SC_W * SC_ARR + o] = dec; sl[SC_KD * SC_ARR + o] = kd; sl[SC_KKA * SC_ARR + o] = kkv * a;
            bon[rg] += rv * kd * rkr[nb];
        }
#pragma unroll
    for (int rg = 0; rg < 4; ++rg) {
        const float s = red16(bon[rg]);
        if ((lane & 15) == 0) { const int sc2 = chunk * SC_CH + 16 * sub + 4 * q + rg; const int t2 = dir ? (SEQ - 1 - sc2) : sc2;
            SB[((size_t)dir * T + (size_t)b * SEQ + t2) * 8 + h] = s; }
    }
}

__device__ __forceinline__ void scan_unit(LAS unsigned char* lds, const bf16_t* RWC, bf16_t* YF, bf16_t* YB, bf16_t* SG, float* SB, const ScanW& sw, int b, int h, int dir,
                                          bf16_t* C2cv, const float* cvw, const float* cvb, int unit) {
    int tid = threadIdx.x; asm volatile("" : "+v"(tid));
    const int lane = tid & 63, wid = __builtin_amdgcn_readfirstlane(tid >> 6);
    LAS float* fl = (LAS float*)lds;
    LAS float* tab = fl + SC_TAB;
    for (int i = tid; i < 976; i += 512) {
        float v;
        if (i < 640) { const int pn = i / 320, r = i % 320, G = r / 64, ch = r % 64;
            const int col = (G < 3) ? (G * 512 + h * 64 + ch) : (1536 + (G - 3) * 128 + dir * 64 + ch);
            v = (pn ? sw.mu_next : sw.mu_prev)[col]; }
        else if (i < 704) v = sw.k_k[h * 64 + (i - 640)];
        else if (i < 720) { const int j = i - 704; v = ((j >> 3) ? sw.mu_next : sw.mu_prev)[1792 + 8 * (2 * h + dir) + (j & 7)]; }
        else { const int k = i - 720, which = k >> 6, c = k & 63;
            v = which == 0 ? sw.w0[dir * 512 + h * 64 + c] : (which == 1 ? sw.a0[dir * 512 + h * 64 + c] : (which == 2 ? sw.k_a[h * 64 + c] : sw.r_k[h * 64 + c])); }
        tab[i] = v;
    }
    { const int row = tid >> 3, chunk = tid & 7; const size_t src = ((size_t)(dir * 512 + h * 64 + row)) * 64 + chunk * 8;
      *(LAS u32x4*)((LAS unsigned char*)tab + SC_BW_OFF + row * 144 + chunk * 16) = *(const u32x4*)(sw.w2t + src);
      *(LAS u32x4*)((LAS unsigned char*)tab + SC_BA_OFF + row * 144 + chunk * 16) = *(const u32x4*)(sw.a2t + src); }
    __syncthreads();
    if (wid >= 4 && wid < 6) scan_produce(fl, tab, RWC, SG, SB, sw, sw.mu_prev + 1792, sw.mu_next + 1792, b, h, dir, 0, wid - 4, lane);
    __syncthreads();
    const int vp = tid >> 3, kq = tid & 7;
    f32x2 S0[4], S1[4];
#pragma unroll
    for (int i = 0; i < 4; ++i) { S0[i] = (f32x2){0.f, 0.f}; S1[i] = (f32x2){0.f, 0.f}; }
    bf16_t* Y = dir ? YB : YF;
    for (int ch = 0; ch < SEQ / SC_CH; ++ch) {
        LAS float* sl = fl + (ch & 1) * SC_SLOT;
        if (wid < 4) {
            const LAS float* base = sl + 8 * kq;
            const LAS float* vbase = sl + SC_V * SC_ARR + 2 * vp;
            f32x4 nkk0, nkk1, nw0, nw1, nka0, nka1, nkd0, nkd1, nr0, nr1; f32x2 nvv;
#define SC_LOAD(s_) do { const LAS float* p_ = base + (s_) * 64; \
                nkk0 = *(const LAS f32x4*)(p_ + SC_KK * SC_ARR); nkk1 = *(const LAS f32x4*)(p_ + SC_KK * SC_ARR + 4); \
                nw0 = *(const LAS f32x4*)(p_ + SC_W * SC_ARR); nw1 = *(const LAS f32x4*)(p_ + SC_W * SC_ARR + 4); \
                nka0 = *(const LAS f32x4*)(p_ + SC_KKA * SC_ARR); nka1 = *(const LAS f32x4*)(p_ + SC_KKA * SC_ARR + 4); \
                nkd0 = *(const LAS f32x4*)(p_ + SC_KD * SC_ARR); nkd1 = *(const LAS f32x4*)(p_ + SC_KD * SC_ARR + 4); \
                nr0 = *(const LAS f32x4*)(p_ + SC_R * SC_ARR); nr1 = *(const LAS f32x4*)(p_ + SC_R * SC_ARR + 4); \
                nvv = *(const LAS f32x2*)(vbase + (s_) * 64); } while (0)
            SC_LOAD(0);
#pragma unroll 2
            for (int s = 0; s < SC_CH; ++s) {
                f32x2 kk[4], w[4], ka[4], kd[4], r[4];
                kk[0] = nkk0.xy; kk[1] = nkk0.zw; kk[2] = nkk1.xy; kk[3] = nkk1.zw;
                w[0] = nw0.xy; w[1] = nw0.zw; w[2] = nw1.xy; w[3] = nw1.zw;
                ka[0] = nka0.xy; ka[1] = nka0.zw; ka[2] = nka1.xy; ka[3] = nka1.zw;
                kd[0] = nkd0.xy; kd[1] = nkd0.zw; kd[2] = nkd1.xy; kd[3] = nkd1.zw;
                r[0] = nr0.xy; r[1] = nr0.zw; r[2] = nr1.xy; r[3] = nr1.zw;
                const f32x2 vv = nvv;
                SC_LOAD((s + 1) & (SC_CH - 1));
                f32x2 t0 = S0[0] * kk[0], t1 = S1[0] * kk[0];
#pragma unroll
                for (int i = 1; i < 4; ++i) { t0 = S0[i] * kk[i] + t0; t1 = S1[i] * kk[i] + t1; }
                const float sa0 = red8(t0.x + t0.y), sa1 = red8(t1.x + t1.y);
                const f32x2 n0 = (f32x2){-sa0, -sa0}, n1 = (f32x2){-sa1, -sa1}, v0 = (f32x2){vv.x, vv.x}, v1 = (f32x2){vv.y, vv.y};
                f32x2 y0 = (f32x2){0.f, 0.f}, y1 = (f32x2){0.f, 0.f};
#pragma unroll
                for (int i = 0; i < 4; ++i) {
                    S0[i] = S0[i] * w[i] + (v0 * kd[i] + n0 * ka[i]);
                    S1[i] = S1[i] * w[i] + (v1 * kd[i] + n1 * ka[i]);
                    y0 = S0[i] * r[i] + y0; y1 = S1[i] * r[i] + y1;
                }
                float yp0 = y0.x + y0.y, yp1 = y1.x + y1.y; asm volatile("" : "+v"(yp0));
                const float ys0 = red8(yp0), ys1 = red8(yp1);
                if (kq == 0) { const int sc = ch * SC_CH + s; const int t = dir ? (SEQ - 1 - sc) : sc;
                    *(unsigned*)(Y + ((size_t)b * SEQ + t) * 512 + h * 64 + 2 * vp) = cvt_pk_bf16(ys0, ys1); }
            }
#undef SC_LOAD
        } else if (wid < 6) {
            if (ch + 1 < SEQ / SC_CH) scan_produce(fl + ((ch + 1) & 1) * SC_SLOT, tab, RWC, SG, SB, sw, sw.mu_prev + 1792, sw.mu_next + 1792, b, h, dir, ch + 1, wid - 4, lane);
        } else {
            conv_item(C2cv, cvw, cvb, unit * 16384 + ch * 128 + (tid - 384));
        }
        __syncthreads();
    }
}


#define XB_TMO      128
#define XB_XCNT(j)  (256  + 64 * (j))
#define XB_XSUB(j)  (1280 + 64 * (j))
#define XB_XGEN(j)  (2304 + 64 * (j))
#define XB_TOP      3328
#define XB_TOPGEN   3392
#define XB_SPIN_CAP (1u << 22)
__device__ __forceinline__ unsigned xb_ld(unsigned* p)              { return __hip_atomic_load(p, __ATOMIC_RELAXED, __HIP_MEMORY_SCOPE_AGENT); }
__device__ __forceinline__ unsigned xb_add(unsigned* p, unsigned v) { return __hip_atomic_fetch_add(p, v, __ATOMIC_RELAXED, __HIP_MEMORY_SCOPE_AGENT); }
__device__ __forceinline__ unsigned xb_xcc_id() { return (unsigned)__builtin_amdgcn_s_getreg((3 << 11) | 20) & 0xFu; }
#define XB_SPIN(cond, bar) do { unsigned _sp = 0; while (cond) { __builtin_amdgcn_s_sleep(1); \
    if ((++_sp & 255u) == 0u) { if (xb_ld(&(bar)[XB_TMO])) break; if (_sp > XB_SPIN_CAP) { atomicAdd(&(bar)[XB_TMO], 1u); break; } } } } while (0)
struct XcdBarrier { unsigned* bar; unsigned x; volatile LAS unsigned* st; };
__device__ __forceinline__ XcdBarrier xcd_barrier_post(unsigned* bar, volatile LAS unsigned* st) {
    XcdBarrier b; b.bar = bar; b.x = xb_xcc_id(); b.st = st;
    if (threadIdx.x == 0) (void)xb_add(&bar[XB_XCNT(b.x)], 1u);
    return b;
}
__device__ __forceinline__ void xcd_barrier_complete(unsigned* bar, unsigned x, unsigned& nloc, unsigned& nx) {
    const unsigned G = gridDim.x * gridDim.y * gridDim.z;
    unsigned sum, cnt, mine, sp = 0u;
    for (;;) {
        sum = 0u; cnt = 0u; mine = 0u;
#pragma unroll
        for (unsigned j = 0; j < 16; ++j) { const unsigned c = xb_ld(&bar[XB_XCNT(j)]); sum += c; cnt += (c > 0u) ? 1u : 0u; mine = (j == x) ? c : mine; }
        if (sum == G) break;
        __builtin_amdgcn_s_sleep(1);
        if ((++sp & 255u) == 0u) { if (xb_ld(&bar[XB_TMO])) break; if (sp > XB_SPIN_CAP) { atomicAdd(&bar[XB_TMO], 1u); break; } }
    }
    nloc = mine > 0u ? mine : 1u; nx = cnt > 0u ? cnt : 1u;
}
__device__ __forceinline__ void xcd_barrier(const XcdBarrier& b) {
    asm volatile("s_waitcnt vmcnt(0)" ::: "memory");
    __syncthreads();
    if (threadIdx.x == 0) {
        unsigned* bar = b.bar;
        __builtin_amdgcn_s_waitcnt(0);
        unsigned nloc = b.st[0], nx = b.st[1];
        if (nloc == 0u) { xcd_barrier_complete(bar, b.x, nloc, nx); b.st[0] = nloc; b.st[1] = nx; }
        const unsigned old = xb_add(&bar[XB_XSUB(b.x)], 1u);
        const unsigned gen = old / nloc;
        if (old + 1u == (gen + 1u) * nloc) {
            __builtin_amdgcn_fence(__ATOMIC_RELEASE, "agent");
            asm volatile("s_waitcnt vmcnt(0)" ::: "memory");
            const unsigned og = xb_add(&bar[XB_TOP], 1u);
            const unsigned tg = og / nx;
            if (og + 1u == (tg + 1u) * nx) xb_add(&bar[XB_TOPGEN], 1u);
            else XB_SPIN(xb_ld(&bar[XB_TOPGEN]) == tg, bar);
            __builtin_amdgcn_fence(__ATOMIC_ACQUIRE, "agent");
            xb_add(&bar[XB_XGEN(b.x)], 1u);
            asm volatile("s_waitcnt vmcnt(0)" ::: "memory");
        } else {
            XB_SPIN(xb_ld(&bar[XB_XGEN(b.x)]) == gen, bar);
            __builtin_amdgcn_fence(__ATOMIC_ACQUIRE, "agent");
            asm volatile("s_waitcnt vmcnt(0)" ::: "memory");
        }
    }
    __syncthreads();
}

#ifdef MK_DBG_STOP
#define DBG_STOP(k) do { if ((k) == MK_DBG_STOP && l == 0) { dbg_dump(p, ws0, bx * 512 + (int)threadIdx.x, G * 512); return; } } while (0)
__device__ __noinline__ void dbg_dump(const Params& p, unsigned char* ws, int gtid, int NGT) {
    const bf16_t* rwc = (const bf16_t*)(ws + WS_RWC); const bf16_t* c2 = (const bf16_t*)(ws + WS_C2); const bf16_t* yf = (const bf16_t*)(ws + WS_YF); const bf16_t* yb = (const bf16_t*)(ws + WS_YB);
    const bf16_t* sg = (const bf16_t*)(ws + WS_SG); const float* sb = (const float*)(ws + WS_SB); const bf16_t* hb = (const bf16_t*)(ws + WS_H);
    for (size_t i = gtid; i < (size_t)T * 1024; i += NGT) {
        const size_t m = i >> 10; const int c = (int)(i & 1023);
        float v = 0.f;
#if MK_DBG_WHAT == 0
        v = bflo(rwc[m * 2048 + 2 * c]) + bflo(rwc[m * 2048 + 2 * c + 1]);
#elif MK_DBG_WHAT == 1
        v = bflo(c2[m * 2304 + 2 * c]) + bflo(c2[m * 2304 + 2 * c + 1]) + (c < 256 ? bflo(c2[m * 2304 + 2048 + c]) : 0.f);
#elif MK_DBG_WHAT == 2
        v = (c < 512 ? bflo(yf[m * 512 + c]) : bflo(yb[m * 512 + c - 512]));
#elif MK_DBG_WHAT == 3
        v = (c < 256 ? bflo(sg[m * 256 + c]) : (c < 272 ? sb[((c - 256) >> 3) * (size_t)T * 8 + m * 8 + (c & 7)] : bflo(hb[m * 1024 + c])));
#elif MK_DBG_WHAT == 6
        v = bflo(((const bf16_t*)(ws + WS_WIN))[(size_t)(4352 + (m % 3072)) * 1024 + c]) + bflo(hb[m * 1024 + c]);
#elif MK_DBG_WHAT == 5
        v = bflo(((const bf16_t*)(ws + WS_GT))[m * 1024 + c]);
#elif MK_DBG_WHAT == 4
        v = bflo(rwc[(size_t)T * 1024 + m * 1024 + c]);
#endif
        p.out[i] = v;
    }
}
#else
#define DBG_STOP(k) do { } while (0)
#endif

#define L1_REFRESH() do { asm volatile("s_waitcnt vmcnt(0)" ::: "memory"); __builtin_amdgcn_fence(__ATOMIC_ACQUIRE, "agent"); asm volatile("s_waitcnt vmcnt(0)" ::: "memory"); } while (0)
#define PHASE_IDS() int tid = threadIdx.x; asm volatile("" : "+v"(tid)); const int lane = tid & 63, wave = __builtin_amdgcn_readfirstlane(tid >> 6); const int gw = vcu * 8 + wave, gtid = bx * 512 + tid; (void)lane; (void)gw; (void)gtid
#define Win_t ((bf16_t*)(ws + WS_WIN))
#define Wbr_t ((bf16_t*)(ws + WS_WBR))
#define Wout_t ((bf16_t*)(ws + WS_WOUT))
#define W1_t ((bf16_t*)(ws + WS_W1))
#define W2_t ((bf16_t*)(ws + WS_W2))
#define w2t ((bf16_t*)(ws + WS_W2T))
#define a2t ((bf16_t*)(ws + WS_A2T))
#define g2t ((bf16_t*)(ws + WS_G2T))
#define Hb ((bf16_t*)(ws + WS_H))
#define RWC ((bf16_t*)(ws + WS_RWC))
#define C2 ((bf16_t*)(ws + WS_C2))
#define YF ((bf16_t*)(ws + WS_YF))
#define YB ((bf16_t*)(ws + WS_YB))
#define SG ((bf16_t*)(ws + WS_SG))
#define VT ((bf16_t*)(ws + WS_VT))
#define SB ((float*)(ws + WS_SB))
#define Gt ((bf16_t*)(ws + WS_GT))
#define Mg ((bf16_t*)(ws + WS_MRG))
#define Ub ((bf16_t*)(ws + WS_U))
__global__ void __launch_bounds__(512, 2) fwd_megakernel(Params p) {
    extern __shared__ __attribute__((aligned(16))) unsigned char lds_raw[];
    LAS unsigned char* lds = (LAS unsigned char*)lds_raw;
    cg::grid_group grid = cg::this_grid();
    volatile LAS unsigned* misc = (volatile LAS unsigned*)(lds + 139264);
    if (threadIdx.x < 16) misc[threadIdx.x] = 0u;
    __syncthreads();
    XcdBarrier xbar = xcd_barrier_post((unsigned*)(p.ws + 65536), misc);
    grid.sync();
    const int G = gridDim.x, bx = blockIdx.x;
    const int vcu = (G % 8 == 0) ? (bx % 8) * (G / 8) + bx / 8 : bx;
    const int NGW = G * 8, NGT = G * 512;
    float* X = p.out;

    for (int l = 0; l < DEPTH; ++l) {
        const float* xin = (l == 0) ? p.in[0] : X;
        unsigned char* ws0 = p.ws; asm volatile("" : "+s"(ws0));
        GAS unsigned char* ws = (GAS unsigned char*)ws0;
        if (PHMASK & (1u << 0)) {
            PHASE_IDS();
            LAS float* scr = (LAS float*)(lds + wave * 8448);
            const float* w_in = p.in[2] + (size_t)l * D_MODEL * IN_COLS;
            const float* w_br = p.in[19] + (size_t)l * 3 * 512 * D_MODEL;
            const float* w_out = p.in[20] + (size_t)l * D_MODEL * D_MODEL;
            const float* w_m1 = p.in[22] + (size_t)l * D_MODEL * D_FF;
            const float* w_m2 = p.in[23] + (size_t)l * D_FF * D_MODEL;
            const float* rw_w2 = p.in[6] + (size_t)l * 2 * 64 * 512;
            const float* rw_a2 = p.in[8] + (size_t)l * 2 * 64 * 512;
            const float* rw_g2 = p.in[9] + (size_t)l * 128 * 512;
            constexpr int I_IN = 232 * 16, I_BR = 3 * 8 * 32, I_OUT = 16 * 32, I_M1 = 16 * 128, I_M2 = 64 * 32, I_L = 32, I_G = 32;
            constexpr int NITEMS = I_IN + I_BR + I_OUT + I_M1 + I_M2 + 2 * I_L + I_G;
            for (int it = gw; it < NITEMS; it += NGW) {
                int r = it;
                if (r < I_IN) { const int db = r % 232, kb = r / 232; int src;
                    if (db < 60) src = 32 * db;
                    else if (db < 64) {
                        const int c = lane & 7;
#pragma unroll
                        for (int j = 0; j < 4; ++j) { const int n = (lane >> 3) + 8 * j; *(u32x4*)(Win_t + (size_t)(32 * db + n) * D_MODEL + 64 * kb + 8 * c) = (u32x4){0u, 0u, 0u, 0u}; }
                        continue; }
                    else if (db < 112) src = 1920 + 32 * (db - 64);
                    else if (db < 136) { const int pp = 32 * (db - 112), tile = pp >> 8, c = pp & 255, bj = c >> 7, wc = (c & 127) >> 5; src = 3456 + tile * 256 + 64 * wc + 32 * bj; }
                    else src = 4224 + 32 * (db - 136);
                    transpose_item(w_in, IN_COLS, 64 * kb, src, Win_t, D_MODEL, 32 * db, scr, lane); continue; }
                r -= I_IN;
                if (r < I_BR) { const int bb = r / 256, q = r % 256, kb = q / 32, nb = q % 32;
                    transpose_item(w_br + (size_t)bb * 512 * D_MODEL, D_MODEL, 64 * kb, 32 * nb, Wbr_t + (size_t)bb * D_MODEL * 512, 512, 32 * nb, scr, lane); continue; }
                r -= I_BR;
                if (r < I_OUT) { transpose_item(w_out, D_MODEL, 64 * (r / 32), 32 * (r % 32), Wout_t, D_MODEL, 32 * (r % 32), scr, lane); continue; }
                r -= I_OUT;
                if (r < I_M1) { transpose_item(w_m1, D_FF, 64 * (r / 128), 32 * (r % 128), W1_t, D_MODEL, 32 * (r % 128), scr, lane); continue; }
                r -= I_M1;
                if (r < I_M2) { transpose_item(w_m2, D_MODEL, 64 * (r / 32), 32 * (r % 32), W2_t, D_FF, 32 * (r % 32), scr, lane); continue; }
                r -= I_M2;
                if (r < I_L) { const int dd = r / 16, nb = r % 16; transpose_item(rw_w2 + (size_t)dd * 64 * 512, 512, 0, 32 * nb, w2t + (size_t)dd * 512 * 64, 64, 32 * nb, scr, lane); continue; }
                r -= I_L;
                if (r < I_L) { const int dd = r / 16, nb = r % 16; transpose_item(rw_a2 + (size_t)dd * 64 * 512, 512, 0, 32 * nb, a2t + (size_t)dd * 512 * 64, 64, 32 * nb, scr, lane); continue; }
                r -= I_L;
                { const int kb = r / 16, nb = r % 16; transpose_item(rw_g2, 512, 64 * kb, 32 * nb, g2t, 256, 32 * nb, scr, lane); }
            }
            for (int i = gtid; i < 512 * 16; i += NGT) *(u32x4*)(g2t + (size_t)(i >> 4) * 256 + 128 + 8 * (i & 15)) = (u32x4){0u, 0u, 0u, 0u};
            if (l == 0) for (int i = gtid; i < T * 16; i += NGT) *(u32x4*)(SG + (size_t)(i >> 4) * 256 + 128 + 8 * (i & 15)) = (u32x4){0u, 0u, 0u, 0u};
            const float* g1 = p.in[1] + (size_t)l * D_MODEL;
            if (T % (2 * NGW) == 0) { for (int m = gw; m < T; m += 2 * NGW) rms_row2(xin + (size_t)m * D_MODEL, xin + (size_t)(m + NGW) * D_MODEL, g1, Hb + (size_t)m * D_MODEL, Hb + (size_t)(m + NGW) * D_MODEL, lane); }
            else { for (int m = gw; m < T; m += NGW) rms_row(xin + (size_t)m * D_MODEL, g1, Hb + (size_t)m * D_MODEL, lane); }
        }
        xcd_barrier(xbar);
        DBG_STOP(1);
        if (PHMASK & (1u << 1)) {
            pg8::StaticOrder S;
#ifndef SKIP_P2A
            { pg8::Gemm g{Hb, Win_t, T, 3584, D_MODEL, D_MODEL}; S.init(T, 3584, G, bx);
              pg8::EpiStore<0> E{RWC, LD_RWC, C2, LD_C2, 8}; pg8::gemm_phase(lds, g, S, E); }
#endif
#ifndef SKIP_P2B
            { pg8::Gemm g{Hb, Win_t + (size_t)3584 * D_MODEL, T, 768, D_MODEL, D_MODEL}; S.init(T, 768, G, bx);
              pg8::EpiAttn E{C2, VT, p.in[17] + l * 64, p.in[18] + l * 64}; pg8::gemm_phase(lds, g, S, E); }
#endif
        }
        xcd_barrier(xbar);
        DBG_STOP(2);
        if (PHMASK & (1u << 2)) {
            PHASE_IDS();
            const float* cvw = p.in[15] + (size_t)l * 3 * 512; const float* cvb = p.in[16] + (size_t)l * 512;
            ScanW sw{p.in[3] + (size_t)l * RW_COLS, p.in[4] + (size_t)l * RW_COLS, p.in[5] + (size_t)l * 1024, p.in[7] + (size_t)l * 1024,
                     p.in[10] + (size_t)l * 512, p.in[11] + (size_t)l * 512, p.in[12] + (size_t)l * 512, w2t, a2t};
#ifndef SKIP_SCAN
#ifdef MK_DUP_SCAN
            for (int u = vcu; u < 256; u += G) { scan_unit(lds, RWC, YF, YB, SG, SB, sw, u >> 4, (u >> 1) & 7, u & 1, C2, cvw, cvb, u); __syncthreads(); }
#endif
            for (int u = vcu; u < 256; u += G) { scan_unit(lds, RWC, YF, YB, SG, SB, sw, u >> 4, (u >> 1) & 7, u & 1, C2, cvw, cvb, u); __syncthreads(); }
#endif
#ifndef SKIP_ATTN
#ifdef MK_DUP_ATTN
            for (int u = vcu; u < 1024; u += G) { attn_unit(lds, C2, (bf16_t*)(ws + 892 * MiB), u >> 6, (u >> 5) & 1, u & 31); }
#endif
            for (int u = vcu; u < 1024; u += G) { attn_unit(lds, C2, nullptr, u >> 6, (u >> 5) & 1, u & 31); }
#endif
        }
        xcd_barrier(xbar);
        DBG_STOP(3);
        if (PHMASK & (1u << 3)) {
            PHASE_IDS();
            const float* mup = p.in[3] + (size_t)l * RW_COLS + 1024; const float* mun = p.in[4] + (size_t)l * RW_COLS + 1024;
            const float* lng = p.in[13] + (size_t)l * 512; const float* lnb = p.in[14] + (size_t)l * 512;
            for (int m = gw; m < T; m += NGW) {
                const int t = m & 4095, c0 = 8 * lane, hh = lane >> 3;
                float yf[8], yb[8], vc[8], vpv[8], vn[8], y[8];
                unpack8(*(const u32x4*)(YF + (size_t)m * 512 + c0), yf); unpack8(*(const u32x4*)(YB + (size_t)m * 512 + c0), yb);
                const bf16_t* rp = RWC + (size_t)m * LD_RWC + 1024 + c0;
                unpack8(*(const u32x4*)rp, vc);
                if (t > 0) unpack8(*(const u32x4*)(rp - LD_RWC), vpv); else {
#pragma unroll
                    for (int j = 0; j < 8; ++j) vpv[j] = 0.f; }
                if (t < SEQ - 1) unpack8(*(const u32x4*)(rp + LD_RWC), vn); else {
#pragma unroll
                    for (int j = 0; j < 8; ++j) vn[j] = 0.f; }
                float s = 0.f;
#pragma unroll
                for (int j = 0; j < 8; ++j) { y[j] = yf[j] + yb[j]; s += y[j]; }
                const float mean = red8(s) * (1.f / 64.f);
                float q = 0.f;
#pragma unroll
                for (int j = 0; j < 8; ++j) { y[j] -= mean; q += y[j] * y[j]; }
                const float rstd = __builtin_amdgcn_rsqf(red8(q) * (1.f / 64.f) + 64e-5f);
                const float bs = 0.5f * (SB[(size_t)m * 8 + hh] + SB[((size_t)T + m) * 8 + hh]);
                float o[8];
#pragma unroll
                for (int j = 0; j < 8; ++j) { const float zv = vc[j] + mup[c0 + j] * (vpv[j] - vc[j]) + mun[c0 + j] * (vn[j] - vc[j]);
                    o[j] = y[j] * rstd * lng[c0 + j] + lnb[c0 + j] + bs * zv; }
                *(u32x4*)(YF + (size_t)m * 512 + c0) = pack8(o);
            }
        }
        xcd_barrier(xbar);
        DBG_STOP(4);
        if (PHMASK & (1u << 4)) {
            pg8::StaticOrder S; pg8::Gemm g{SG, g2t, T, 512, 256, 256}; S.init(T, 512, G, bx);
            pg8::EpiMulInPlace E{YF, 512}; pg8::gemm_phase(lds, g, S, E);
        }
        xcd_barrier(xbar);
        DBG_STOP(5);
        if (PHMASK & (1u << 5)) {
            pg8::StaticOrder S; S.init(T, 1024, G, bx);
            const bf16_t* Wg = Win_t + (size_t)4352 * D_MODEL;
            if (P4_CALLS >= 1)
            { pg8::Gemm g{Hb, Wg, T, 1024, D_MODEL, D_MODEL}; pg8::EpiStore<MK_GATE_ACT> E{Gt, D_MODEL, Gt, D_MODEL, 1 << 20}; pg8::gemm_phase(lds, g, S, E); }
            L1_REFRESH();
            if (P4_CALLS >= 2)
            { pg8::Gemm g{YF, Wbr_t, T, 1024, 512, 512}; pg8::EpiBranch<true> E{Gt, Mg}; pg8::gemm_phase(lds, g, S, E); }
            if (P4_CALLS >= 3)
            { pg8::Gemm g{Hb, Wg + (size_t)1024 * D_MODEL, T, 1024, D_MODEL, D_MODEL}; pg8::EpiStore<1> E{Gt, D_MODEL, Gt, D_MODEL, 1 << 20}; pg8::gemm_phase(lds, g, S, E); }
            L1_REFRESH();
            if (P4_CALLS >= 4)
            { pg8::Gemm g{C2, Wbr_t + (size_t)1024 * 512, T, 1024, 512, LD_C2}; pg8::EpiBranch<false> E{Gt, Mg}; pg8::gemm_phase(lds, g, S, E); }
            if (P4_CALLS >= 5)
            { pg8::Gemm g{Hb, Wg + (size_t)2048 * D_MODEL, T, 1024, D_MODEL, D_MODEL}; pg8::EpiStore<1> E{Gt, D_MODEL, Gt, D_MODEL, 1 << 20}; pg8::gemm_phase(lds, g, S, E); }
            L1_REFRESH();
            if (P4_CALLS >= 6)
            { pg8::Gemm g{C2 + 1536, Wbr_t + (size_t)2048 * 512, T, 1024, 512, LD_C2}; pg8::EpiBranch<false> E{Gt, Mg}; pg8::gemm_phase(lds, g, S, E); }
        }
        xcd_barrier(xbar);
        DBG_STOP(6);
        if (PHMASK & (1u << 6)) {
            pg8::StaticOrder S; S.init(T, 1024, G, bx);
            pg8::Gemm g{Mg, Wout_t, T, 1024, D_MODEL, D_MODEL}; pg8::EpiResidual E{xin, X}; pg8::gemm_phase(lds, g, S, E);
        }
        xcd_barrier(xbar);
        DBG_STOP(7);
        if (PHMASK & (1u << 7)) {
            PHASE_IDS();
            const float* g2 = p.in[21] + (size_t)l * D_MODEL;
            if (T % (2 * NGW) == 0) { for (int m = gw; m < T; m += 2 * NGW) rms_row2(X + (size_t)m * D_MODEL, X + (size_t)(m + NGW) * D_MODEL, g2, Hb + (size_t)m * D_MODEL, Hb + (size_t)(m + NGW) * D_MODEL, lane); }
            else { for (int m = gw; m < T; m += NGW) rms_row(X + (size_t)m * D_MODEL, g2, Hb + (size_t)m * D_MODEL, lane); }
        }
        xcd_barrier(xbar);
        DBG_STOP(8);
        if (PHMASK & (1u << 8)) {
            pg8::StaticOrder S; S.init(T, D_FF, G, bx);
            pg8::Gemm g{Hb, W1_t, T, D_FF, D_MODEL, D_MODEL}; pg8::EpiStore<2> E{Ub, D_FF, Ub, D_FF, 1 << 20}; pg8::gemm_phase(lds, g, S, E);
#ifdef MK_DUP_P7
            pg8::gemm_phase(lds, g, S, E);
#endif
        }
        xcd_barrier(xbar);
        DBG_STOP(9);
        if (PHMASK & (1u << 9)) {
            pg8::StaticOrder S; S.init(T, 1024, G, bx);
            pg8::Gemm g{Ub, W2_t, T, 1024, D_FF, D_FF}; pg8::EpiResidual E{X, X}; pg8::gemm_phase(lds, g, S, E);
        }
        xcd_barrier(xbar);
        DBG_STOP(10);
    }
}

extern "C" void kernel_launch(void* const* d_in, const int* in_sizes, int n_in, void* d_out, int out_size, void* d_ws, size_t ws_size, hipStream_t stream) {
    static int grid = 0;
    if (grid == 0) {
        if (n_in != 24 || out_size != T * D_MODEL || ws_size < WS_END) { fprintf(stderr, "kernel_launch: unexpected shapes (n_in %d out %d ws %zu)\n", n_in, out_size, ws_size); grid = -1; return; }
        int dev = 0, cus = 0, per_cu = 0;
        hipGetDevice(&dev);
        hipDeviceGetAttribute(&cus, hipDeviceAttributeMultiprocessorCount, dev);
        hipFuncSetAttribute((const void*)fwd_megakernel, hipFuncAttributeMaxDynamicSharedMemorySize, LDS_BYTES);
        hipOccupancyMaxActiveBlocksPerMultiprocessor(&per_cu, (const void*)fwd_megakernel, 512, LDS_BYTES);
        if (per_cu < 1) { fprintf(stderr, "kernel_launch: occupancy query says %d blocks per CU\n", per_cu); per_cu = 1; }
        (void)hipGetLastError();
        grid = cus;
    }
    if (grid < 0) return;
    if (hipMemsetAsync(d_ws, 0, 1u << 20, stream) != hipSuccess) { fprintf(stderr, "kernel_launch: memset failed\n"); return; }
    Params p{};
    for (int i = 0; i < 24; ++i) p.in[i] = (const float*)d_in[i];
    p.out = (float*)d_out; p.ws = (unsigned char*)d_ws;
    void* args[] = {&p};
    hipError_t e = hipLaunchCooperativeKernel((const void*)fwd_megakernel, dim3(grid), dim3(512), args, LDS_BYTES, stream);
    if (e != hipSuccess) fprintf(stderr, "cooperative launch failed: %s (grid %d)\n", hipGetErrorString(e), grid);
}
```

```cpp
#include <hip/hip_runtime.h>
#include <hip/hip_cooperative_groups.h>
#include <cstdio>
#include <cstdint>
namespace cg = cooperative_groups;

#define LAS __attribute__((address_space(3)))
#define GAS __attribute__((address_space(1)))
typedef unsigned short bf16_t;
typedef short bf16x8 __attribute__((ext_vector_type(8)));
typedef short bf16x4 __attribute__((ext_vector_type(4)));
typedef float f32x2 __attribute__((ext_vector_type(2)));
typedef float f32x4 __attribute__((ext_vector_type(4)));
typedef float f32x16 __attribute__((ext_vector_type(16)));
typedef unsigned u32x2 __attribute__((ext_vector_type(2)));
typedef unsigned u32x4 __attribute__((ext_vector_type(4)));

constexpr int D_MODEL = 1024, BATCH = 16, SEQ = 4096, DEPTH = 4, D_FF = 4096;
constexpr int T = BATCH * SEQ;
constexpr int IN_COLS = 7296, RW_COLS = 1920;
constexpr int NWIN = 7424;
constexpr int LD_RWC = 2048, LD_C2 = 2304;
constexpr float LOG2E = 1.4426950408889634f;

constexpr size_t MiB = 1u << 20;
constexpr size_t WS_WIN = 2 * MiB, WS_WBR = 17 * MiB, WS_WOUT = 20 * MiB, WS_W1 = 22 * MiB, WS_W2 = 30 * MiB;
constexpr size_t WS_W2T = 38 * MiB, WS_A2T = 38 * MiB + 131072, WS_G2T = 38 * MiB + 262144;
constexpr size_t WS_H = 40 * MiB, WS_RWC = 168 * MiB, WS_C2 = 424 * MiB, WS_YF = 712 * MiB, WS_YB = 776 * MiB;
constexpr size_t WS_SG = 840 * MiB, WS_VT = 872 * MiB, WS_SB = 888 * MiB, WS_END = 892 * MiB;
#ifdef MK_GT_FRESH
constexpr size_t WS_GT = 892 * MiB;
#else
constexpr size_t WS_GT = WS_RWC;
#endif
constexpr size_t WS_MRG = WS_RWC + 128 * MiB, WS_U = WS_RWC;

#ifndef MK_GATE_ACT
#define MK_GATE_ACT 1
#endif
#ifndef MK_P4_CALLS
#define MK_P4_CALLS 6
#endif
constexpr int P4_CALLS = MK_P4_CALLS;
#ifndef MK_PHMASK
#define MK_PHMASK 0xffffffffu
#endif
constexpr unsigned PHMASK = MK_PHMASK;
constexpr int LDS_BYTES = 140288;

typedef __bf16 bf16x2_t __attribute__((ext_vector_type(2)));
__device__ __forceinline__ unsigned cvt_pk_bf16(float lo, float hi) { const f32x2 v = {lo, hi}; const bf16x2_t b = __builtin_convertvector(v, bf16x2_t); return __builtin_bit_cast(unsigned, b); }
__device__ __forceinline__ bf16_t f2bf(float f) { return (bf16_t)(cvt_pk_bf16(f, 0.f) & 0xffffu); }
__device__ __forceinline__ float bflo(unsigned u) { return __builtin_bit_cast(float, u << 16); }
__device__ __forceinline__ float bfhi(unsigned u) { return __builtin_bit_cast(float, u & 0xffff0000u); }
__device__ __forceinline__ void unpack8(const u32x4 v, float* f) { f[0] = bflo(v.x); f[1] = bfhi(v.x); f[2] = bflo(v.y); f[3] = bfhi(v.y); f[4] = bflo(v.z); f[5] = bfhi(v.z); f[6] = bflo(v.w); f[7] = bfhi(v.w); }
__device__ __forceinline__ u32x4 pack8(const float* f) { u32x4 w; w.x = cvt_pk_bf16(f[0], f[1]); w.y = cvt_pk_bf16(f[2], f[3]); w.z = cvt_pk_bf16(f[4], f[5]); w.w = cvt_pk_bf16(f[6], f[7]); return w; }
__device__ __forceinline__ float trans_settle(float x) { float r; asm volatile("s_nop 1\n\tv_mov_b32 %0, %1" : "=v"(r) : "v"(x)); return r; }
__device__ __forceinline__ float sigmoid_f(float x) { return __builtin_amdgcn_rcpf(1.f + __builtin_amdgcn_exp2f(-LOG2E * x)); }
__device__ __forceinline__ float tanh_f(float x) { return 1.f - 2.f * __builtin_amdgcn_rcpf(1.f + __builtin_amdgcn_exp2f(2.f * LOG2E * x)); }
__device__ __forceinline__ float wave_sum(float v) {
#pragma unroll
    for (int o = 1; o < 64; o <<= 1) v += __shfl_xor(v, o);
    return v;
}
template <int CTRL> __device__ __forceinline__ float dpp_f(float x) { return __builtin_bit_cast(float, __builtin_amdgcn_update_dpp(0, __builtin_bit_cast(int, x), CTRL, 0xf, 0xf, true)); }
__device__ __forceinline__ float red8(float x) { x += dpp_f<0xB1>(x); x += dpp_f<0x4E>(x); x += dpp_f<0x141>(x); return x; }
__device__ __forceinline__ float red16(float x) { x = red8(x); x += dpp_f<0x140>(x); return x; }

namespace pg8 {
constexpr int BM = 256, BK = 64, HALF = 128, HTB = HALF * BK * 2, STAGE_BYTES = 8 * HTB, NXCD = 8, WGM = 8;
__host__ __device__ __forceinline__ int lds_byte(int r, int c) { const int st = (r >> 4) * 2 + (c >> 5), rr = r & 15, cc = c & 31, ob = rr * 64 + cc * 2; return st * 1024 + (ob ^ (((ob >> 9) & 1) << 5)); }
__host__ __device__ __forceinline__ void stage_rc(int b, int& R, int& C) { const int st = b / 1024, sb = b % 1024, swz = sb ^ (((sb >> 9) & 1) << 5); R = (st >> 1) * 16 + swz / 64; C = (st & 1) * 32 + (swz % 64) / 2; }
__host__ __device__ __forceinline__ int perm32(int rho) { const int n = rho >> 4, i = rho & 15; return 8 * (i >> 2) + 4 * n + (i & 3); }

struct Unit { int pm, pn; };
struct Gemm { const bf16_t* A; const bf16_t* Bt; int M, N, K, lda; };

struct StaticOrder {
    int nM, nN, nwg, G, c;
    __device__ void init(int M, int N, int G_, int c_) { nM = M / BM; nN = N / BM; nwg = nM * nN; G = G_; c = c_; }
    __device__ bool next(int i, Unit& u) const {
        const long L = (long)i * G + c; if (L >= nwg) return false;
        int wgid = (int)L; { const int q = nwg / NXCD, r = nwg % NXCD, xcd = wgid % NXCD, off = wgid / NXCD; wgid = (xcd < r ? xcd * (q + 1) : r * (q + 1) + (xcd - r) * q) + off; }
        const int nig = WGM * nN, gid = wgid / nig, fm = gid * WGM, gsz = (nM - fm) < WGM ? (nM - fm) : WGM;
        u.pm = fm + ((wgid % nig) % gsz); u.pn = (wgid % nig) / gsz; return true;
    }
};

template <class Epi>
__device__ __forceinline__ void gemm_phase(LAS unsigned char* lds, const Gemm g, const StaticOrder& S, const Epi& E) {
    int tid = threadIdx.x; asm volatile("" : "+v"(tid));
    const int wid = __builtin_amdgcn_readfirstlane(tid >> 6), lane = tid & 63, wr = wid >> 2, wc = wid & 3, fr = lane & 15, fq = lane >> 4;
    const int K = g.K, nt = K / BK, lda = g.lda;
    unsigned voffA[2], voffB[2];
#pragma unroll
    for (int i = 0; i < 2; ++i) { int R, C; stage_rc(tid * 16 + i * 8192, R, C); const int Rb = Epi::PERM ? ((R & ~31) + perm32(R & 31)) : R;
        voffA[i] = (unsigned)(R * lda + C) * 2u; voffB[i] = (unsigned)(Rb * K + C) * 2u; }
    const size_t kstep = (size_t)(BK * 2);
    const size_t hstepA = (size_t)HALF * lda * 2, hstepB = (size_t)HALF * K * 2;
    const size_t tstepA = 2 * hstepA, tstepB = 2 * hstepB;
    const unsigned ldsw = (unsigned)wid * 1024u;
    const int aoff = lds_byte(wr * 64 + fr, fq * 8), boff = lds_byte(wc * 32 + fr, fq * 8);
#define PG8_SA(b, h) (((b) * 2 + (h)) * HTB)
#define PG8_SB(b, h) ((4 + (b) * 2 + (h)) * HTB)
#define PG8_STAGE(bufoff, gbase, voff) do { _Pragma("unroll") for (int _i = 0; _i < 2; ++_i) \
        __builtin_amdgcn_global_load_lds((const unsigned*)((const char*)(gbase) + (voff)[_i]), (LAS unsigned*)(lds + (bufoff) + ldsw + _i * 8192), 16, 0, 0); } while (0)
#define PG8_LDA(dst, b, h) do { _Pragma("unroll") for (int m = 0; m < 4; ++m) _Pragma("unroll") for (int k = 0; k < 2; ++k) dst[m][k] = *(const LAS bf16x8*)(lds + PG8_SA(b, h) + aoff + m * 2048 + k * 1024); } while (0)
#define PG8_LDB(dst, b, h) do { _Pragma("unroll") for (int n = 0; n < 2; ++n) _Pragma("unroll") for (int k = 0; k < 2; ++k) dst[n][k] = *(const LAS bf16x8*)(lds + PG8_SB(b, h) + boff + n * 2048 + k * 1024); } while (0)
#define PG8_MMA(ai, bj, At, Bt) do { __builtin_amdgcn_s_setprio(1); _Pragma("unroll") for (int m = 0; m < 4; ++m) _Pragma("unroll") for (int n = 0; n < 2; ++n) _Pragma("unroll") for (int k = 0; k < 2; ++k) \
        acc[ai][bj][m][n] = __builtin_amdgcn_mfma_f32_16x16x32_bf16(Bt[n][k], At[m][k], acc[ai][bj][m][n], 0, 0, 0); __builtin_amdgcn_s_setprio(0); } while (0)
#define PG8_WAIT_V(n) asm volatile("s_waitcnt vmcnt(" #n ")" ::: "memory")
#define PG8_WAIT_L(n) asm volatile("s_waitcnt lgkmcnt(" #n ")" ::: "memory")
#define PG8_BAR __builtin_amdgcn_s_barrier()
#define PG8_SCHED __builtin_amdgcn_sched_barrier(0)
    Unit cur, nxt; int ui = 0;
    if (!S.next(0, cur)) return;
    f32x4 acc[2][2][4][2];
#pragma unroll
    for (int a = 0; a < 2; ++a)
#pragma unroll
        for (int b = 0; b < 2; ++b)
#pragma unroll
            for (int m = 0; m < 4; ++m)
#pragma unroll
                for (int n = 0; n < 2; ++n) acc[a][b][m][n] = (f32x4){0.f, 0.f, 0.f, 0.f};
    bf16x8 At[4][2], B0[2][2], B1[2][2];
    const char* cA = (const char*)g.A + (size_t)cur.pm * tstepA; const char* cB = (const char*)g.Bt + (size_t)cur.pn * tstepB;
    PG8_STAGE(PG8_SB(0, 0), cB, voffB); PG8_STAGE(PG8_SB(0, 1), cB + hstepB, voffB); PG8_STAGE(PG8_SA(0, 0), cA, voffA); PG8_STAGE(PG8_SA(0, 1), cA + hstepA, voffA);
    if (wr == 1) PG8_BAR;
    PG8_WAIT_V(2); PG8_BAR;
    PG8_STAGE(PG8_SB(1, 0), cB + kstep, voffB); PG8_STAGE(PG8_SA(1, 0), cA + kstep, voffA); PG8_STAGE(PG8_SB(1, 1), cB + hstepB + kstep, voffB);
    PG8_WAIT_V(6); PG8_BAR;
    for (;;) {
        const bool has_next = S.next(ui + 1, nxt);
        const char* nA = has_next ? (const char*)g.A + (size_t)nxt.pm * tstepA : cA; const char* nB = has_next ? (const char*)g.Bt + (size_t)nxt.pn * tstepB : cB;
#pragma nounroll
        for (int t = 0; t < nt; t += 2) {
            const bool last = (t == nt - 2);
            const char* a1 = cA + (size_t)(t + 1) * kstep;
            const char* a2 = last ? nA : cA + (size_t)(t + 2) * kstep; const char* b2 = last ? nB : cB + (size_t)(t + 2) * kstep;
            const char* a3 = a2 + kstep; const char* b3 = b2 + kstep;
            PG8_LDB(B0, 0, 0); PG8_LDB(B1, 0, 1); PG8_SCHED; PG8_LDA(At, 0, 0); PG8_STAGE(PG8_SA(1, 1), a1 + hstepA, voffA);
            PG8_WAIT_V(8); PG8_WAIT_L(0); PG8_BAR; PG8_MMA(0, 0, At, B0); PG8_MMA(0, 1, At, B1); PG8_BAR; PG8_SCHED;
            PG8_LDA(At, 0, 1); PG8_STAGE(PG8_SB(0, 0), b2, voffB); PG8_STAGE(PG8_SB(0, 1), b2 + hstepB, voffB); PG8_STAGE(PG8_SA(0, 0), a2, voffA);
            PG8_WAIT_V(8); PG8_WAIT_L(0); PG8_BAR; PG8_MMA(1, 0, At, B0); PG8_MMA(1, 1, At, B1); PG8_BAR; PG8_SCHED;
            PG8_LDB(B0, 1, 0); PG8_LDB(B1, 1, 1); PG8_SCHED; PG8_LDA(At, 1, 0); PG8_STAGE(PG8_SA(0, 1), a2 + hstepA, voffA);
            PG8_WAIT_V(8); PG8_WAIT_L(0); PG8_BAR; PG8_MMA(0, 0, At, B0); PG8_MMA(0, 1, At, B1); PG8_BAR; PG8_SCHED;
            PG8_LDA(At, 1, 1); PG8_STAGE(PG8_SB(1, 0), b3, voffB); PG8_STAGE(PG8_SB(1, 1), b3 + hstepB, voffB); PG8_STAGE(PG8_SA(1, 0), a3, voffA);
            PG8_WAIT_V(8); PG8_WAIT_L(0); PG8_BAR; PG8_MMA(1, 0, At, B0); PG8_MMA(1, 1, At, B1); PG8_BAR; PG8_SCHED;
        }
        if (wr == 0) PG8_BAR;
        E(acc, cur, wr, wc, fr, fq);
        if (!has_next) break;
#pragma unroll
        for (int a = 0; a < 2; ++a)
#pragma unroll
            for (int b = 0; b < 2; ++b)
#pragma unroll
                for (int m = 0; m < 4; ++m)
#pragma unroll
                    for (int n = 0; n < 2; ++n) acc[a][b][m][n] = (f32x4){0.f, 0.f, 0.f, 0.f};
        cur = nxt; cA = nA; cB = nB; ++ui;
        if (wr == 1) PG8_BAR;
    }
    PG8_WAIT_V(0);
    PG8_BAR;
#undef PG8_SA
#undef PG8_SB
#undef PG8_STAGE
#undef PG8_LDA
#undef PG8_LDB
#undef PG8_MMA
#undef PG8_WAIT_V
#undef PG8_WAIT_L
#undef PG8_BAR
#undef PG8_SCHED
}

#define EPI_FENCE() do { asm volatile("" ::: "memory"); __builtin_amdgcn_sched_barrier(0); } while (0)
template <int ACT> struct EpiStore {
    static constexpr bool PERM = true;
    bf16_t* O0; int ld0; bf16_t* O1; int ld1; int pn_split;
    __device__ __forceinline__ void operator()(const f32x4 (&acc)[2][2][4][2], const Unit& u, int wr, int wc, int fr, int fq) const {
        bf16_t* base; int ld, colt;
        if (u.pn < pn_split) { base = O0; ld = ld0; colt = u.pn * BM; } else { base = O1; ld = ld1; colt = (u.pn - pn_split) * BM; }
        const int row0 = u.pm * BM + wr * 64 + fr, col0 = colt + wc * 32 + 8 * fq;
#pragma unroll
        for (int ai = 0; ai < 2; ++ai)
#pragma unroll
            for (int m = 0; m < 4; ++m) { bf16_t* rowp = base + (size_t)(row0 + ai * HALF + m * 16) * ld + col0;
#pragma unroll
                for (int bj = 0; bj < 2; ++bj) { float v[8];
#pragma unroll
                    for (int j = 0; j < 4; ++j) { v[j] = acc[ai][bj][m][0][j]; v[4 + j] = acc[ai][bj][m][1][j]; }
#pragma unroll
                    for (int j = 0; j < 8; ++j) { if (ACT == 1) v[j] = sigmoid_f(v[j]); if (ACT == 2) { const float r = fmaxf(v[j], 0.f); v[j] = r * r; } }
                    *(u32x4*)(rowp + bj * HALF) = pack8(v); }
                EPI_FENCE(); }
    }
};
struct EpiResidual {
    static constexpr bool PERM = false;
    const float* xin; float* xout;
    __device__ __forceinline__ void operator()(const f32x4 (&acc)[2][2][4][2], const Unit& u, int wr, int wc, int fr, int fq) const {
        const int row0 = u.pm * BM + wr * 64 + fr, col0 = u.pn * BM + wc * 32 + 4 * fq;
#pragma unroll
        for (int ai = 0; ai < 2; ++ai)
#pragma unroll
            for (int m = 0; m < 4; ++m) { const size_t off = (size_t)(row0 + ai * HALF + m * 16) * D_MODEL + col0;
#pragma unroll
                for (int bj = 0; bj < 2; ++bj)
#pragma unroll
                    for (int n = 0; n < 2; ++n) { const f32x4 b = *(const f32x4*)(xin + off + bj * HALF + n * 16); *(f32x4*)(xout + off + bj * HALF + n * 16) = b + acc[ai][bj][m][n]; } }
    }
};
struct EpiMulInPlace {
    static constexpr bool PERM = true;
    bf16_t* Y; int ld;
    __device__ __forceinline__ void operator()(const f32x4 (&acc)[2][2][4][2], const Unit& u, int wr, int wc, int fr, int fq) const {
        const int row0 = u.pm * BM + wr * 64 + fr, col0 = u.pn * BM + wc * 32 + 8 * fq;
#pragma unroll
        for (int ai = 0; ai < 2; ++ai)
#pragma unroll
            for (int m = 0; m < 4; ++m) { bf16_t* rowp = Y + (size_t)(row0 + ai * HALF + m * 16) * ld + col0;
#pragma unroll
                for (int bj = 0; bj < 2; ++bj) { float y[8]; unpack8(*(const u32x4*)(rowp + bj * HALF), y);
#pragma unroll
                    for (int j = 0; j < 4; ++j) { y[j] *= acc[ai][bj][m][0][j]; y[4 + j] *= acc[ai][bj][m][1][j]; }
                    *(u32x4*)(rowp + bj * HALF) = pack8(y); }
                EPI_FENCE(); }
    }
};
template <bool FIRST> struct EpiBranch {
    static constexpr bool PERM = true;
    const bf16_t* Gt; bf16_t* Mg;
    __device__ __forceinline__ void operator()(const f32x4 (&acc)[2][2][4][2], const Unit& u, int wr, int wc, int fr, int fq) const {
        const int row0 = u.pm * BM + wr * 64 + fr, col0 = u.pn * BM + wc * 32 + 8 * fq;
#pragma unroll
        for (int ai = 0; ai < 2; ++ai) {
            u32x4 gq[4][2], mq[4][2];
#pragma unroll
            for (int m = 0; m < 4; ++m) { const size_t off = (size_t)(row0 + ai * HALF + m * 16) * D_MODEL + col0;
#pragma unroll
                for (int bj = 0; bj < 2; ++bj) { gq[m][bj] = *(const u32x4*)(Gt + off + bj * HALF); if (!FIRST) mq[m][bj] = *(const u32x4*)(Mg + off + bj * HALF); } }
#pragma unroll
            for (int m = 0; m < 4; ++m) { const size_t off = (size_t)(row0 + ai * HALF + m * 16) * D_MODEL + col0;
#pragma unroll
                for (int bj = 0; bj < 2; ++bj) { float gt[8], o[8]; unpack8(gq[m][bj], gt);
                    if (FIRST) {
#pragma unroll
                        for (int j = 0; j < 8; ++j) o[j] = 0.f;
                    } else unpack8(mq[m][bj], o);
#pragma unroll
                    for (int j = 0; j < 4; ++j) { o[j] += gt[j] * acc[ai][bj][m][0][j]; o[4 + j] += gt[4 + j] * acc[ai][bj][m][1][j]; }
                    *(u32x4*)(Mg + off + bj * HALF) = pack8(o); } }
            EPI_FENCE(); }
    }
};
struct EpiAttn {
    static constexpr bool PERM = false;
    bf16_t* C2; bf16_t* VT; const float* qg; const float* kg;
    __device__ __forceinline__ void operator()(const f32x4 (&acc)[2][2][4][2], const Unit& u, int wr, int wc, int fr, int fq) const {
        if (u.pn == 2 && wc >= 2) {
#pragma unroll
            for (int ai = 0; ai < 2; ++ai)
#pragma unroll
                for (int m = 0; m < 4; ++m) { const int row = u.pm * BM + ai * HALF + wr * 64 + m * 16 + fr;
                    bf16_t* rowp = C2 + (size_t)row * LD_C2 + 2048 + wc * 64 + 4 * fq;
#pragma unroll
                    for (int bj = 0; bj < 2; ++bj)
#pragma unroll
                        for (int n = 0; n < 2; ++n) { const f32x4 x = acc[ai][bj][m][n]; u32x2 w; w.x = cvt_pk_bf16(x[0], x[1]); w.y = cvt_pk_bf16(x[2], x[3]); *(u32x2*)(rowp + 32 * bj + 16 * n) = w; }
                    EPI_FENCE(); }
        } else {
            const bool isK = (u.pn == 2);
            int opq = 0; asm volatile("" : "+v"(opq));
            fq += opq; fr += opq;
            const float* gp = isK ? kg : qg;
            const int colbase = isK ? (2048 + wc * 64) : (1536 + (u.pn * 4 + wc) * 64);
            const float sc = isK ? 1.f : 0.125f * LOG2E;
            float gv[2][2][4], invf[4];
#pragma unroll
            for (int bj = 0; bj < 2; ++bj)
#pragma unroll
                for (int n = 0; n < 2; ++n)
#pragma unroll
                    for (int j = 0; j < 4; ++j) gv[bj][n][j] = gp[32 * bj + 16 * n + 4 * fq + j] * sc;
#pragma unroll
            for (int j = 0; j < 4; ++j) invf[j] = __builtin_amdgcn_exp2f(-(float)(4 * fq + j) * (13.287712379549449f / 16.f));
#pragma unroll
            for (int ai = 0; ai < 2; ++ai)
#pragma unroll
                for (int m = 0; m < 4; ++m) { const int row = u.pm * BM + ai * HALF + wr * 64 + m * 16 + fr; const int t = row & 4095;
                    float ss = 0.f;
#pragma unroll
                    for (int bj = 0; bj < 2; ++bj)
#pragma unroll
                        for (int n = 0; n < 2; ++n) { const f32x4 x = acc[ai][bj][m][n]; ss += (x[0] * x[0] + x[1] * x[1]) + (x[2] * x[2] + x[3] * x[3]); }
                    ss += __shfl_xor(ss, 16); ss += __shfl_xor(ss, 32);
                    const float rinv = __builtin_amdgcn_rsqf(ss * (1.f / 64.f) + 1e-6f);
                    bf16_t* rowp = C2 + (size_t)row * LD_C2 + colbase + 4 * fq;
#pragma unroll
                    for (int bj = 0; bj < 2; ++bj) { const float pos = (float)(bj ? (t & 63) : (t >> 6)); float o1[4], o2[4];
#pragma unroll
                        for (int j = 0; j < 4; ++j) { const float ang = pos * invf[j], c = __cosf(ang), s = __sinf(ang);
                            const float x1 = acc[ai][bj][m][0][j] * rinv * gv[bj][0][j], x2 = acc[ai][bj][m][1][j] * rinv * gv[bj][1][j];
                            o1[j] = x1 * c - x2 * s; o2[j] = x2 * c + x1 * s; }
                        u32x2 w1, w2; w1.x = cvt_pk_bf16(o1[0], o1[1]); w1.y = cvt_pk_bf16(o1[2], o1[3]); w2.x = cvt_pk_bf16(o2[0], o2[1]); w2.y = cvt_pk_bf16(o2[2], o2[3]);
                        *(u32x2*)(rowp + 32 * bj) = w1; *(u32x2*)(rowp + 32 * bj + 16) = w2; }
                    EPI_FENCE(); }
        }
    }
};
}

struct Params { const float* in[24]; float* out; unsigned char* ws; };

__device__ __forceinline__ void transpose_item(const float* W, int ldw, int k0, int n_src, bf16_t* WT, int ldt, int dst_row0, LAS float* scr, int lane) {
#pragma unroll 8
    for (int i = 0; i < 32; ++i) { const int kk = 2 * i + (lane >> 5); scr[kk * 33 + (lane & 31)] = W[(size_t)(k0 + kk) * ldw + n_src + (lane & 31)]; }
    asm volatile("s_waitcnt lgkmcnt(0)" ::: "memory");
    const int c = lane & 7;
#pragma unroll
    for (int j = 0; j < 4; ++j) { const int n = (lane >> 3) + 8 * j; const LAS float* s = scr + (8 * c) * 33 + n;
        u32x4 o; o.x = cvt_pk_bf16(s[0 * 33], s[1 * 33]); o.y = cvt_pk_bf16(s[2 * 33], s[3 * 33]); o.z = cvt_pk_bf16(s[4 * 33], s[5 * 33]); o.w = cvt_pk_bf16(s[6 * 33], s[7 * 33]);
        *(u32x4*)(WT + (size_t)(dst_row0 + n) * ldt + k0 + 8 * c) = o; }
    asm volatile("s_waitcnt lgkmcnt(0)" ::: "memory");
}
__device__ __forceinline__ void rms_row2(const float* xrow0, const float* xrow1, const float* g, bf16_t* orow0, bf16_t* orow1, int lane) {
    const f32x4* xr0 = (const f32x4*)xrow0 + lane; const f32x4* xr1 = (const f32x4*)xrow1 + lane; const f32x4* gr = (const f32x4*)g + lane;
    f32x4 v0[4], v1[4]; float s0 = 0.f, s1 = 0.f;
#pragma unroll
    for (int j = 0; j < 4; ++j) { v0[j] = xr0[64 * j]; v1[j] = xr1[64 * j]; }
#pragma unroll
    for (int j = 0; j < 4; ++j) { s0 += (v0[j].x * v0[j].x + v0[j].y * v0[j].y) + (v0[j].z * v0[j].z + v0[j].w * v0[j].w); s1 += (v1[j].x * v1[j].x + v1[j].y * v1[j].y) + (v1[j].z * v1[j].z + v1[j].w * v1[j].w); }
    const float inv0 = __builtin_amdgcn_rsqf(wave_sum(s0) * (1.f / D_MODEL) + 1e-6f), inv1 = __builtin_amdgcn_rsqf(wave_sum(s1) * (1.f / D_MODEL) + 1e-6f);
    u32x2* o0 = (u32x2*)orow0 + lane; u32x2* o1 = (u32x2*)orow1 + lane;
#pragma unroll
    for (int j = 0; j < 4; ++j) { const f32x4 gg = gr[64 * j]; u32x2 w;
        w.x = cvt_pk_bf16(v0[j].x * inv0 * gg.x, v0[j].y * inv0 * gg.y); w.y = cvt_pk_bf16(v0[j].z * inv0 * gg.z, v0[j].w * inv0 * gg.w); o0[64 * j] = w;
        w.x = cvt_pk_bf16(v1[j].x * inv1 * gg.x, v1[j].y * inv1 * gg.y); w.y = cvt_pk_bf16(v1[j].z * inv1 * gg.z, v1[j].w * inv1 * gg.w); o1[64 * j] = w; }
}
__device__ __forceinline__ void rms_row(const float* xrow, const float* g, bf16_t* orow, int lane) {
    const f32x4* xr = (const f32x4*)xrow + lane; const f32x4* gr = (const f32x4*)g + lane;
    f32x4 v[4]; float s = 0.f;
#pragma unroll
    for (int j = 0; j < 4; ++j) { v[j] = xr[64 * j]; s += (v[j].x * v[j].x + v[j].y * v[j].y) + (v[j].z * v[j].z + v[j].w * v[j].w); }
    const float inv = __builtin_amdgcn_rsqf(wave_sum(s) * (1.f / D_MODEL) + 1e-6f);
    u32x2* o8 = (u32x2*)orow + lane;
#pragma unroll
    for (int j = 0; j < 4; ++j) { const f32x4 gg = gr[64 * j]; u32x2 w; w.x = cvt_pk_bf16(v[j].x * inv * gg.x, v[j].y * inv * gg.y); w.y = cvt_pk_bf16(v[j].z * inv * gg.z, v[j].w * inv * gg.w); o8[64 * j] = w; }
}

constexpr int AT_KSTR = 72, AT_VSTR = 68;
constexpr int AT_KBYTES = 64 * AT_KSTR * 2, AT_VBYTES = 64 * AT_VSTR * 2;
__device__ __forceinline__ void vt_write(LAS unsigned char* p, const u32x4 v) {
    *(LAS unsigned short*)(p + 0 * (AT_VSTR * 2)) = (unsigned short)(v.x & 0xffffu); *(LAS unsigned short*)(p + 1 * (AT_VSTR * 2)) = (unsigned short)(v.x >> 16);
    *(LAS unsigned short*)(p + 2 * (AT_VSTR * 2)) = (unsigned short)(v.y & 0xffffu); *(LAS unsigned short*)(p + 3 * (AT_VSTR * 2)) = (unsigned short)(v.y >> 16);
    *(LAS unsigned short*)(p + 4 * (AT_VSTR * 2)) = (unsigned short)(v.z & 0xffffu); *(LAS unsigned short*)(p + 5 * (AT_VSTR * 2)) = (unsigned short)(v.z >> 16);
    *(LAS unsigned short*)(p + 6 * (AT_VSTR * 2)) = (unsigned short)(v.w & 0xffffu); *(LAS unsigned short*)(p + 7 * (AT_VSTR * 2)) = (unsigned short)(v.w >> 16);
}
__device__ __forceinline__ void attn_tile(LAS unsigned char* lds, int cur, int r32, int hi, const bf16x8 (&qf)[4], float& mref, float& lrun, f32x16& o0, f32x16& o1) {
        const LAS unsigned char* kb = lds + cur * AT_KBYTES + r32 * (AT_KSTR * 2) + hi * 16;
        f32x16 p0, p1;
        { const float nm = -mref;
#pragma unroll
          for (int r = 0; r < 16; ++r) { p0[r] = nm; p1[r] = nm; } }
#pragma unroll
        for (int d0 = 0; d0 < 4; ++d0) {
            const bf16x8 a0 = *(const LAS bf16x8*)(kb + d0 * 32), a1 = *(const LAS bf16x8*)(kb + 32 * (AT_KSTR * 2) + d0 * 32);
            p0 = __builtin_amdgcn_mfma_f32_32x32x16_bf16(a0, qf[d0], p0, 0, 0, 0);
            p1 = __builtin_amdgcn_mfma_f32_32x32x16_bf16(a1, qf[d0], p1, 0, 0, 0);
        }
        float mx = __builtin_fmaxf(__builtin_fmaxf(p0[0], p1[0]), p0[1]);
        mx = __builtin_fmaxf(__builtin_fmaxf(mx, p1[1]), p0[2]);
#pragma unroll
        for (int r = 2; r < 14; r += 2) { mx = __builtin_fmaxf(__builtin_fmaxf(mx, p1[r]), p0[r + 1]); mx = __builtin_fmaxf(__builtin_fmaxf(mx, p1[r + 1]), p0[r + 2]); }
        mx = __builtin_fmaxf(__builtin_fmaxf(mx, p1[14]), p0[15]); mx = __builtin_fmaxf(mx, p1[15]);
        mx = __builtin_fmaxf(mx, __shfl_xor(mx, 32));
        if (__builtin_expect(__any(mx > 8.0f), 0)) {
            const float dl = __builtin_fmaxf(mx, 0.f), f = __builtin_amdgcn_exp2f(-dl);
            mref += dl; lrun *= f;
#pragma unroll
            for (int r = 0; r < 16; ++r) { p0[r] -= dl; p1[r] -= dl; o0[r] *= f; o1[r] *= f; }
        }
        f32x2 ls2 = {0.f, 0.f};
#pragma unroll
        for (int r = 0; r < 16; r += 2) {
            p0[r] = __builtin_amdgcn_exp2f(p0[r]); p0[r + 1] = __builtin_amdgcn_exp2f(p0[r + 1]); p1[r] = __builtin_amdgcn_exp2f(p1[r]); p1[r + 1] = __builtin_amdgcn_exp2f(p1[r + 1]);
            ls2 += (f32x2){p0[r], p0[r + 1]}; ls2 += (f32x2){p1[r], p1[r + 1]};
        }
        lrun += ls2.x + ls2.y;
        bf16x8 pf[4];
        { u32x4 w;
          w.x = cvt_pk_bf16(p0[0], p0[1]); w.y = cvt_pk_bf16(p0[2], p0[3]); w.z = cvt_pk_bf16(p0[4], p0[5]); w.w = cvt_pk_bf16(p0[6], p0[7]); pf[0] = __builtin_bit_cast(bf16x8, w);
          w.x = cvt_pk_bf16(p0[8], p0[9]); w.y = cvt_pk_bf16(p0[10], p0[11]); w.z = cvt_pk_bf16(p0[12], p0[13]); w.w = cvt_pk_bf16(p0[14], p0[15]); pf[1] = __builtin_bit_cast(bf16x8, w);
          w.x = cvt_pk_bf16(p1[0], p1[1]); w.y = cvt_pk_bf16(p1[2], p1[3]); w.z = cvt_pk_bf16(p1[4], p1[5]); w.w = cvt_pk_bf16(p1[6], p1[7]); pf[2] = __builtin_bit_cast(bf16x8, w);
          w.x = cvt_pk_bf16(p1[8], p1[9]); w.y = cvt_pk_bf16(p1[10], p1[11]); w.z = cvt_pk_bf16(p1[12], p1[13]); w.w = cvt_pk_bf16(p1[14], p1[15]); pf[3] = __builtin_bit_cast(bf16x8, w); }
        const LAS unsigned char* vb = lds + 2 * AT_KBYTES + cur * AT_VBYTES + r32 * (AT_VSTR * 2) + hi * 8;
#pragma unroll
        for (int s = 0; s < 4; ++s) {
            const int koff = ((s >> 1) * 32 + (s & 1) * 16) * 2;
            const u32x2 l0 = *(const LAS u32x2*)(vb + koff), h0 = *(const LAS u32x2*)(vb + koff + 16);
            const u32x2 l1 = *(const LAS u32x2*)(vb + 32 * (AT_VSTR * 2) + koff), h1 = *(const LAS u32x2*)(vb + 32 * (AT_VSTR * 2) + koff + 16);
            const bf16x8 a0 = __builtin_bit_cast(bf16x8, (u32x4){l0.x, l0.y, h0.x, h0.y}), a1 = __builtin_bit_cast(bf16x8, (u32x4){l1.x, l1.y, h1.x, h1.y});
            o0 = __builtin_amdgcn_mfma_f32_32x32x16_bf16(a0, pf[s], o0, 0, 0, 0);
            o1 = __builtin_amdgcn_mfma_f32_32x32x16_bf16(a1, pf[s], o1, 0, 0, 0);
        }
}
__device__ __forceinline__ void attn_unit(LAS unsigned char* lds, bf16_t* C2, bf16_t* Odummy, int b, int kvh, int qb) {
    int tid = threadIdx.x; asm volatile("" : "+v"(tid));
    const int lane = tid & 63, r32 = lane & 31, hi = lane >> 5, wid = __builtin_amdgcn_readfirstlane(tid >> 6);
    const int g = wid & 3, th = wid >> 2, head = kvh * 4 + g;
    const size_t rowbase = (size_t)b * SEQ;
    const int tok0 = qb * 128 + th * 64;
    bf16_t* qrowA = C2 + (rowbase + tok0 + r32) * LD_C2 + 1536 + head * 64;
    bf16_t* qrowB = qrowA + (size_t)32 * LD_C2;
    bf16x8 qfA[4], qfB[4];
#pragma unroll
    for (int d0 = 0; d0 < 4; ++d0) { qfA[d0] = *(const bf16x8*)(qrowA + d0 * 16 + hi * 8); qfB[d0] = *(const bf16x8*)(qrowB + d0 * 16 + hi * 8); }
    const int srow = tid >> 3, sch = tid & 7;
    const bf16_t* ksrc = C2 + (rowbase + srow) * LD_C2 + 2048 + kvh * 64 + sch * 8;
    const bf16_t* vsrc = ksrc + 128;
    LAS unsigned char* kdst = lds + srow * (AT_KSTR * 2) + sch * 16;
    LAS unsigned char* vdst = lds + 2 * AT_KBYTES + (8 * sch) * (AT_VSTR * 2) + srow * 2;
    u32x4 kregA = *(const u32x4*)ksrc, vregA = *(const u32x4*)vsrc, kregB, vregB;
    *(LAS u32x4*)kdst = kregA; vt_write(vdst, vregA);
    kregA = *(const u32x4*)(ksrc + (size_t)64 * LD_C2); vregA = *(const u32x4*)(vsrc + (size_t)64 * LD_C2);
    __syncthreads();
    f32x16 oA0 = {}, oA1 = {}, oB0 = {}, oB1 = {};
    float mrefA = 0.f, lrunA = 0.f, mrefB = 0.f, lrunB = 0.f;
#define AT_STEP(kt, cur, KW, VW, KL, VL) { \
        if ((kt) + 2 < SEQ / 64) { KL = *(const u32x4*)(ksrc + (size_t)((kt) + 2) * 64 * LD_C2); VL = *(const u32x4*)(vsrc + (size_t)((kt) + 2) * 64 * LD_C2); } \
        attn_tile(lds, cur, r32, hi, qfA, mrefA, lrunA, oA0, oA1); \
        __builtin_amdgcn_sched_barrier(0); \
        attn_tile(lds, cur, r32, hi, qfB, mrefB, lrunB, oB0, oB1); \
        __builtin_amdgcn_sched_barrier(0); \
        if ((kt) + 1 < SEQ / 64) { *(LAS u32x4*)(kdst + ((cur) ^ 1) * AT_KBYTES) = KW; vt_write(vdst + ((cur) ^ 1) * AT_VBYTES, VW); } \
        __syncthreads(); }
    for (int kt = 0; kt < SEQ / 64; kt += 2) {
        AT_STEP(kt, 0, kregA, vregA, kregB, vregB);
        AT_STEP(kt + 1, 1, kregB, vregB, kregA, vregA);
    }
#undef AT_STEP
#pragma unroll
    for (int blk = 0; blk < 2; ++blk) {
        float lr = blk ? lrunB : lrunA; lr += __shfl_xor(lr, 32);
        const float rl = __builtin_amdgcn_rcpf(lr);
        const f32x16& o0 = blk ? oB0 : oA0; const f32x16& o1 = blk ? oB1 : oA1;
        bf16_t* qrow = blk ? qrowB : qrowA;
        bf16_t* orow = Odummy ? Odummy + (rowbase + tok0 + 32 * blk + r32) * 512 + head * 64 : qrow;
#pragma unroll
        for (int g4 = 0; g4 < 4; ++g4) {
            u32x2 w0, w1;
            w0.x = cvt_pk_bf16(o0[4 * g4] * rl, o0[4 * g4 + 1] * rl); w0.y = cvt_pk_bf16(o0[4 * g4 + 2] * rl, o0[4 * g4 + 3] * rl);
            w1.x = cvt_pk_bf16(o1[4 * g4] * rl, o1[4 * g4 + 1] * rl); w1.y = cvt_pk_bf16(o1[4 * g4 + 2] * rl, o1[4 * g4 + 3] * rl);
            *(u32x2*)(orow + 8 * g4 + 4 * hi) = w0; *(u32x2*)(orow + 32 + 8 * g4 + 4 * hi) = w1;
        }
    }
}

__device__ __forceinline__ void conv_item(bf16_t* C2, const float* cvw, const float* cvb, int idx) {
    const int m = idx >> 6, c0 = (idx & 63) * 8, t = m & 4095;
    bf16_t* rp = C2 + (size_t)m * LD_C2 + c0;
    const bf16_t* rpp = (t > 0) ? rp - LD_C2 : rp; const bf16_t* rpn = (t < SEQ - 1) ? rp + LD_C2 : rp;
    const float fp = (t > 0) ? 1.f : 0.f, fn = (t < SEQ - 1) ? 1.f : 0.f;
    float bg[8], c[8], x[8], a[8], bq[8], a2[8], b2[8], o[8];
    unpack8(*(const u32x4*)rp, bg); unpack8(*(const u32x4*)(rp + 512), c); unpack8(*(const u32x4*)(rp + 1024), x);
    unpack8(*(const u32x4*)(rpp + 512), a); unpack8(*(const u32x4*)(rpp + 1024), bq); unpack8(*(const u32x4*)(rpn + 512), a2); unpack8(*(const u32x4*)(rpn + 1024), b2);
#pragma unroll
    for (int j = 0; j < 8; ++j) o[j] = bg[j] * (cvb[c0 + j] + cvw[c0 + j] * (a[j] * bq[j] * fp) + cvw[512 + c0 + j] * (c[j] * x[j]) + cvw[1024 + c0 + j] * (a2[j] * b2[j] * fn));
    *(u32x4*)rp = pack8(o);
}
constexpr int SC_CH = 32;
constexpr int SC_ARR = SC_CH * 64;
constexpr int SC_R = 0, SC_W = 1, SC_KD = 2, SC_V = 3, SC_KK = 4, SC_KKA = 5, SC_ZK = 6, SC_NARR = 7;
constexpr int SC_SLOT = SC_NARR * SC_ARR;
constexpr int SC_BW_OFF = 4096, SC_BA_OFF = 4096 + 9216;
constexpr int SC_TAB = 2 * SC_SLOT;
struct ScanW { const float *mu_prev, *mu_next, *w0, *a0, *k_k, *k_a, *r_k; const bf16_t *w2t, *a2t; };

__device__ __forceinline__ void scan_produce(LAS float* sl, LAS float* tab, const bf16_t* RWC, bf16_t* SG, float* SB, const ScanW& sw, const float* mu_gd_p, const float* mu_gd_n,
                                             int b, int h, int dir, int chunk, int sub, int lane) {
    asm volatile("" : "+v"(lane));
    const int tok = lane & 15, q = lane >> 4;
    const int tokidx = 16 * sub + tok;
    const int sc = chunk * SC_CH + tokidx;
    const int t = dir ? (SEQ - 1 - sc) : sc;
    const bf16_t* rp = RWC + ((size_t)b * SEQ + t) * LD_RWC;
    const bool hasp = t > 0, hasn = t < SEQ - 1;
    const bf16_t* rpp = hasp ? rp - LD_RWC : rp;
    const bf16_t* rpn = hasn ? rp + LD_RWC : rp;
    const float fp = hasp ? 1.f : 0.f, fn = hasn ? 1.f : 0.f;
    u32x4 Lc[6], Lp[6], Ln[6];
#pragma unroll
    for (int G = 0; G < 3; ++G)
#pragma unroll
        for (int hf = 0; hf < 2; ++hf) { const int cb = G * 512 + h * 64 + 16 * q + 8 * hf;
            Lc[2 * G + hf] = *(const u32x4*)(rp + cb); Lp[2 * G + hf] = *(const u32x4*)(rpp + cb); Ln[2 * G + hf] = *(const u32x4*)(rpn + cb); }
    u32x4 Mc[5], Mp[5], Mn[5];
#pragma unroll
    for (int i = 0; i < 4; ++i) { const int cb = 1536 + (i >> 1) * 128 + dir * 64 + 32 * (i & 1) + 8 * q;
        Mc[i] = *(const u32x4*)(rp + cb); Mp[i] = *(const u32x4*)(rpp + cb); Mn[i] = *(const u32x4*)(rpn + cb); }
    float zk[16];
#pragma unroll
    for (int G = 0; G < 3; ++G) {
        float z[16];
#pragma unroll
        for (int hf = 0; hf < 2; ++hf) {
            float c[8], p[8], n[8];
            unpack8(Lc[2 * G + hf], c); unpack8(Lp[2 * G + hf], p); unpack8(Ln[2 * G + hf], n);
            const LAS float* mp = tab + G * 64 + 16 * q + 8 * hf; const LAS float* mn = mp + 320;
#pragma unroll
            for (int j = 0; j < 8; ++j) z[8 * hf + j] = c[j] + mp[j] * (p[j] * fp - c[j]) + mn[j] * (n[j] * fn - c[j]);
        }
        LAS float* dst = sl + (G == 0 ? SC_R : (G == 1 ? SC_ZK : SC_V)) * SC_ARR + tokidx * 64 + 16 * q;
#pragma unroll
        for (int j4 = 0; j4 < 4; ++j4) *(LAS f32x4*)(dst + 4 * j4) = (f32x4){z[4 * j4], z[4 * j4 + 1], z[4 * j4 + 2], z[4 * j4 + 3]};
        if (G == 1) {
#pragma unroll
            for (int j = 0; j < 16; ++j) zk[j] = z[j];
        }
    }
    {
        const LAS float* kkt = tab + 640 + 16 * q;
        float kr[16], ss = 0.f;
#pragma unroll
        for (int j = 0; j < 16; ++j) { kr[j] = zk[j] * kkt[j]; ss += kr[j] * kr[j]; }
        ss += __shfl_xor(ss, 16); ss += __shfl_xor(ss, 32);
        const float inv = 1.f / fmaxf(sqrtf(ss), 1e-12f);
        LAS float* dst = sl + SC_KK * SC_ARR + tokidx * 64 + 16 * q;
#pragma unroll
        for (int j4 = 0; j4 < 4; ++j4) *(LAS f32x4*)(dst + 4 * j4) = (f32x4){kr[4 * j4] * inv, kr[4 * j4 + 1] * inv, kr[4 * j4 + 2] * inv, kr[4 * j4 + 3] * inv};
    }
    bf16x8 Awd[2], Aad[2];
#pragma unroll
    for (int i = 0; i < 4; ++i) {
        const int G = 3 + (i >> 1), ks = i & 1;
        float c[8], p[8], n[8], z[8];
        unpack8(Mc[i], c); unpack8(Mp[i], p); unpack8(Mn[i], n);
        const LAS float* mp = tab + G * 64 + 32 * ks + 8 * q; const LAS float* mn = mp + 320;
#pragma unroll
        for (int j = 0; j < 8; ++j) { z[j] = c[j] + mp[j] * (p[j] * fp - c[j]) + mn[j] * (n[j] * fn - c[j]); if (G == 3) z[j] = tanh_f(z[j]); }
        const bf16x8 fr8 = __builtin_bit_cast(bf16x8, pack8(z));
        if (G == 3) Awd[ks] = fr8; else Aad[ks] = fr8;
    }
    asm volatile("s_waitcnt lgkmcnt(0)" ::: "memory");
    f32x4 aw[4], aa[4];
    float w0r[4], a0r[4], kar[4], rkr[4];
#pragma unroll
    for (int nb = 0; nb < 4; ++nb) {
        const int cl = 16 * nb + (lane & 15);
        const LAS unsigned char* wp = (const LAS unsigned char*)tab + SC_BW_OFF + cl * 144 + 16 * (lane >> 4); const LAS unsigned char* ap = wp + (SC_BA_OFF - SC_BW_OFF);
        const bf16x8 bw0 = *(const LAS bf16x8*)wp, bw1 = *(const LAS bf16x8*)(wp + 64), ba0 = *(const LAS bf16x8*)ap, ba1 = *(const LAS bf16x8*)(ap + 64);
        w0r[nb] = tab[720 + cl]; a0r[nb] = tab[784 + cl]; kar[nb] = tab[848 + cl]; rkr[nb] = tab[912 + cl];
        aw[nb] = __builtin_amdgcn_mfma_f32_16x16x32_bf16(Awd[0], bw0, (f32x4){0.f, 0.f, 0.f, 0.f}, 0, 0, 0);
        aw[nb] = __builtin_amdgcn_mfma_f32_16x16x32_bf16(Awd[1], bw1, aw[nb], 0, 0, 0);
        aa[nb] = __builtin_amdgcn_mfma_f32_16x16x32_bf16(Aad[0], ba0, (f32x4){0.f, 0.f, 0.f, 0.f}, 0, 0, 0);
        aa[nb] = __builtin_amdgcn_mfma_f32_16x16x32_bf16(Aad[1], ba1, aa[nb], 0, 0, 0);
    }
    float bon[4] = {0.f, 0.f, 0.f, 0.f};
#pragma unroll
    for (int nb = 0; nb < 4; ++nb)
#pragma unroll
        for (int rg = 0; rg < 4; ++rg) {
            const int ti = 16 * sub + 4 * q + rg, c = 16 * nb + (lane & 15), o = ti * 64 + c;
            const float dec = trans_settle(__builtin_amdgcn_exp2f(-0.6065306597126334f * LOG2E * sigmoid_f(aw[nb][rg] + w0r[nb])));
            const float a = sigmoid_f(aa[nb][rg] + a0r[nb]);
            const float zkv = sl[SC_ZK * SC_ARR + o], kkv = sl[SC_KK * SC_ARR + o], rv = sl[SC_R * SC_ARR + o];
            const float kd = zkv * (1.f + (a - 1.f) * kar[nb]);
            sl[SC_W * SC_ARR + o] = dec; sl[SC_KD * SC_ARR + o] = kd; sl[SC_KKA * SC_ARR + o] = kkv * a;
            bon[rg] += rv * kd * rkr[nb];
        }
#pragma unroll
    for (int rg = 0; rg < 4; ++rg) {
        const float s = red16(bon[rg]);
        if ((lane & 15) == 0) { const int sc2 = chunk * SC_CH + 16 * sub + 4 * q + rg; const int t2 = dir ? (SEQ - 1 - sc2) : sc2;
            SB[((size_t)dir * T + (size_t)b * SEQ + t2) * 8 + h] = s; }
    }
}

__device__ __forceinline__ void scan_unit(LAS unsigned char* lds, const bf16_t* RWC, bf16_t* YF, bf16_t* YB, bf16_t* SG, float* SB, const ScanW& sw, int b, int h, int dir,
                                          bf16_t* C2cv, const float* cvw, const float* cvb, int unit) {
    int tid = threadIdx.x; asm volatile("" : "+v"(tid));
    const int lane = tid & 63, wid = __builtin_amdgcn_readfirstlane(tid >> 6);
    LAS float* fl = (LAS float*)lds;
    LAS float* tab = fl + SC_TAB;
    for (int i = tid; i < 976; i += 512) {
        float v;
        if (i < 640) { const int pn = i / 320, r = i % 320, G = r / 64, ch = r % 64;
            const int col = (G < 3) ? (G * 512 + h * 64 + ch) : (1536 + (G - 3) * 128 + dir * 64 + ch);
            v = (pn ? sw.mu_next : sw.mu_prev)[col]; }
        else if (i < 704) v = sw.k_k[h * 64 + (i - 640)];
        else if (i < 720) { const int j = i - 704; v = ((j >> 3) ? sw.mu_next : sw.mu_prev)[1792 + 8 * (2 * h + dir) + (j & 7)]; }
        else { const int k = i - 720, which = k >> 6, c = k & 63;
            v = which == 0 ? sw.w0[dir * 512 + h * 64 + c] : (which == 1 ? sw.a0[dir * 512 + h * 64 + c] : (which == 2 ? sw.k_a[h * 64 + c] : sw.r_k[h * 64 + c])); }
        tab[i] = v;
    }
    { const int row = tid >> 3, chunk = tid & 7; const size_t src = ((size_t)(dir * 512 + h * 64 + row)) * 64 + chunk * 8;
      *(LAS u32x4*)((LAS unsigned char*)tab + SC_BW_OFF + row * 144 + chunk * 16) = *(const u32x4*)(sw.w2t + src);
      *(LAS u32x4*)((LAS unsigned char*)tab + SC_BA_OFF + row * 144 + chunk * 16) = *(const u32x4*)(sw.a2t + src); }
    __syncthreads();
    if (wid >= 4 && wid < 6) scan_produce(fl, tab, RWC, SG, SB, sw, sw.mu_prev + 1792, sw.mu_next + 1792, b, h, dir, 0, wid - 4, lane);
    __syncthreads();
    const int vp = tid >> 3, kq = tid & 7;
    f32x2 S0[4], S1[4];
#pragma unroll
    for (int i = 0; i < 4; ++i) { S0[i] = (f32x2){0.f, 0.f}; S1[i] = (f32x2){0.f, 0.f}; }
    bf16_t* Y = dir ? YB : YF;
    for (int ch = 0; ch < SEQ / SC_CH; ++ch) {
        LAS float* sl = fl + (ch & 1) * SC_SLOT;
        if (wid < 4) {
            const LAS float* base = sl + 8 * kq;
            const LAS float* vbase = sl + SC_V * SC_ARR + 2 * vp;
            f32x4 nkk0, nkk1, nw0, nw1, nka0, nka1, nkd0, nkd1, nr0, nr1; f32x2 nvv;
#define SC_LOAD(s_) do { const LAS float* p_ = base + (s_) * 64; \
                nkk0 = *(const LAS f32x4*)(p_ + SC_KK * SC_ARR); nkk1 = *(const LAS f32x4*)(p_ + SC_KK * SC_ARR + 4); \
                nw0 = *(const LAS f32x4*)(p_ + SC_W * SC_ARR); nw1 = *(const LAS f32x4*)(p_ + SC_W * SC_ARR + 4); \
                nka0 = *(const LAS f32x4*)(p_ + SC_KKA * SC_ARR); nka1 = *(const LAS f32x4*)(p_ + SC_KKA * SC_ARR + 4); \
                nkd0 = *(const LAS f32x4*)(p_ + SC_KD * SC_ARR); nkd1 = *(const LAS f32x4*)(p_ + SC_KD * SC_ARR + 4); \
                nr0 = *(const LAS f32x4*)(p_ + SC_R * SC_ARR); nr1 = *(const LAS f32x4*)(p_ + SC_R * SC_ARR + 4); \
                nvv = *(const LAS f32x2*)(vbase + (s_) * 64); } while (0)
            SC_LOAD(0);
#pragma unroll 2
            for (int s = 0; s < SC_CH; ++s) {
                f32x2 kk[4], w[4], ka[4], kd[4], r[4];
                kk[0] = nkk0.xy; kk[1] = nkk0.zw; kk[2] = nkk1.xy; kk[3] = nkk1.zw;
                w[0] = nw0.xy; w[1] = nw0.zw; w[2] = nw1.xy; w[3] = nw1.zw;
                ka[0] = nka0.xy; ka[1] = nka0.zw; ka[2] = nka1.xy; ka[3] = nka1.zw;
                kd[0] = nkd0.xy; kd[1] = nkd0.zw; kd[2] = nkd1.xy; kd[3] = nkd1.zw;
                r[0] = nr0.xy; r[1] = nr0.zw; r[2] = nr1.xy; r[3] = nr1.zw;
                const f32x2 vv = nvv;
                SC_LOAD((s + 1) & (SC_CH - 1));
                f32x2 t0 = S0[0] * kk[0], t1 = S1[0] * kk[0];
#pragma unroll
                for (int i = 1; i < 4; ++i) { t0 = S0[i] * kk[i] + t0; t1 = S1[i] * kk[i] + t1; }
                const float sa0 = red8(t0.x + t0.y), sa1 = red8(t1.x + t1.y);
                const f32x2 n0 = (f32x2){-sa0, -sa0}, n1 = (f32x2){-sa1, -sa1}, v0 = (f32x2){vv.x, vv.x}, v1 = (f32x2){vv.y, vv.y};
                f32x2 y0 = (f32x2){0.f, 0.f}, y1 = (f32x2){0.f, 0.f};
#pragma unroll
                for (int i = 0; i < 4; ++i) {
                    S0[i] = S0[i] * w[i] + (v0 * kd[i] + n0 * ka[i]);
                    S1[i] = S1[i] * w[i] + (v1 * kd[i] + n1 * ka[i]);
                    y0 = S0[i] * r[i] + y0; y1 = S1[i] * r[i] + y1;
                }
                float yp0 = y0.x + y0.y, yp1 = y1.x + y1.y; asm volatile("" : "+v"(yp0));
                const float ys0 = red8(yp0), ys1 = red8(yp1);
                if (kq == 0) { const int sc = ch * SC_CH + s; const int t = dir ? (SEQ - 1 - sc) : sc;
                    *(unsigned*)(Y + ((size_t)b * SEQ + t) * 512 + h * 64 + 2 * vp) = cvt_pk_bf16(ys0, ys1); }
            }
#undef SC_LOAD
        } else if (wid < 6) {
            if (ch + 1 < SEQ / SC_CH) scan_produce(fl + ((ch + 1) & 1) * SC_SLOT, tab, RWC, SG, SB, sw, sw.mu_prev + 1792, sw.mu_next + 1792, b, h, dir, ch + 1, wid - 4, lane);
        } else {
            conv_item(C2cv, cvw, cvb, unit * 16384 + ch * 128 + (tid - 384));
            { const int j = tid - 384, tok = j >> 2, pr = j & 3, sc = ch * SC_CH + tok, t = dir ? (SEQ - 1 - sc) : sc, cg8 = 8 * (2 * h + dir) + 2 * pr;
              const bf16_t* rp = RWC + ((size_t)b * SEQ + t) * LD_RWC + 1792 + cg8;
              const unsigned uc = *(const unsigned*)rp, up = *(const unsigned*)(t > 0 ? rp - LD_RWC : rp), un = *(const unsigned*)(t < SEQ - 1 ? rp + LD_RWC : rp);
              const float fp = t > 0 ? 1.f : 0.f, fn = t < SEQ - 1 ? 1.f : 0.f;
              const float c0 = bflo(uc), c1 = bfhi(uc);
              const float z0 = sigmoid_f(c0 + tab[704 + 2 * pr] * (bflo(up) * fp - c0) + tab[712 + 2 * pr] * (bflo(un) * fn - c0));
              const float z1 = sigmoid_f(c1 + tab[705 + 2 * pr] * (bfhi(up) * fp - c1) + tab[713 + 2 * pr] * (bfhi(un) * fn - c1));
              *(unsigned*)(SG + ((size_t)b * SEQ + t) * 256 + cg8) = cvt_pk_bf16(z0, z1); }
        }
        __syncthreads();
    }
}


#define XB_TMO      128
#define XB_XCNT(j)  (256  + 64 * (j))
#define XB_XSUB(j)  (1280 + 64 * (j))
#define XB_XGEN(j)  (2304 + 64 * (j))
#define XB_TOP      3328
#define XB_TOPGEN   3392
#define XB_SPIN_CAP (1u << 22)
__device__ __forceinline__ unsigned xb_ld(unsigned* p)              { return __hip_atomic_load(p, __ATOMIC_RELAXED, __HIP_MEMORY_SCOPE_AGENT); }
__device__ __forceinline__ unsigned xb_add(unsigned* p, unsigned v) { return __hip_atomic_fetch_add(p, v, __ATOMIC_RELAXED, __HIP_MEMORY_SCOPE_AGENT); }
__device__ __forceinline__ unsigned xb_xcc_id() { return (unsigned)__builtin_amdgcn_s_getreg((3 << 11) | 20) & 0xFu; }
#define XB_SPIN(cond, bar) do { unsigned _sp = 0; while (cond) { __builtin_amdgcn_s_sleep(1); \
    if ((++_sp & 255u) == 0u) { if (xb_ld(&(bar)[XB_TMO])) break; if (_sp > XB_SPIN_CAP) { atomicAdd(&(bar)[XB_TMO], 1u); break; } } } } while (0)
struct XcdBarrier { unsigned* bar; unsigned x; volatile LAS unsigned* st; };
__device__ __forceinline__ XcdBarrier xcd_barrier_post(unsigned* bar, volatile LAS unsigned* st) {
    XcdBarrier b; b.bar = bar; b.x = xb_xcc_id(); b.st = st;
    if (threadIdx.x == 0) (void)xb_add(&bar[XB_XCNT(b.x)], 1u);
    return b;
}
__device__ __forceinline__ void xcd_barrier_complete(unsigned* bar, unsigned x, unsigned& nloc, unsigned& nx) {
    const unsigned G = gridDim.x * gridDim.y * gridDim.z;
    unsigned sum, cnt, mine, sp = 0u;
    for (;;) {
        sum = 0u; cnt = 0u; mine = 0u;
#pragma unroll
        for (unsigned j = 0; j < 16; ++j) { const unsigned c = xb_ld(&bar[XB_XCNT(j)]); sum += c; cnt += (c > 0u) ? 1u : 0u; mine = (j == x) ? c : mine; }
        if (sum == G) break;
        __builtin_amdgcn_s_sleep(1);
        if ((++sp & 255u) == 0u) { if (xb_ld(&bar[XB_TMO])) break; if (sp > XB_SPIN_CAP) { atomicAdd(&bar[XB_TMO], 1u); break; } }
    }
    nloc = mine > 0u ? mine : 1u; nx = cnt > 0u ? cnt : 1u;
}
__device__ __forceinline__ void xcd_barrier(const XcdBarrier& b) {
    asm volatile("s_waitcnt vmcnt(0)" ::: "memory");
    __syncthreads();
    if (threadIdx.x == 0) {
        unsigned* bar = b.bar;
        __builtin_amdgcn_s_waitcnt(0);
        unsigned nloc = b.st[0], nx = b.st[1];
        if (nloc == 0u) { xcd_barrier_complete(bar, b.x, nloc, nx); b.st[0] = nloc; b.st[1] = nx; }
        const unsigned old = xb_add(&bar[XB_XSUB(b.x)], 1u);
        const unsigned gen = old / nloc;
        if (old + 1u == (gen + 1u) * nloc) {
            __builtin_amdgcn_fence(__ATOMIC_RELEASE, "agent");
            asm volatile("s_waitcnt vmcnt(0)" ::: "memory");
            const unsigned og = xb_add(&bar[XB_TOP], 1u);
            const unsigned tg = og / nx;
            if (og + 1u == (tg + 1u) * nx) xb_add(&bar[XB_TOPGEN], 1u);
            else XB_SPIN(xb_ld(&bar[XB_TOPGEN]) == tg, bar);
            __builtin_amdgcn_fence(__ATOMIC_ACQUIRE, "agent");
            xb_add(&bar[XB_XGEN(b.x)], 1u);
            asm volatile("s_waitcnt vmcnt(0)" ::: "memory");
        } else {
            XB_SPIN(xb_ld(&bar[XB_XGEN(b.x)]) == gen, bar);
            __builtin_amdgcn_fence(__ATOMIC_ACQUIRE, "agent");
            asm volatile("s_waitcnt vmcnt(0)" ::: "memory");
        }
    }
    __syncthreads();
}

#ifdef MK_DBG_STOP
#define DBG_STOP(k) do { if ((k) == MK_DBG_STOP && l == 0) { dbg_dump(p, ws0, bx * 512 + (int)threadIdx.x, G * 512); return; } } while (0)
__device__ __noinline__ void dbg_dump(const Params& p, unsigned char* ws, int gtid, int NGT) {
    const bf16_t* rwc = (const bf16_t*)(ws + WS_RWC); const bf16_t* c2 = (const bf16_t*)(ws + WS_C2); const bf16_t* yf = (const bf16_t*)(ws + WS_YF); const bf16_t* yb = (const bf16_t*)(ws + WS_YB);
    const bf16_t* sg = (const bf16_t*)(ws + WS_SG); const float* sb = (const float*)(ws + WS_SB); const bf16_t* hb = (const bf16_t*)(ws + WS_H);
    for (size_t i = gtid; i < (size_t)T * 1024; i += NGT) {
        const size_t m = i >> 10; const int c = (int)(i & 1023);
        float v = 0.f;
#if MK_DBG_WHAT == 0
        v = bflo(rwc[m * 2048 + 2 * c]) + bflo(rwc[m * 2048 + 2 * c + 1]);
#elif MK_DBG_WHAT == 1
        v = bflo(c2[m * 2304 + 2 * c]) + bflo(c2[m * 2304 + 2 * c + 1]) + (c < 256 ? bflo(c2[m * 2304 + 2048 + c]) : 0.f);
#elif MK_DBG_WHAT == 2
        v = (c < 512 ? bflo(yf[m * 512 + c]) : bflo(yb[m * 512 + c - 512]));
#elif MK_DBG_WHAT == 3
        v = (c < 256 ? bflo(sg[m * 256 + c]) : (c < 272 ? sb[((c - 256) >> 3) * (size_t)T * 8 + m * 8 + (c & 7)] : bflo(hb[m * 1024 + c])));
#elif MK_DBG_WHAT == 6
        v = bflo(((const bf16_t*)(ws + WS_WIN))[(size_t)(4352 + (m % 3072)) * 1024 + c]) + bflo(hb[m * 1024 + c]);
#elif MK_DBG_WHAT == 5
        v = bflo(((const bf16_t*)(ws + WS_GT))[m * 1024 + c]);
#elif MK_DBG_WHAT == 4
        v = bflo(rwc[(size_t)T * 1024 + m * 1024 + c]);
#endif
        p.out[i] = v;
    }
}
#else
#define DBG_STOP(k) do { } while (0)
#endif

#define L1_REFRESH() do { asm volatile("s_waitcnt vmcnt(0)" ::: "memory"); __builtin_amdgcn_fence(__ATOMIC_ACQUIRE, "agent"); asm volatile("s_waitcnt vmcnt(0)" ::: "memory"); } while (0)
#define PHASE_IDS() int tid = threadIdx.x; asm volatile("" : "+v"(tid)); const int lane = tid & 63, wave = __builtin_amdgcn_readfirstlane(tid >> 6); const int gw = vcu * 8 + wave, gtid = bx * 512 + tid; (void)lane; (void)gw; (void)gtid
#define Win_t ((bf16_t*)(ws + WS_WIN))
#define Wbr_t ((bf16_t*)(ws + WS_WBR))
#define Wout_t ((bf16_t*)(ws + WS_WOUT))
#define W1_t ((bf16_t*)(ws + WS_W1))
#define W2_t ((bf16_t*)(ws + WS_W2))
#define w2t ((bf16_t*)(ws + WS_W2T))
#define a2t ((bf16_t*)(ws + WS_A2T))
#define g2t ((bf16_t*)(ws + WS_G2T))
#define Hb ((bf16_t*)(ws + WS_H))
#define RWC ((bf16_t*)(ws + WS_RWC))
#define C2 ((bf16_t*)(ws + WS_C2))
#define YF ((bf16_t*)(ws + WS_YF))
#define YB ((bf16_t*)(ws + WS_YB))
#define SG ((bf16_t*)(ws + WS_SG))
#define VT ((bf16_t*)(ws + WS_VT))
#define SB ((float*)(ws + WS_SB))
#define Gt ((bf16_t*)(ws + WS_GT))
#define Mg ((bf16_t*)(ws + WS_MRG))
#define Ub ((bf16_t*)(ws + WS_U))
__global__ void __launch_bounds__(512, 2) fwd_megakernel(Params p) {
    extern __shared__ __attribute__((aligned(16))) unsigned char lds_raw[];
    LAS unsigned char* lds = (LAS unsigned char*)lds_raw;
    cg::grid_group grid = cg::this_grid();
    volatile LAS unsigned* misc = (volatile LAS unsigned*)(lds + 139264);
    if (threadIdx.x < 16) misc[threadIdx.x] = 0u;
    __syncthreads();
    XcdBarrier xbar = xcd_barrier_post((unsigned*)(p.ws + 65536), misc);
    grid.sync();
    const int G = gridDim.x, bx = blockIdx.x;
    const int vcu = (G % 8 == 0) ? (bx % 8) * (G / 8) + bx / 8 : bx;
    const int NGW = G * 8, NGT = G * 512;
    float* X = p.out;

    for (int l = 0; l < DEPTH; ++l) {
        const float* xin = (l == 0) ? p.in[0] : X;
        unsigned char* ws0 = p.ws; asm volatile("" : "+s"(ws0));
        GAS unsigned char* ws = (GAS unsigned char*)ws0;
        if (PHMASK & (1u << 0)) {
            PHASE_IDS();
            LAS float* scr = (LAS float*)(lds + wave * 8448);
            const float* w_in = p.in[2] + (size_t)l * D_MODEL * IN_COLS;
            const float* w_br = p.in[19] + (size_t)l * 3 * 512 * D_MODEL;
            const float* w_out = p.in[20] + (size_t)l * D_MODEL * D_MODEL;
            const float* w_m1 = p.in[22] + (size_t)l * D_MODEL * D_FF;
            const float* w_m2 = p.in[23] + (size_t)l * D_FF * D_MODEL;
            const float* rw_w2 = p.in[6] + (size_t)l * 2 * 64 * 512;
            const float* rw_a2 = p.in[8] + (size_t)l * 2 * 64 * 512;
            const float* rw_g2 = p.in[9] + (size_t)l * 128 * 512;
            constexpr int I_IN = 232 * 16, I_BR = 3 * 8 * 32, I_OUT = 16 * 32, I_M1 = 16 * 128, I_M2 = 64 * 32, I_L = 32, I_G = 32;
            constexpr int NITEMS = I_IN + I_BR + I_OUT + I_M1 + I_M2 + 2 * I_L + I_G;
            for (int it = gw; it < NITEMS; it += NGW) {
                int r = it;
                if (r < I_IN) { const int db = r % 232, kb = r / 232; int src;
                    if (db < 60) src = 32 * db;
                    else if (db < 64) {
                        const int c = lane & 7;
#pragma unroll
                        for (int j = 0; j < 4; ++j) { const int n = (lane >> 3) + 8 * j; *(u32x4*)(Win_t + (size_t)(32 * db + n) * D_MODEL + 64 * kb + 8 * c) = (u32x4){0u, 0u, 0u, 0u}; }
                        continue; }
                    else if (db < 112) src = 1920 + 32 * (db - 64);
                    else if (db < 136) { const int pp = 32 * (db - 112), tile = pp >> 8, c = pp & 255, bj = c >> 7, wc = (c & 127) >> 5; src = 3456 + tile * 256 + 64 * wc + 32 * bj; }
                    else src = 4224 + 32 * (db - 136);
                    transpose_item(w_in, IN_COLS, 64 * kb, src, Win_t, D_MODEL, 32 * db, scr, lane); continue; }
                r -= I_IN;
                if (r < I_BR) { const int bb = r / 256, q = r % 256, kb = q / 32, nb = q % 32;
                    transpose_item(w_br + (size_t)bb * 512 * D_MODEL, D_MODEL, 64 * kb, 32 * nb, Wbr_t + (size_t)bb * D_MODEL * 512, 512, 32 * nb, scr, lane); continue; }
                r -= I_BR;
                if (r < I_OUT) { transpose_item(w_out, D_MODEL, 64 * (r / 32), 32 * (r % 32), Wout_t, D_MODEL, 32 * (r % 32), scr, lane); continue; }
                r -= I_OUT;
                if (r < I_M1) { transpose_item(w_m1, D_FF, 64 * (r / 128), 32 * (r % 128), W1_t, D_MODEL, 32 * (r % 128), scr, lane); continue; }
                r -= I_M1;
                if (r < I_M2) { transpose_item(w_m2, D_MODEL, 64 * (r / 32), 32 * (r % 32), W2_t, D_FF, 32 * (r % 32), scr, lane); continue; }
                r -= I_M2;
                if (r < I_L) { const int dd = r / 16, nb = r % 16; transpose_item(rw_w2 + (size_t)dd * 64 * 512, 512, 0, 32 * nb, w2t + (size_t)dd * 512 * 64, 64, 32 * nb, scr, lane); continue; }
                r -= I_L;
                if (r < I_L) { const int dd = r / 16, nb = r % 16; transpose_item(rw_a2 + (size_t)dd * 64 * 512, 512, 0, 32 * nb, a2t + (size_t)dd * 512 * 64, 64, 32 * nb, scr, lane); continue; }
                r -= I_L;
                { const int kb = r / 16, nb = r % 16; transpose_item(rw_g2, 512, 64 * kb, 32 * nb, g2t, 256, 32 * nb, scr, lane); }
            }
            for (int i = gtid; i < 512 * 16; i += NGT) *(u32x4*)(g2t + (size_t)(i >> 4) * 256 + 128 + 8 * (i & 15)) = (u32x4){0u, 0u, 0u, 0u};
            if (l == 0) for (int i = gtid; i < T * 16; i += NGT) *(u32x4*)(SG + (size_t)(i >> 4) * 256 + 128 + 8 * (i & 15)) = (u32x4){0u, 0u, 0u, 0u};
            const float* g1 = p.in[1] + (size_t)l * D_MODEL;
            if (T % (2 * NGW) == 0) { for (int m = gw; m < T; m += 2 * NGW) rms_row2(xin + (size_t)m * D_MODEL, xin + (size_t)(m + NGW) * D_MODEL, g1, Hb + (size_t)m * D_MODEL, Hb + (size_t)(m + NGW) * D_MODEL, lane); }
            else { for (int m = gw; m < T; m += NGW) rms_row(xin + (size_t)m * D_MODEL, g1, Hb + (size_t)m * D_MODEL, lane); }
        }
        xcd_barrier(xbar);
        DBG_STOP(1);
        if (PHMASK & (1u << 1)) {
            pg8::StaticOrder S;
#ifndef SKIP_P2A
            { pg8::Gemm g{Hb, Win_t, T, 3584, D_MODEL, D_MODEL}; S.init(T, 3584, G, bx);
              pg8::EpiStore<0> E{RWC, LD_RWC, C2, LD_C2, 8}; pg8::gemm_phase(lds, g, S, E); }
#endif
#ifndef SKIP_P2B
            { pg8::Gemm g{Hb, Win_t + (size_t)3584 * D_MODEL, T, 768, D_MODEL, D_MODEL}; S.init(T, 768, G, bx);
              pg8::EpiAttn E{C2, VT, p.in[17] + l * 64, p.in[18] + l * 64}; pg8::gemm_phase(lds, g, S, E); }
#endif
        }
        xcd_barrier(xbar);
        DBG_STOP(2);
        if (PHMASK & (1u << 2)) {
            PHASE_IDS();
            const float* cvw = p.in[15] + (size_t)l * 3 * 512; const float* cvb = p.in[16] + (size_t)l * 512;
            ScanW sw{p.in[3] + (size_t)l * RW_COLS, p.in[4] + (size_t)l * RW_COLS, p.in[5] + (size_t)l * 1024, p.in[7] + (size_t)l * 1024,
                     p.in[10] + (size_t)l * 512, p.in[11] + (size_t)l * 512, p.in[12] + (size_t)l * 512, w2t, a2t};
#ifndef SKIP_SCAN
#ifdef MK_DUP_SCAN
            for (int u = vcu; u < 256; u += G) { scan_unit(lds, RWC, YF, YB, SG, SB, sw, u >> 4, (u >> 1) & 7, u & 1, C2, cvw, cvb, u); __syncthreads(); }
#endif
            for (int u = vcu; u < 256; u += G) { scan_unit(lds, RWC, YF, YB, SG, SB, sw, u >> 4, (u >> 1) & 7, u & 1, C2, cvw, cvb, u); __syncthreads(); }
#endif
#ifndef SKIP_ATTN
#ifdef MK_DUP_ATTN
            for (int u = vcu; u < 1024; u += G) { attn_unit(lds, C2, (bf16_t*)(ws + 892 * MiB), u >> 6, (u >> 5) & 1, u & 31); }
#endif
            for (int u = vcu; u < 1024; u += G) { attn_unit(lds, C2, nullptr, u >> 6, (u >> 5) & 1, u & 31); }
#endif
        }
        xcd_barrier(xbar);
        DBG_STOP(3);
        if (PHMASK & (1u << 3)) {
            PHASE_IDS();
            const float* mup = p.in[3] + (size_t)l * RW_COLS + 1024; const float* mun = p.in[4] + (size_t)l * RW_COLS + 1024;
            const float* lng = p.in[13] + (size_t)l * 512; const float* lnb = p.in[14] + (size_t)l * 512;
            for (int m = gw; m < T; m += NGW) {
                const int t = m & 4095, c0 = 8 * lane, hh = lane >> 3;
                float yf[8], yb[8], vc[8], vpv[8], vn[8], y[8];
                unpack8(*(const u32x4*)(YF + (size_t)m * 512 + c0), yf); unpack8(*(const u32x4*)(YB + (size_t)m * 512 + c0), yb);
                const bf16_t* rp = RWC + (size_t)m * LD_RWC + 1024 + c0;
                unpack8(*(const u32x4*)rp, vc);
                if (t > 0) unpack8(*(const u32x4*)(rp - LD_RWC), vpv); else {
#pragma unroll
                    for (int j = 0; j < 8; ++j) vpv[j] = 0.f; }
                if (t < SEQ - 1) unpack8(*(const u32x4*)(rp + LD_RWC), vn); else {
#pragma unroll
                    for (int j = 0; j < 8; ++j) vn[j] = 0.f; }
                float s = 0.f;
#pragma unroll
                for (int j = 0; j < 8; ++j) { y[j] = yf[j] + yb[j]; s += y[j]; }
                const float mean = red8(s) * (1.f / 64.f);
                float q = 0.f;
#pragma unroll
                for (int j = 0; j < 8; ++j) { y[j] -= mean; q += y[j] * y[j]; }
                const float rstd = __builtin_amdgcn_rsqf(red8(q) * (1.f / 64.f) + 64e-5f);
                const float bs = 0.5f * (SB[(size_t)m * 8 + hh] + SB[((size_t)T + m) * 8 + hh]);
                float o[8];
#pragma unroll
                for (int j = 0; j < 8; ++j) { const float zv = vc[j] + mup[c0 + j] * (vpv[j] - vc[j]) + mun[c0 + j] * (vn[j] - vc[j]);
                    o[j] = y[j] * rstd * lng[c0 + j] + lnb[c0 + j] + bs * zv; }
                *(u32x4*)(YF + (size_t)m * 512 + c0) = pack8(o);
            }
        }
        xcd_barrier(xbar);
        DBG_STOP(4);
        if (PHMASK & (1u << 4)) {
            pg8::StaticOrder S; pg8::Gemm g{SG, g2t, T, 512, 256, 256}; S.init(T, 512, G, bx);
            pg8::EpiMulInPlace E{YF, 512}; pg8::gemm_phase(lds, g, S, E);
        }
        xcd_barrier(xbar);
        DBG_STOP(5);
        if (PHMASK & (1u << 5)) {
            pg8::StaticOrder S; S.init(T, 1024, G, bx);
            const bf16_t* Wg = Win_t + (size_t)4352 * D_MODEL;
            if (P4_CALLS >= 1)
            { pg8::Gemm g{Hb, Wg, T, 1024, D_MODEL, D_MODEL}; pg8::EpiStore<MK_GATE_ACT> E{Gt, D_MODEL, Gt, D_MODEL, 1 << 20}; pg8::gemm_phase(lds, g, S, E); }
            L1_REFRESH();
            if (P4_CALLS >= 2)
            { pg8::Gemm g{YF, Wbr_t, T, 1024, 512, 512}; pg8::EpiBranch<true> E{Gt, Mg}; pg8::gemm_phase(lds, g, S, E); }
            if (P4_CALLS >= 3)
            { pg8::Gemm g{Hb, Wg + (size_t)1024 * D_MODEL, T, 1024, D_MODEL, D_MODEL}; pg8::EpiStore<1> E{Gt, D_MODEL, Gt, D_MODEL, 1 << 20}; pg8::gemm_phase(lds, g, S, E); }
            L1_REFRESH();
            if (P4_CALLS >= 4)
            { pg8::Gemm g{C2, Wbr_t + (size_t)1024 * 512, T, 1024, 512, LD_C2}; pg8::EpiBranch<false> E{Gt, Mg}; pg8::gemm_phase(lds, g, S, E); }
            if (P4_CALLS >= 5)
            { pg8::Gemm g{Hb, Wg + (size_t)2048 * D_MODEL, T, 1024, D_MODEL, D_MODEL}; pg8::EpiStore<1> E{Gt, D_MODEL, Gt, D_MODEL, 1 << 20}; pg8::gemm_phase(lds, g, S, E); }
            L1_REFRESH();
            if (P4_CALLS >= 6)
            { pg8::Gemm g{C2 + 1536, Wbr_t + (size_t)2048 * 512, T, 1024, 512, LD_C2}; pg8::EpiBranch<false> E{Gt, Mg}; pg8::gemm_phase(lds, g, S, E); }
        }
        xcd_barrier(xbar);
        DBG_STOP(6);
        if (PHMASK & (1u << 6)) {
            pg8::StaticOrder S; S.init(T, 1024, G, bx);
            pg8::Gemm g{Mg, Wout_t, T, 1024, D_MODEL, D_MODEL}; pg8::EpiResidual E{xin, X}; pg8::gemm_phase(lds, g, S, E);
        }
        xcd_barrier(xbar);
        DBG_STOP(7);
        if (PHMASK & (1u << 7)) {
            PHASE_IDS();
            const float* g2 = p.in[21] + (size_t)l * D_MODEL;
            if (T % (2 * NGW) == 0) { for (int m = gw; m < T; m += 2 * NGW) rms_row2(X + (size_t)m * D_MODEL, X + (size_t)(m + NGW) * D_MODEL, g2, Hb + (size_t)m * D_MODEL, Hb + (size_t)(m + NGW) * D_MODEL, lane); }
            else { for (int m = gw; m < T; m += NGW) rms_row(X + (size_t)m * D_MODEL, g2, Hb + (size_t)m * D_MODEL, lane); }
        }
        xcd_barrier(xbar);
        DBG_STOP(8);
        if (PHMASK & (1u << 8)) {
            pg8::StaticOrder S; S.init(T, D_FF, G, bx);
            pg8::Gemm g{Hb, W1_t, T, D_FF, D_MODEL, D_MODEL}; pg8::EpiStore<2> E{Ub, D_FF, Ub, D_FF, 1 << 20}; pg8::gemm_phase(lds, g, S, E);
#ifdef MK_DUP_P7
            pg8::gemm_phase(lds, g, S, E);
#endif
        }
        xcd_barrier(xbar);
        DBG_STOP(9);
        if (PHMASK & (1u << 9)) {
            pg8::StaticOrder S; S.init(T, 1024, G, bx);
            pg8::Gemm g{Ub, W2_t, T, 1024, D_FF, D_FF}; pg8::EpiResidual E{X, X}; pg8::gemm_phase(lds, g, S, E);
        }
        xcd_barrier(xbar);
        DBG_STOP(10);
    }
}

extern "C" void kernel_launch(void* const* d_in, const int* in_sizes, int n_in, void* d_out, int out_size, void* d_ws, size_t ws_size, hipStream_t stream) {
    static int grid = 0;
    if (grid == 0) {
        if (n_in != 24 || out_size != T * D_MODEL || ws_size < WS_END) { fprintf(stderr, "kernel_launch: unexpected shapes (n_in %d out %d ws %zu)\n", n_in, out_size, ws_size); grid = -1; return; }
        int dev = 0, cus = 0, per_cu = 0;
        hipGetDevice(&dev);
        hipDeviceGetAttribute(&cus, hipDeviceAttributeMultiprocessorCount, dev);
        hipFuncSetAttribute((const void*)fwd_megakernel, hipFuncAttributeMaxDynamicSharedMemorySize, LDS_BYTES);
        hipOccupancyMaxActiveBlocksPerMultiprocessor(&per_cu, (const void*)fwd_megakernel, 512, LDS_BYTES);
        if (per_cu < 1) { fprintf(stderr, "kernel_launch: occupancy query says %d blocks per CU\n", per_cu); per_cu = 1; }
        (void)hipGetLastError();
        grid = cus;
    }
    if (grid < 0) return;
    if (hipMemsetAsync(d_ws, 0, 1u << 20, stream) != hipSuccess) { fprintf(stderr, "kernel_launch: memset failed\n"); return; }
    Params p{};
    for (int i = 0; i < 24; ++i) p.in[i] = (const float*)d_in[i];
    p.out = (float*)d_out; p.ws = (unsigned char*)d_ws;
    void* args[] = {&p};
    hipError_t e = hipLaunchCooperativeKernel((const void*)fwd_megakernel, dim3(grid), dim3(512), args, LDS_BYTES, stream);
    if (e != hipSuccess) fprintf(stderr, "cooperative launch failed: %s (grid %d)\n", hipGetErrorString(e), grid);
}
```

```cpp
#include <hip/hip_runtime.h>
#include <hip/hip_cooperative_groups.h>
#include <cstdio>
#include <cstdint>
namespace cg = cooperative_groups;

#define LAS __attribute__((address_space(3)))
#define GAS __attribute__((address_space(1)))
typedef unsigned short bf16_t;
typedef short bf16x8 __attribute__((ext_vector_type(8)));
typedef short bf16x4 __attribute__((ext_vector_type(4)));
typedef float f32x2 __attribute__((ext_vector_type(2)));
typedef float f32x4 __attribute__((ext_vector_type(4)));
typedef float f32x16 __attribute__((ext_vector_type(16)));
typedef unsigned u32x2 __attribute__((ext_vector_type(2)));
typedef unsigned u32x4 __attribute__((ext_vector_type(4)));

constexpr int D_MODEL = 1024, BATCH = 16, SEQ = 4096, DEPTH = 4, D_FF = 4096;
constexpr int T = BATCH * SEQ;
constexpr int IN_COLS = 7296, RW_COLS = 1920;
constexpr int NWIN = 7424;
constexpr int LD_RWC = 2048, LD_C2 = 2304;
constexpr float LOG2E = 1.4426950408889634f;

constexpr size_t MiB = 1u << 20;
constexpr size_t WS_WIN = 2 * MiB, WS_WBR = 17 * MiB, WS_WOUT = 20 * MiB, WS_W1 = 22 * MiB, WS_W2 = 30 * MiB;
constexpr size_t WS_W2T = 38 * MiB, WS_A2T = 38 * MiB + 131072, WS_G2T = 38 * MiB + 262144;
constexpr size_t WS_H = 40 * MiB, WS_RWC = 168 * MiB, WS_C2 = 424 * MiB, WS_YF = 712 * MiB, WS_YB = 776 * MiB;
constexpr size_t WS_SG = 840 * MiB, WS_VT = 872 * MiB, WS_SB = 888 * MiB, WS_END = 892 * MiB;
#ifdef MK_GT_FRESH
constexpr size_t WS_GT = 892 * MiB;
#else
constexpr size_t WS_GT = WS_RWC;
#endif
constexpr size_t WS_MRG = WS_RWC + 128 * MiB, WS_U = WS_RWC;

#ifndef MK_GATE_ACT
#define MK_GATE_ACT 1
#endif
#ifndef MK_P4_CALLS
#define MK_P4_CALLS 6
#endif
constexpr int P4_CALLS = MK_P4_CALLS;
#ifndef MK_PHMASK
#define MK_PHMASK 0xffffffffu
#endif
constexpr unsigned PHMASK = MK_PHMASK;
constexpr int LDS_BYTES = 140288;

typedef __bf16 bf16x2_t __attribute__((ext_vector_type(2)));
__device__ __forceinline__ unsigned cvt_pk_bf16(float lo, float hi) { const f32x2 v = {lo, hi}; const bf16x2_t b = __builtin_convertvector(v, bf16x2_t); return __builtin_bit_cast(unsigned, b); }
__device__ __forceinline__ bf16_t f2bf(float f) { return (bf16_t)(cvt_pk_bf16(f, 0.f) & 0xffffu); }
__device__ __forceinline__ float bflo(unsigned u) { return __builtin_bit_cast(float, u << 16); }
__device__ __forceinline__ float bfhi(unsigned u) { return __builtin_bit_cast(float, u & 0xffff0000u); }
__device__ __forceinline__ void unpack8(const u32x4 v, float* f) { f[0] = bflo(v.x); f[1] = bfhi(v.x); f[2] = bflo(v.y); f[3] = bfhi(v.y); f[4] = bflo(v.z); f[5] = bfhi(v.z); f[6] = bflo(v.w); f[7] = bfhi(v.w); }
__device__ __forceinline__ u32x4 pack8(const float* f) { u32x4 w; w.x = cvt_pk_bf16(f[0], f[1]); w.y = cvt_pk_bf16(f[2], f[3]); w.z = cvt_pk_bf16(f[4], f[5]); w.w = cvt_pk_bf16(f[6], f[7]); return w; }
__device__ __forceinline__ float trans_settle(float x) { float r; asm volatile("s_nop 1\n\tv_mov_b32 %0, %1" : "=v"(r) : "v"(x)); return r; }
__device__ __forceinline__ float sigmoid_f(float x) { return __builtin_amdgcn_rcpf(1.f + __builtin_amdgcn_exp2f(-LOG2E * x)); }
__device__ __forceinline__ float tanh_f(float x) { return 1.f - 2.f * __builtin_amdgcn_rcpf(1.f + __builtin_amdgcn_exp2f(2.f * LOG2E * x)); }
__device__ __forceinline__ float wave_sum(float v) {
#pragma unroll
    for (int o = 1; o < 64; o <<= 1) v += __shfl_xor(v, o);
    return v;
}
template <int CTRL> __device__ __forceinline__ float dpp_f(float x) { return __builtin_bit_cast(float, __builtin_amdgcn_update_dpp(0, __builtin_bit_cast(int, x), CTRL, 0xf, 0xf, true)); }
__device__ __forceinline__ float red8(float x) { x += dpp_f<0xB1>(x); x += dpp_f<0x4E>(x); x += dpp_f<0x141>(x); return x; }
__device__ __forceinline__ float red8_nopack(float x) { x += dpp_f<0xB1>(x); asm volatile("" : "+v"(x)); x += dpp_f<0x4E>(x); asm volatile("" : "+v"(x)); x += dpp_f<0x141>(x); asm volatile("" : "+v"(x)); return x; }
__device__ __forceinline__ float red16(float x) { x = red8(x); x += dpp_f<0x140>(x); return x; }

namespace pg8 {
constexpr int BM = 256, BK = 64, HALF = 128, HTB = HALF * BK * 2, STAGE_BYTES = 8 * HTB, NXCD = 8, WGM = 8;
__host__ __device__ __forceinline__ int lds_byte(int r, int c) { const int st = (r >> 4) * 2 + (c >> 5), rr = r & 15, cc = c & 31, ob = rr * 64 + cc * 2; return st * 1024 + (ob ^ (((ob >> 9) & 1) << 5)); }
__host__ __device__ __forceinline__ void stage_rc(int b, int& R, int& C) { const int st = b / 1024, sb = b % 1024, swz = sb ^ (((sb >> 9) & 1) << 5); R = (st >> 1) * 16 + swz / 64; C = (st & 1) * 32 + (swz % 64) / 2; }
__host__ __device__ __forceinline__ int perm32(int rho) { const int n = rho >> 4, i = rho & 15; return 8 * (i >> 2) + 4 * n + (i & 3); }

struct Unit { int pm, pn; };
struct Gemm { const bf16_t* A; const bf16_t* Bt; int M, N, K, lda; };

struct StaticOrder {
    int nM, nN, nwg, G, c;
    __device__ void init(int M, int N, int G_, int c_) { nM = M / BM; nN = N / BM; nwg = nM * nN; G = G_; c = c_; }
    __device__ bool next(int i, Unit& u) const {
        const long L = (long)i * G + c; if (L >= nwg) return false;
        int wgid = (int)L; { const int q = nwg / NXCD, r = nwg % NXCD, xcd = wgid % NXCD, off = wgid / NXCD; wgid = (xcd < r ? xcd * (q + 1) : r * (q + 1) + (xcd - r) * q) + off; }
        const int nig = WGM * nN, gid = wgid / nig, fm = gid * WGM, gsz = (nM - fm) < WGM ? (nM - fm) : WGM;
        u.pm = fm + ((wgid % nig) % gsz); u.pn = (wgid % nig) / gsz; return true;
    }
};

template <class Epi>
__device__ __forceinline__ void gemm_phase(LAS unsigned char* lds, const Gemm g, const StaticOrder& S, const Epi& E) {
    int tid = threadIdx.x; asm volatile("" : "+v"(tid));
    const int wid = __builtin_amdgcn_readfirstlane(tid >> 6), lane = tid & 63, wr = wid >> 2, wc = wid & 3, fr = lane & 15, fq = lane >> 4;
    const int K = g.K, nt = K / BK, lda = g.lda;
    unsigned voffA[2], voffB[2];
#pragma unroll
    for (int i = 0; i < 2; ++i) { int R, C; stage_rc(tid * 16 + i * 8192, R, C); const int Rb = Epi::PERM ? ((R & ~31) + perm32(R & 31)) : R;
        voffA[i] = (unsigned)(R * lda + C) * 2u; voffB[i] = (unsigned)(Rb * K + C) * 2u; }
    const size_t kstep = (size_t)(BK * 2);
    const size_t hstepA = (size_t)HALF * lda * 2, hstepB = (size_t)HALF * K * 2;
    const size_t tstepA = 2 * hstepA, tstepB = 2 * hstepB;
    const unsigned ldsw = (unsigned)wid * 1024u;
    const int aoff = lds_byte(wr * 64 + fr, fq * 8), boff = lds_byte(wc * 32 + fr, fq * 8);
#define PG8_SA(b, h) (((b) * 2 + (h)) * HTB)
#define PG8_SB(b, h) ((4 + (b) * 2 + (h)) * HTB)
#define PG8_STAGE(bufoff, gbase, voff) do { _Pragma("unroll") for (int _i = 0; _i < 2; ++_i) \
        __builtin_amdgcn_global_load_lds((const unsigned*)((const char*)(gbase) + (voff)[_i]), (LAS unsigned*)(lds + (bufoff) + ldsw + _i * 8192), 16, 0, 0); } while (0)
#define PG8_LDA(dst, b, h) do { _Pragma("unroll") for (int m = 0; m < 4; ++m) _Pragma("unroll") for (int k = 0; k < 2; ++k) dst[m][k] = *(const LAS bf16x8*)(lds + PG8_SA(b, h) + aoff + m * 2048 + k * 1024); } while (0)
#define PG8_LDB(dst, b, h) do { _Pragma("unroll") for (int n = 0; n < 2; ++n) _Pragma("unroll") for (int k = 0; k < 2; ++k) dst[n][k] = *(const LAS bf16x8*)(lds + PG8_SB(b, h) + boff + n * 2048 + k * 1024); } while (0)
#define PG8_MMA(ai, bj, At, Bt) do { __builtin_amdgcn_s_setprio(1); _Pragma("unroll") for (int m = 0; m < 4; ++m) _Pragma("unroll") for (int n = 0; n < 2; ++n) _Pragma("unroll") for (int k = 0; k < 2; ++k) \
        acc[ai][bj][m][n] = __builtin_amdgcn_mfma_f32_16x16x32_bf16(Bt[n][k], At[m][k], acc[ai][bj][m][n], 0, 0, 0); __builtin_amdgcn_s_setprio(0); } while (0)
#define PG8_WAIT_V(n) asm volatile("s_waitcnt vmcnt(" #n ")" ::: "memory")
#define PG8_WAIT_L(n) asm volatile("s_waitcnt lgkmcnt(" #n ")" ::: "memory")
#define PG8_BAR __builtin_amdgcn_s_barrier()
#define PG8_SCHED __builtin_amdgcn_sched_barrier(0)
    Unit cur, nxt; int ui = 0;
    if (!S.next(0, cur)) return;
    f32x4 acc[2][2][4][2];
#pragma unroll
    for (int a = 0; a < 2; ++a)
#pragma unroll
        for (int b = 0; b < 2; ++b)
#pragma unroll
            for (int m = 0; m < 4; ++m)
#pragma unroll
                for (int n = 0; n < 2; ++n) acc[a][b][m][n] = (f32x4){0.f, 0.f, 0.f, 0.f};
    bf16x8 At[4][2], B0[2][2], B1[2][2];
    const char* cA = (const char*)g.A + (size_t)cur.pm * tstepA; const char* cB = (const char*)g.Bt + (size_t)cur.pn * tstepB;
    PG8_STAGE(PG8_SB(0, 0), cB, voffB); PG8_STAGE(PG8_SB(0, 1), cB + hstepB, voffB); PG8_STAGE(PG8_SA(0, 0), cA, voffA); PG8_STAGE(PG8_SA(0, 1), cA + hstepA, voffA);
    if (wr == 1) PG8_BAR;
    PG8_WAIT_V(2); PG8_BAR;
    PG8_STAGE(PG8_SB(1, 0), cB + kstep, voffB); PG8_STAGE(PG8_SA(1, 0), cA + kstep, voffA); PG8_STAGE(PG8_SB(1, 1), cB + hstepB + kstep, voffB);
    PG8_WAIT_V(6); PG8_BAR;
    for (;;) {
        const bool has_next = S.next(ui + 1, nxt);
        const char* nA = has_next ? (const char*)g.A + (size_t)nxt.pm * tstepA : cA; const char* nB = has_next ? (const char*)g.Bt + (size_t)nxt.pn * tstepB : cB;
#pragma nounroll
        for (int t = 0; t < nt; t += 2) {
            const bool last = (t == nt - 2);
            const char* a1 = cA + (size_t)(t + 1) * kstep;
            const char* a2 = last ? nA : cA + (size_t)(t + 2) * kstep; const char* b2 = last ? nB : cB + (size_t)(t + 2) * kstep;
            const char* a3 = a2 + kstep; const char* b3 = b2 + kstep;
            PG8_LDB(B0, 0, 0); PG8_LDB(B1, 0, 1); PG8_SCHED; PG8_LDA(At, 0, 0); PG8_STAGE(PG8_SA(1, 1), a1 + hstepA, voffA);
            PG8_WAIT_V(8); PG8_WAIT_L(0); PG8_BAR; PG8_MMA(0, 0, At, B0); PG8_MMA(0, 1, At, B1); PG8_BAR; PG8_SCHED;
            PG8_LDA(At, 0, 1); PG8_STAGE(PG8_SB(0, 0), b2, voffB); PG8_STAGE(PG8_SB(0, 1), b2 + hstepB, voffB); PG8_STAGE(PG8_SA(0, 0), a2, voffA);
            PG8_WAIT_V(8); PG8_WAIT_L(0); PG8_BAR; PG8_MMA(1, 0, At, B0); PG8_MMA(1, 1, At, B1); PG8_BAR; PG8_SCHED;
            PG8_LDB(B0, 1, 0); PG8_LDB(B1, 1, 1); PG8_SCHED; PG8_LDA(At, 1, 0); PG8_STAGE(PG8_SA(0, 1), a2 + hstepA, voffA);
            PG8_WAIT_V(8); PG8_WAIT_L(0); PG8_BAR; PG8_MMA(0, 0, At, B0); PG8_MMA(0, 1, At, B1); PG8_BAR; PG8_SCHED;
            PG8_LDA(At, 1, 1); PG8_STAGE(PG8_SB(1, 0), b3, voffB); PG8_STAGE(PG8_SB(1, 1), b3 + hstepB, voffB); PG8_STAGE(PG8_SA(1, 0), a3, voffA);
            PG8_WAIT_V(8); PG8_WAIT_L(0); PG8_BAR; PG8_MMA(1, 0, At, B0); PG8_MMA(1, 1, At, B1); PG8_BAR; PG8_SCHED;
        }
        if (wr == 0) PG8_BAR;
        E(acc, cur, wr, wc, fr, fq);
        if (!has_next) break;
#pragma unroll
        for (int a = 0; a < 2; ++a)
#pragma unroll
            for (int b = 0; b < 2; ++b)
#pragma unroll
                for (int m = 0; m < 4; ++m)
#pragma unroll
                    for (int n = 0; n < 2; ++n) acc[a][b][m][n] = (f32x4){0.f, 0.f, 0.f, 0.f};
        cur = nxt; cA = nA; cB = nB; ++ui;
        if (wr == 1) PG8_BAR;
    }
    PG8_WAIT_V(0);
    PG8_BAR;
#undef PG8_SA
#undef PG8_SB
#undef PG8_STAGE
#undef PG8_LDA
#undef PG8_LDB
#undef PG8_MMA
#undef PG8_WAIT_V
#undef PG8_WAIT_L
#undef PG8_BAR
#undef PG8_SCHED
}

#define EPI_FENCE() do { asm volatile("" ::: "memory"); __builtin_amdgcn_sched_barrier(0); } while (0)
template <int ACT> struct EpiStore {
    static constexpr bool PERM = true;
    bf16_t* O0; int ld0; bf16_t* O1; int ld1; int pn_split;
    __device__ __forceinline__ void operator()(const f32x4 (&acc)[2][2][4][2], const Unit& u, int wr, int wc, int fr, int fq) const {
        bf16_t* base; int ld, colt;
        if (u.pn < pn_split) { base = O0; ld = ld0; colt = u.pn * BM; } else { base = O1; ld = ld1; colt = (u.pn - pn_split) * BM; }
        const int row0 = u.pm * BM + wr * 64 + fr, col0 = colt + wc * 32 + 8 * fq;
#pragma unroll
        for (int ai = 0; ai < 2; ++ai)
#pragma unroll
            for (int m = 0; m < 4; ++m) { bf16_t* rowp = base + (size_t)(row0 + ai * HALF + m * 16) * ld + col0;
#pragma unroll
                for (int bj = 0; bj < 2; ++bj) { float v[8];
#pragma unroll
                    for (int j = 0; j < 4; ++j) { v[j] = acc[ai][bj][m][0][j]; v[4 + j] = acc[ai][bj][m][1][j]; }
#pragma unroll
                    for (int j = 0; j < 8; ++j) { if (ACT == 1) v[j] = sigmoid_f(v[j]); if (ACT == 2) { const float r = fmaxf(v[j], 0.f); v[j] = r * r; } }
                    *(u32x4*)(rowp + bj * HALF) = pack8(v); }
                EPI_FENCE(); }
    }
};
struct EpiResidual {
    static constexpr bool PERM = false;
    const float* xin; float* xout;
    __device__ __forceinline__ void operator()(const f32x4 (&acc)[2][2][4][2], const Unit& u, int wr, int wc, int fr, int fq) const {
        const int row0 = u.pm * BM + wr * 64 + fr, col0 = u.pn * BM + wc * 32 + 4 * fq;
#pragma unroll
        for (int ai = 0; ai < 2; ++ai)
#pragma unroll
            for (int m = 0; m < 4; ++m) { const size_t off = (size_t)(row0 + ai * HALF + m * 16) * D_MODEL + col0;
#pragma unroll
                for (int bj = 0; bj < 2; ++bj)
#pragma unroll
                    for (int n = 0; n < 2; ++n) { const f32x4 b = *(const f32x4*)(xin + off + bj * HALF + n * 16); *(f32x4*)(xout + off + bj * HALF + n * 16) = b + acc[ai][bj][m][n]; } }
    }
};
struct EpiMulInPlace {
    static constexpr bool PERM = true;
    bf16_t* Y; int ld;
    __device__ __forceinline__ void operator()(const f32x4 (&acc)[2][2][4][2], const Unit& u, int wr, int wc, int fr, int fq) const {
        const int row0 = u.pm * BM + wr * 64 + fr, col0 = u.pn * BM + wc * 32 + 8 * fq;
#pragma unroll
        for (int ai = 0; ai < 2; ++ai)
#pragma unroll
            for (int m = 0; m < 4; ++m) { bf16_t* rowp = Y + (size_t)(row0 + ai * HALF + m * 16) * ld + col0;
#pragma unroll
                for (int bj = 0; bj < 2; ++bj) { float y[8]; unpack8(*(const u32x4*)(rowp + bj * HALF), y);
#pragma unroll
                    for (int j = 0; j < 4; ++j) { y[j] *= acc[ai][bj][m][0][j]; y[4 + j] *= acc[ai][bj][m][1][j]; }
                    *(u32x4*)(rowp + bj * HALF) = pack8(y); }
                EPI_FENCE(); }
    }
};
template <bool FIRST> struct EpiBranch {
    static constexpr bool PERM = true;
    const bf16_t* Gt; bf16_t* Mg;
    __device__ __forceinline__ void operator()(const f32x4 (&acc)[2][2][4][2], const Unit& u, int wr, int wc, int fr, int fq) const {
        const int row0 = u.pm * BM + wr * 64 + fr, col0 = u.pn * BM + wc * 32 + 8 * fq;
#pragma unroll
        for (int ai = 0; ai < 2; ++ai) {
            u32x4 gq[4][2], mq[4][2];
#pragma unroll
            for (int m = 0; m < 4; ++m) { const size_t off = (size_t)(row0 + ai * HALF + m * 16) * D_MODEL + col0;
#pragma unroll
                for (int bj = 0; bj < 2; ++bj) { gq[m][bj] = *(const u32x4*)(Gt + off + bj * HALF); if (!FIRST) mq[m][bj] = *(const u32x4*)(Mg + off + bj * HALF); } }
#pragma unroll
            for (int m = 0; m < 4; ++m) { const size_t off = (size_t)(row0 + ai * HALF + m * 16) * D_MODEL + col0;
#pragma unroll
                for (int bj = 0; bj < 2; ++bj) { float gt[8], o[8]; unpack8(gq[m][bj], gt);
                    if (FIRST) {
#pragma unroll
                        for (int j = 0; j < 8; ++j) o[j] = 0.f;
                    } else unpack8(mq[m][bj], o);
#pragma unroll
                    for (int j = 0; j < 4; ++j) { o[j] += gt[j] * acc[ai][bj][m][0][j]; o[4 + j] += gt[4 + j] * acc[ai][bj][m][1][j]; }
                    *(u32x4*)(Mg + off + bj * HALF) = pack8(o); } }
            EPI_FENCE(); }
    }
};
struct EpiAttn {
    static constexpr bool PERM = false;
    bf16_t* C2; bf16_t* VT; const float* qg; const float* kg;
    __device__ __forceinline__ void operator()(const f32x4 (&acc)[2][2][4][2], const Unit& u, int wr, int wc, int fr, int fq) const {
        if (u.pn == 2 && wc >= 2) {
#pragma unroll
            for (int ai = 0; ai < 2; ++ai)
#pragma unroll
                for (int m = 0; m < 4; ++m) { const int row = u.pm * BM + ai * HALF + wr * 64 + m * 16 + fr;
                    bf16_t* rowp = C2 + (size_t)row * LD_C2 + 2048 + wc * 64 + 4 * fq;
#pragma unroll
                    for (int bj = 0; bj < 2; ++bj)
#pragma unroll
                        for (int n = 0; n < 2; ++n) { const f32x4 x = acc[ai][bj][m][n]; u32x2 w; w.x = cvt_pk_bf16(x[0], x[1]); w.y = cvt_pk_bf16(x[2], x[3]); *(u32x2*)(rowp + 32 * bj + 16 * n) = w; }
                    EPI_FENCE(); }
        } else {
            const bool isK = (u.pn == 2);
            int opq = 0; asm volatile("" : "+v"(opq));
            fq += opq; fr += opq;
            const float* gp = isK ? kg : qg;
            const int colbase = isK ? (2048 + wc * 64) : (1536 + (u.pn * 4 + wc) * 64);
            const float sc = isK ? 1.f : 0.125f * LOG2E;
            float gv[2][2][4], invf[4];
#pragma unroll
            for (int bj = 0; bj < 2; ++bj)
#pragma unroll
                for (int n = 0; n < 2; ++n)
#pragma unroll
                    for (int j = 0; j < 4; ++j) gv[bj][n][j] = gp[32 * bj + 16 * n + 4 * fq + j] * sc;
#pragma unroll
            for (int j = 0; j < 4; ++j) invf[j] = __builtin_amdgcn_exp2f(-(float)(4 * fq + j) * (13.287712379549449f / 16.f));
#pragma unroll
            for (int ai = 0; ai < 2; ++ai)
#pragma unroll
                for (int m = 0; m < 4; ++m) { const int row = u.pm * BM + ai * HALF + wr * 64 + m * 16 + fr; const int t = row & 4095;
                    float ss = 0.f;
#pragma unroll
                    for (int bj = 0; bj < 2; ++bj)
#pragma unroll
                        for (int n = 0; n < 2; ++n) { const f32x4 x = acc[ai][bj][m][n]; ss += (x[0] * x[0] + x[1] * x[1]) + (x[2] * x[2] + x[3] * x[3]); }
                    ss += __shfl_xor(ss, 16); ss += __shfl_xor(ss, 32);
                    const float rinv = __builtin_amdgcn_rsqf(ss * (1.f / 64.f) + 1e-6f);
                    bf16_t* rowp = C2 + (size_t)row * LD_C2 + colbase + 4 * fq;
#pragma unroll
                    for (int bj = 0; bj < 2; ++bj) { const float pos = (float)(bj ? (t & 63) : (t >> 6)); float o1[4], o2[4];
#pragma unroll
                        for (int j = 0; j < 4; ++j) { const float ang = pos * invf[j], c = __cosf(ang), s = __sinf(ang);
                            const float x1 = acc[ai][bj][m][0][j] * rinv * gv[bj][0][j], x2 = acc[ai][bj][m][1][j] * rinv * gv[bj][1][j];
                            o1[j] = x1 * c - x2 * s; o2[j] = x2 * c + x1 * s; }
                        u32x2 w1, w2; w1.x = cvt_pk_bf16(o1[0], o1[1]); w1.y = cvt_pk_bf16(o1[2], o1[3]); w2.x = cvt_pk_bf16(o2[0], o2[1]); w2.y = cvt_pk_bf16(o2[2], o2[3]);
                        *(u32x2*)(rowp + 32 * bj) = w1; *(u32x2*)(rowp + 32 * bj + 16) = w2; }
                    EPI_FENCE(); }
        }
    }
};
}

struct Params { const float* in[24]; float* out; unsigned char* ws; };

__device__ __forceinline__ void transpose_item(const float* W, int ldw, int k0, int n_src, bf16_t* WT, int ldt, int dst_row0, LAS float* scr, int lane) {
#pragma unroll 8
    for (int i = 0; i < 32; ++i) { const int kk = 2 * i + (lane >> 5); scr[kk * 33 + (lane & 31)] = W[(size_t)(k0 + kk) * ldw + n_src + (lane & 31)]; }
    asm volatile("s_waitcnt lgkmcnt(0)" ::: "memory");
    const int c = lane & 7;
#pragma unroll
    for (int j = 0; j < 4; ++j) { const int n = (lane >> 3) + 8 * j; const LAS float* s = scr + (8 * c) * 33 + n;
        u32x4 o; o.x = cvt_pk_bf16(s[0 * 33], s[1 * 33]); o.y = cvt_pk_bf16(s[2 * 33], s[3 * 33]); o.z = cvt_pk_bf16(s[4 * 33], s[5 * 33]); o.w = cvt_pk_bf16(s[6 * 33], s[7 * 33]);
        *(u32x4*)(WT + (size_t)(dst_row0 + n) * ldt + k0 + 8 * c) = o; }
    asm volatile("s_waitcnt lgkmcnt(0)" ::: "memory");
}
__device__ __forceinline__ void rms_row2(const float* xrow0, const float* xrow1, const float* g, bf16_t* orow0, bf16_t* orow1, int lane) {
    const f32x4* xr0 = (const f32x4*)xrow0 + lane; const f32x4* xr1 = (const f32x4*)xrow1 + lane; const f32x4* gr = (const f32x4*)g + lane;
    f32x4 v0[4], v1[4]; float s0 = 0.f, s1 = 0.f;
#pragma unroll
    for (int j = 0; j < 4; ++j) { v0[j] = xr0[64 * j]; v1[j] = xr1[64 * j]; }
#pragma unroll
    for (int j = 0; j < 4; ++j) { s0 += (v0[j].x * v0[j].x + v0[j].y * v0[j].y) + (v0[j].z * v0[j].z + v0[j].w * v0[j].w); s1 += (v1[j].x * v1[j].x + v1[j].y * v1[j].y) + (v1[j].z * v1[j].z + v1[j].w * v1[j].w); }
    const float inv0 = __builtin_amdgcn_rsqf(wave_sum(s0) * (1.f / D_MODEL) + 1e-6f), inv1 = __builtin_amdgcn_rsqf(wave_sum(s1) * (1.f / D_MODEL) + 1e-6f);
    u32x2* o0 = (u32x2*)orow0 + lane; u32x2* o1 = (u32x2*)orow1 + lane;
#pragma unroll
    for (int j = 0; j < 4; ++j) { const f32x4 gg = gr[64 * j]; u32x2 w;
        w.x = cvt_pk_bf16(v0[j].x * inv0 * gg.x, v0[j].y * inv0 * gg.y); w.y = cvt_pk_bf16(v0[j].z * inv0 * gg.z, v0[j].w * inv0 * gg.w); o0[64 * j] = w;
        w.x = cvt_pk_bf16(v1[j].x * inv1 * gg.x, v1[j].y * inv1 * gg.y); w.y = cvt_pk_bf16(v1[j].z * inv1 * gg.z, v1[j].w * inv1 * gg.w); o1[64 * j] = w; }
}
__device__ __forceinline__ void rms_row(const float* xrow, const float* g, bf16_t* orow, int lane) {
    const f32x4* xr = (const f32x4*)xrow + lane; const f32x4* gr = (const f32x4*)g + lane;
    f32x4 v[4]; float s = 0.f;
#pragma unroll
    for (int j = 0; j < 4; ++j) { v[j] = xr[64 * j]; s += (v[j].x * v[j].x + v[j].y * v[j].y) + (v[j].z * v[j].z + v[j].w * v[j].w); }
    const float inv = __builtin_amdgcn_rsqf(wave_sum(s) * (1.f / D_MODEL) + 1e-6f);
    u32x2* o8 = (u32x2*)orow + lane;
#pragma unroll
    for (int j = 0; j < 4; ++j) { const f32x4 gg = gr[64 * j]; u32x2 w; w.x = cvt_pk_bf16(v[j].x * inv * gg.x, v[j].y * inv * gg.y); w.y = cvt_pk_bf16(v[j].z * inv * gg.z, v[j].w * inv * gg.w); o8[64 * j] = w; }
}

constexpr int AT_KSTR = 72, AT_VSTR = 68;
constexpr int AT_KBYTES = 64 * AT_KSTR * 2, AT_VBYTES = 64 * AT_VSTR * 2;
__device__ __forceinline__ void vt_write(LAS unsigned char* p, const u32x4 v) {
    *(LAS unsigned short*)(p + 0 * (AT_VSTR * 2)) = (unsigned short)(v.x & 0xffffu); *(LAS unsigned short*)(p + 1 * (AT_VSTR * 2)) = (unsigned short)(v.x >> 16);
    *(LAS unsigned short*)(p + 2 * (AT_VSTR * 2)) = (unsigned short)(v.y & 0xffffu); *(LAS unsigned short*)(p + 3 * (AT_VSTR * 2)) = (unsigned short)(v.y >> 16);
    *(LAS unsigned short*)(p + 4 * (AT_VSTR * 2)) = (unsigned short)(v.z & 0xffffu); *(LAS unsigned short*)(p + 5 * (AT_VSTR * 2)) = (unsigned short)(v.z >> 16);
    *(LAS unsigned short*)(p + 6 * (AT_VSTR * 2)) = (unsigned short)(v.w & 0xffffu); *(LAS unsigned short*)(p + 7 * (AT_VSTR * 2)) = (unsigned short)(v.w >> 16);
}
__device__ __forceinline__ void attn_tile(LAS unsigned char* lds, int cur, int r32, int hi, const bf16x8 (&qf)[4], float& mref, float& lrun, f32x16& o0, f32x16& o1) {
        const LAS unsigned char* kb = lds + cur * AT_KBYTES + r32 * (AT_KSTR * 2) + hi * 16;
        f32x16 p0, p1;
        { const float nm = -mref;
#pragma unroll
          for (int r = 0; r < 16; ++r) { p0[r] = nm; p1[r] = nm; } }
#pragma unroll
        for (int d0 = 0; d0 < 4; ++d0) {
            const bf16x8 a0 = *(const LAS bf16x8*)(kb + d0 * 32), a1 = *(const LAS bf16x8*)(kb + 32 * (AT_KSTR * 2) + d0 * 32);
            p0 = __builtin_amdgcn_mfma_f32_32x32x16_bf16(a0, qf[d0], p0, 0, 0, 0);
            p1 = __builtin_amdgcn_mfma_f32_32x32x16_bf16(a1, qf[d0], p1, 0, 0, 0);
        }
        float mx = __builtin_fmaxf(__builtin_fmaxf(p0[0], p1[0]), p0[1]);
        mx = __builtin_fmaxf(__builtin_fmaxf(mx, p1[1]), p0[2]);
#pragma unroll
        for (int r = 2; r < 14; r += 2) { mx = __builtin_fmaxf(__builtin_fmaxf(mx, p1[r]), p0[r + 1]); mx = __builtin_fmaxf(__builtin_fmaxf(mx, p1[r + 1]), p0[r + 2]); }
        mx = __builtin_fmaxf(__builtin_fmaxf(mx, p1[14]), p0[15]); mx = __builtin_fmaxf(mx, p1[15]);
        mx = __builtin_fmaxf(mx, __shfl_xor(mx, 32));
        if (__builtin_expect(__any(mx > 8.0f), 0)) {
            const float dl = __builtin_fmaxf(mx, 0.f), f = __builtin_amdgcn_exp2f(-dl);
            mref += dl; lrun *= f;
#pragma unroll
            for (int r = 0; r < 16; ++r) { p0[r] -= dl; p1[r] -= dl; o0[r] *= f; o1[r] *= f; }
        }
        f32x2 ls2 = {0.f, 0.f};
#pragma unroll
        for (int r = 0; r < 16; r += 2) {
            p0[r] = __builtin_amdgcn_exp2f(p0[r]); p0[r + 1] = __builtin_amdgcn_exp2f(p0[r + 1]); p1[r] = __builtin_amdgcn_exp2f(p1[r]); p1[r + 1] = __builtin_amdgcn_exp2f(p1[r + 1]);
            ls2 += (f32x2){p0[r], p0[r + 1]}; ls2 += (f32x2){p1[r], p1[r + 1]};
        }
        lrun += ls2.x + ls2.y;
        bf16x8 pf[4];
        { u32x4 w;
          w.x = cvt_pk_bf16(p0[0], p0[1]); w.y = cvt_pk_bf16(p0[2], p0[3]); w.z = cvt_pk_bf16(p0[4], p0[5]); w.w = cvt_pk_bf16(p0[6], p0[7]); pf[0] = __builtin_bit_cast(bf16x8, w);
          w.x = cvt_pk_bf16(p0[8], p0[9]); w.y = cvt_pk_bf16(p0[10], p0[11]); w.z = cvt_pk_bf16(p0[12], p0[13]); w.w = cvt_pk_bf16(p0[14], p0[15]); pf[1] = __builtin_bit_cast(bf16x8, w);
          w.x = cvt_pk_bf16(p1[0], p1[1]); w.y = cvt_pk_bf16(p1[2], p1[3]); w.z = cvt_pk_bf16(p1[4], p1[5]); w.w = cvt_pk_bf16(p1[6], p1[7]); pf[2] = __builtin_bit_cast(bf16x8, w);
          w.x = cvt_pk_bf16(p1[8], p1[9]); w.y = cvt_pk_bf16(p1[10], p1[11]); w.z = cvt_pk_bf16(p1[12], p1[13]); w.w = cvt_pk_bf16(p1[14], p1[15]); pf[3] = __builtin_bit_cast(bf16x8, w); }
        const LAS unsigned char* vb = lds + 2 * AT_KBYTES + cur * AT_VBYTES + r32 * (AT_VSTR * 2) + hi * 8;
#pragma unroll
        for (int s = 0; s < 4; ++s) {
            const int koff = ((s >> 1) * 32 + (s & 1) * 16) * 2;
            const u32x2 l0 = *(const LAS u32x2*)(vb + koff), h0 = *(const LAS u32x2*)(vb + koff + 16);
            const u32x2 l1 = *(const LAS u32x2*)(vb + 32 * (AT_VSTR * 2) + koff), h1 = *(const LAS u32x2*)(vb + 32 * (AT_VSTR * 2) + koff + 16);
            const bf16x8 a0 = __builtin_bit_cast(bf16x8, (u32x4){l0.x, l0.y, h0.x, h0.y}), a1 = __builtin_bit_cast(bf16x8, (u32x4){l1.x, l1.y, h1.x, h1.y});
            o0 = __builtin_amdgcn_mfma_f32_32x32x16_bf16(a0, pf[s], o0, 0, 0, 0);
            o1 = __builtin_amdgcn_mfma_f32_32x32x16_bf16(a1, pf[s], o1, 0, 0, 0);
        }
}
__device__ __forceinline__ void attn_unit(LAS unsigned char* lds, bf16_t* C2, bf16_t* Odummy, int b, int kvh, int qb) {
    int tid = threadIdx.x; asm volatile("" : "+v"(tid));
    const int lane = tid & 63, r32 = lane & 31, hi = lane >> 5, wid = __builtin_amdgcn_readfirstlane(tid >> 6);
    const int g = wid & 3, th = wid >> 2, head = kvh * 4 + g;
    const size_t rowbase = (size_t)b * SEQ;
    const int tok0 = qb * 128 + th * 64;
    bf16_t* qrowA = C2 + (rowbase + tok0 + r32) * LD_C2 + 1536 + head * 64;
    bf16_t* qrowB = qrowA + (size_t)32 * LD_C2;
    bf16x8 qfA[4], qfB[4];
#pragma unroll
    for (int d0 = 0; d0 < 4; ++d0) { qfA[d0] = *(const bf16x8*)(qrowA + d0 * 16 + hi * 8); qfB[d0] = *(const bf16x8*)(qrowB + d0 * 16 + hi * 8); }
    const int srow = tid >> 3, sch = tid & 7;
    const bf16_t* ksrc = C2 + (rowbase + srow) * LD_C2 + 2048 + kvh * 64 + sch * 8;
    const bf16_t* vsrc = ksrc + 128;
    LAS unsigned char* kdst = lds + srow * (AT_KSTR * 2) + sch * 16;
    LAS unsigned char* vdst = lds + 2 * AT_KBYTES + (8 * sch) * (AT_VSTR * 2) + srow * 2;
    u32x4 kregA = *(const u32x4*)ksrc, vregA = *(const u32x4*)vsrc, kregB, vregB;
    *(LAS u32x4*)kdst = kregA; vt_write(vdst, vregA);
    kregA = *(const u32x4*)(ksrc + (size_t)64 * LD_C2); vregA = *(const u32x4*)(vsrc + (size_t)64 * LD_C2);
    __syncthreads();
    f32x16 oA0 = {}, oA1 = {}, oB0 = {}, oB1 = {};
    float mrefA = 0.f, lrunA = 0.f, mrefB = 0.f, lrunB = 0.f;
#define AT_STEP(kt, cur, KW, VW, KL, VL) { \
        if ((kt) + 2 < SEQ / 64) { KL = *(const u32x4*)(ksrc + (size_t)((kt) + 2) * 64 * LD_C2); VL = *(const u32x4*)(vsrc + (size_t)((kt) + 2) * 64 * LD_C2); } \
        attn_tile(lds, cur, r32, hi, qfA, mrefA, lrunA, oA0, oA1); \
        __builtin_amdgcn_sched_barrier(0); \
        attn_tile(lds, cur, r32, hi, qfB, mrefB, lrunB, oB0, oB1); \
        __builtin_amdgcn_sched_barrier(0); \
        if ((kt) + 1 < SEQ / 64) { *(LAS u32x4*)(kdst + ((cur) ^ 1) * AT_KBYTES) = KW; vt_write(vdst + ((cur) ^ 1) * AT_VBYTES, VW); } \
        __syncthreads(); }
    for (int kt = 0; kt < SEQ / 64; kt += 2) {
        AT_STEP(kt, 0, kregA, vregA, kregB, vregB);
        AT_STEP(kt + 1, 1, kregB, vregB, kregA, vregA);
    }
#undef AT_STEP
#pragma unroll
    for (int blk = 0; blk < 2; ++blk) {
        float lr = blk ? lrunB : lrunA; lr += __shfl_xor(lr, 32);
        const float rl = __builtin_amdgcn_rcpf(lr);
        const f32x16& o0 = blk ? oB0 : oA0; const f32x16& o1 = blk ? oB1 : oA1;
        bf16_t* qrow = blk ? qrowB : qrowA;
        bf16_t* orow = Odummy ? Odummy + (rowbase + tok0 + 32 * blk + r32) * 512 + head * 64 : qrow;
#pragma unroll
        for (int g4 = 0; g4 < 4; ++g4) {
            u32x2 w0, w1;
            w0.x = cvt_pk_bf16(o0[4 * g4] * rl, o0[4 * g4 + 1] * rl); w0.y = cvt_pk_bf16(o0[4 * g4 + 2] * rl, o0[4 * g4 + 3] * rl);
            w1.x = cvt_pk_bf16(o1[4 * g4] * rl, o1[4 * g4 + 1] * rl); w1.y = cvt_pk_bf16(o1[4 * g4 + 2] * rl, o1[4 * g4 + 3] * rl);
            *(u32x2*)(orow + 8 * g4 + 4 * hi) = w0; *(u32x2*)(orow + 32 + 8 * g4 + 4 * hi) = w1;
        }
    }
}

__device__ __forceinline__ void conv_item(bf16_t* C2, const float* cvw, const float* cvb, int idx) {
    const int m = idx >> 6, c0 = (idx & 63) * 8, t = m & 4095;
    bf16_t* rp = C2 + (size_t)m * LD_C2 + c0;
    const bf16_t* rpp = (t > 0) ? rp - LD_C2 : rp; const bf16_t* rpn = (t < SEQ - 1) ? rp + LD_C2 : rp;
    const float fp = (t > 0) ? 1.f : 0.f, fn = (t < SEQ - 1) ? 1.f : 0.f;
    float bg[8], c[8], x[8], a[8], bq[8], a2[8], b2[8], o[8];
    unpack8(*(const u32x4*)rp, bg); unpack8(*(const u32x4*)(rp + 512), c); unpack8(*(const u32x4*)(rp + 1024), x);
    unpack8(*(const u32x4*)(rpp + 512), a); unpack8(*(const u32x4*)(rpp + 1024), bq); unpack8(*(const u32x4*)(rpn + 512), a2); unpack8(*(const u32x4*)(rpn + 1024), b2);
#pragma unroll
    for (int j = 0; j < 8; ++j) o[j] = bg[j] * (cvb[c0 + j] + cvw[c0 + j] * (a[j] * bq[j] * fp) + cvw[512 + c0 + j] * (c[j] * x[j]) + cvw[1024 + c0 + j] * (a2[j] * b2[j] * fn));
    *(u32x4*)rp = pack8(o);
}
constexpr int SC_CH = 32;
constexpr int SC_ARR = SC_CH * 64;
constexpr int SC_R = 0, SC_W = 1, SC_KD = 2, SC_V = 3, SC_KK = 4, SC_KKA = 5, SC_ZK = 6, SC_NARR = 7;
constexpr int SC_SLOT = SC_NARR * SC_ARR;
constexpr int SC_BW_OFF = 4096, SC_BA_OFF = 4096 + 9216;
constexpr int SC_TAB = 2 * SC_SLOT;
struct ScanW { const float *mu_prev, *mu_next, *w0, *a0, *k_k, *k_a, *r_k; const bf16_t *w2t, *a2t; };

__device__ __forceinline__ void scan_produce(LAS float* sl, LAS float* tab, const bf16_t* RWC, bf16_t* SG, float* SB, const ScanW& sw, const float* mu_gd_p, const float* mu_gd_n,
                                             int b, int h, int dir, int chunk, int sub, int lane) {
    asm volatile("" : "+v"(lane));
    const int tok = lane & 15, q = lane >> 4;
    const int tokidx = 16 * sub + tok;
    const int sc = chunk * SC_CH + tokidx;
    const int t = dir ? (SEQ - 1 - sc) : sc;
    const bf16_t* rp = RWC + ((size_t)b * SEQ + t) * LD_RWC;
    const bool hasp = t > 0, hasn = t < SEQ - 1;
    const bf16_t* rpp = hasp ? rp - LD_RWC : rp;
    const bf16_t* rpn = hasn ? rp + LD_RWC : rp;
    const float fp = hasp ? 1.f : 0.f, fn = hasn ? 1.f : 0.f;
    u32x4 Lc[6], Lp[6], Ln[6];
#pragma unroll
    for (int G = 0; G < 3; ++G)
#pragma unroll
        for (int hf = 0; hf < 2; ++hf) { const int cb = G * 512 + h * 64 + 16 * q + 8 * hf;
            Lc[2 * G + hf] = *(const u32x4*)(rp + cb); Lp[2 * G + hf] = *(const u32x4*)(rpp + cb); Ln[2 * G + hf] = *(const u32x4*)(rpn + cb); }
    u32x4 Mc[5], Mp[5], Mn[5];
#pragma unroll
    for (int i = 0; i < 4; ++i) { const int cb = 1536 + (i >> 1) * 128 + dir * 64 + 32 * (i & 1) + 8 * q;
        Mc[i] = *(const u32x4*)(rp + cb); Mp[i] = *(const u32x4*)(rpp + cb); Mn[i] = *(const u32x4*)(rpn + cb); }
    float zk[16];
#pragma unroll
    for (int G = 0; G < 3; ++G) {
        float z[16];
#pragma unroll
        for (int hf = 0; hf < 2; ++hf) {
            float c[8], p[8], n[8];
            unpack8(Lc[2 * G + hf], c); unpack8(Lp[2 * G + hf], p); unpack8(Ln[2 * G + hf], n);
            const LAS float* mp = tab + G * 64 + 16 * q + 8 * hf; const LAS float* mn = mp + 320;
#pragma unroll
            for (int j = 0; j < 8; ++j) z[8 * hf + j] = c[j] + mp[j] * (p[j] * fp - c[j]) + mn[j] * (n[j] * fn - c[j]);
        }
        LAS float* dst = sl + (G == 0 ? SC_R : (G == 1 ? SC_ZK : SC_V)) * SC_ARR + tokidx * 64 + 16 * q;
#pragma unroll
        for (int j4 = 0; j4 < 4; ++j4) *(LAS f32x4*)(dst + 4 * j4) = (f32x4){z[4 * j4], z[4 * j4 + 1], z[4 * j4 + 2], z[4 * j4 + 3]};
        if (G == 1) {
#pragma unroll
            for (int j = 0; j < 16; ++j) zk[j] = z[j];
        }
    }
    {
        const LAS float* kkt = tab + 640 + 16 * q;
        float kr[16], ss = 0.f;
#pragma unroll
        for (int j = 0; j < 16; ++j) { kr[j] = zk[j] * kkt[j]; ss += kr[j] * kr[j]; }
        ss += __shfl_xor(ss, 16); ss += __shfl_xor(ss, 32);
        const float inv = 1.f / fmaxf(sqrtf(ss), 1e-12f);
        LAS float* dst = sl + SC_KK * SC_ARR + tokidx * 64 + 16 * q;
#pragma unroll
        for (int j4 = 0; j4 < 4; ++j4) *(LAS f32x4*)(dst + 4 * j4) = (f32x4){kr[4 * j4] * inv, kr[4 * j4 + 1] * inv, kr[4 * j4 + 2] * inv, kr[4 * j4 + 3] * inv};
    }
    bf16x8 Awd[2], Aad[2];
#pragma unroll
    for (int i = 0; i < 4; ++i) {
        const int G = 3 + (i >> 1), ks = i & 1;
        float c[8], p[8], n[8], z[8];
        unpack8(Mc[i], c); unpack8(Mp[i], p); unpack8(Mn[i], n);
        const LAS float* mp = tab + G * 64 + 32 * ks + 8 * q; const LAS float* mn = mp + 320;
#pragma unroll
        for (int j = 0; j < 8; ++j) { z[j] = c[j] + mp[j] * (p[j] * fp - c[j]) + mn[j] * (n[j] * fn - c[j]); if (G == 3) z[j] = tanh_f(z[j]); }
        const bf16x8 fr8 = __builtin_bit_cast(bf16x8, pack8(z));
        if (G == 3) Awd[ks] = fr8; else Aad[ks] = fr8;
    }
    asm volatile("s_waitcnt lgkmcnt(0)" ::: "memory");
    f32x4 aw[4], aa[4];
    float w0r[4], a0r[4], kar[4];
#pragma unroll
    for (int nb = 0; nb < 4; ++nb) {
        const int cl = 16 * nb + (lane & 15);
        const LAS unsigned char* wp = (const LAS unsigned char*)tab + SC_BW_OFF + cl * 144 + 16 * (lane >> 4); const LAS unsigned char* ap = wp + (SC_BA_OFF - SC_BW_OFF);
        const bf16x8 bw0 = *(const LAS bf16x8*)wp, bw1 = *(const LAS bf16x8*)(wp + 64), ba0 = *(const LAS bf16x8*)ap, ba1 = *(const LAS bf16x8*)(ap + 64);
        w0r[nb] = tab[720 + cl]; a0r[nb] = tab[784 + cl]; kar[nb] = tab[848 + cl];
        aw[nb] = __builtin_amdgcn_mfma_f32_16x16x32_bf16(Awd[0], bw0, (f32x4){0.f, 0.f, 0.f, 0.f}, 0, 0, 0);
        aw[nb] = __builtin_amdgcn_mfma_f32_16x16x32_bf16(Awd[1], bw1, aw[nb], 0, 0, 0);
        aa[nb] = __builtin_amdgcn_mfma_f32_16x16x32_bf16(Aad[0], ba0, (f32x4){0.f, 0.f, 0.f, 0.f}, 0, 0, 0);
        aa[nb] = __builtin_amdgcn_mfma_f32_16x16x32_bf16(Aad[1], ba1, aa[nb], 0, 0, 0);
    }
#pragma unroll
    for (int nb = 0; nb < 4; ++nb)
#pragma unroll
        for (int rg = 0; rg < 4; ++rg) {
            const int ti = 16 * sub + 4 * q + rg, c = 16 * nb + (lane & 15), o = ti * 64 + c;
            const float dec = trans_settle(__builtin_amdgcn_exp2f(-0.6065306597126334f * LOG2E * sigmoid_f(aw[nb][rg] + w0r[nb])));
            const float a = sigmoid_f(aa[nb][rg] + a0r[nb]);
            const float zkv = sl[SC_ZK * SC_ARR + o], kkv = sl[SC_KK * SC_ARR + o];
            const float kd = zkv * (1.f + (a - 1.f) * kar[nb]);
            sl[SC_W * SC_ARR + o] = dec; sl[SC_KD * SC_ARR + o] = kd; sl[SC_KKA * SC_ARR + o] = kkv * a;
        }
}

__device__ __forceinline__ void scan_unit(LAS unsigned char* lds, const bf16_t* RWC, bf16_t* YF, bf16_t* YB, bf16_t* SG, float* SB, const ScanW& sw, int b, int h, int dir,
                                          bf16_t* C2cv, const float* cvw, const float* cvb, int unit) {
    int tid = threadIdx.x; asm volatile("" : "+v"(tid));
    const int lane = tid & 63, wid = __builtin_amdgcn_readfirstlane(tid >> 6);
    LAS float* fl = (LAS float*)lds;
    LAS float* tab = fl + SC_TAB;
    for (int i = tid; i < 976; i += 512) {
        float v;
        if (i < 640) { const int pn = i / 320, r = i % 320, G = r / 64, ch = r % 64;
            const int col = (G < 3) ? (G * 512 + h * 64 + ch) : (1536 + (G - 3) * 128 + dir * 64 + ch);
            v = (pn ? sw.mu_next : sw.mu_prev)[col]; }
        else if (i < 704) v = sw.k_k[h * 64 + (i - 640)];
        else if (i < 720) { const int j = i - 704; v = ((j >> 3) ? sw.mu_next : sw.mu_prev)[1792 + 8 * (2 * h + dir) + (j & 7)]; }
        else { const int k = i - 720, which = k >> 6, c = k & 63;
            v = which == 0 ? sw.w0[dir * 512 + h * 64 + c] : (which == 1 ? sw.a0[dir * 512 + h * 64 + c] : (which == 2 ? sw.k_a[h * 64 + c] : sw.r_k[h * 64 + c])); }
        tab[i] = v;
    }
    { const int row = tid >> 3, chunk = tid & 7; const size_t src = ((size_t)(dir * 512 + h * 64 + row)) * 64 + chunk * 8;
      *(LAS u32x4*)((LAS unsigned char*)tab + SC_BW_OFF + row * 144 + chunk * 16) = *(const u32x4*)(sw.w2t + src);
      *(LAS u32x4*)((LAS unsigned char*)tab + SC_BA_OFF + row * 144 + chunk * 16) = *(const u32x4*)(sw.a2t + src); }
    __syncthreads();
    if (wid >= 4 && wid < 6) scan_produce(fl, tab, RWC, SG, SB, sw, sw.mu_prev + 1792, sw.mu_next + 1792, b, h, dir, 0, wid - 4, lane);
    __syncthreads();
    const int vp = tid >> 3, kq = tid & 7;
    f32x2 S0[4], S1[4];
#pragma unroll
    for (int i = 0; i < 4; ++i) { S0[i] = (f32x2){0.f, 0.f}; S1[i] = (f32x2){0.f, 0.f}; }
    bf16_t* Y = dir ? YB : YF;
    for (int ch = 0; ch < SEQ / SC_CH; ++ch) {
        LAS float* sl = fl + (ch & 1) * SC_SLOT;
        if (wid < 4) {
            const LAS float* base = sl + 8 * kq;
            const LAS float* vbase = sl + SC_V * SC_ARR + 2 * vp;
            f32x4 nkk0, nkk1, nw0, nw1, nka0, nka1, nkd0, nkd1, nr0, nr1; f32x2 nvv;
#define SC_LOAD(s_) do { const LAS float* p_ = base + (s_) * 64; \
                nkk0 = *(const LAS f32x4*)(p_ + SC_KK * SC_ARR); nkk1 = *(const LAS f32x4*)(p_ + SC_KK * SC_ARR + 4); \
                nw0 = *(const LAS f32x4*)(p_ + SC_W * SC_ARR); nw1 = *(const LAS f32x4*)(p_ + SC_W * SC_ARR + 4); \
                nka0 = *(const LAS f32x4*)(p_ + SC_KKA * SC_ARR); nka1 = *(const LAS f32x4*)(p_ + SC_KKA * SC_ARR + 4); \
                nkd0 = *(const LAS f32x4*)(p_ + SC_KD * SC_ARR); nkd1 = *(const LAS f32x4*)(p_ + SC_KD * SC_ARR + 4); \
                nr0 = *(const LAS f32x4*)(p_ + SC_R * SC_ARR); nr1 = *(const LAS f32x4*)(p_ + SC_R * SC_ARR + 4); \
                nvv = *(const LAS f32x2*)(vbase + (s_) * 64); } while (0)
            SC_LOAD(0);
#pragma unroll 2
            for (int s = 0; s < SC_CH; ++s) {
                f32x2 kk[4], w[4], ka[4], kd[4], r[4];
                kk[0] = nkk0.xy; kk[1] = nkk0.zw; kk[2] = nkk1.xy; kk[3] = nkk1.zw;
                w[0] = nw0.xy; w[1] = nw0.zw; w[2] = nw1.xy; w[3] = nw1.zw;
                ka[0] = nka0.xy; ka[1] = nka0.zw; ka[2] = nka1.xy; ka[3] = nka1.zw;
                kd[0] = nkd0.xy; kd[1] = nkd0.zw; kd[2] = nkd1.xy; kd[3] = nkd1.zw;
                r[0] = nr0.xy; r[1] = nr0.zw; r[2] = nr1.xy; r[3] = nr1.zw;
                const f32x2 vv = nvv;
                SC_LOAD((s + 1) & (SC_CH - 1));
                f32x2 t0 = S0[0] * kk[0], t1 = S1[0] * kk[0];
#pragma unroll
                for (int i = 1; i < 4; ++i) { t0 = S0[i] * kk[i] + t0; t1 = S1[i] * kk[i] + t1; }
                const float sa0 = red8(t0.x + t0.y), sa1 = red8(t1.x + t1.y);
                const f32x2 n0 = (f32x2){-sa0, -sa0}, n1 = (f32x2){-sa1, -sa1}, v0 = (f32x2){vv.x, vv.x}, v1 = (f32x2){vv.y, vv.y};
                f32x2 y0 = (f32x2){0.f, 0.f}, y1 = (f32x2){0.f, 0.f};
#pragma unroll
                for (int i = 0; i < 4; ++i) {
                    S0[i] = S0[i] * w[i] + (v0 * kd[i] + n0 * ka[i]);
                    S1[i] = S1[i] * w[i] + (v1 * kd[i] + n1 * ka[i]);
                    y0 = S0[i] * r[i] + y0; y1 = S1[i] * r[i] + y1;
                }
                float yp0 = y0.x + y0.y, yp1 = y1.x + y1.y; asm volatile("" : "+v"(yp0));
                const float ys0 = red8_nopack(yp0), ys1 = red8(yp1);
                if (kq == 0) { const int sc = ch * SC_CH + s; const int t = dir ? (SEQ - 1 - sc) : sc;
                    *(unsigned*)(Y + ((size_t)b * SEQ + t) * 512 + h * 64 + 2 * vp) = cvt_pk_bf16(ys0, ys1); }
            }
#undef SC_LOAD
        } else if (wid < 6) {
            if (ch + 1 < SEQ / SC_CH) scan_produce(fl + ((ch + 1) & 1) * SC_SLOT, tab, RWC, SG, SB, sw, sw.mu_prev + 1792, sw.mu_next + 1792, b, h, dir, ch + 1, wid - 4, lane);
        } else {
            conv_item(C2cv, cvw, cvb, unit * 16384 + ch * 128 + (tid - 384));
            { const int j = tid - 384, tok = j >> 2, pr = j & 3, sc = ch * SC_CH + tok, t = dir ? (SEQ - 1 - sc) : sc, cg8 = 8 * (2 * h + dir) + 2 * pr;
              const bf16_t* rp = RWC + ((size_t)b * SEQ + t) * LD_RWC + 1792 + cg8;
              const unsigned uc = *(const unsigned*)rp, up = *(const unsigned*)(t > 0 ? rp - LD_RWC : rp), un = *(const unsigned*)(t < SEQ - 1 ? rp + LD_RWC : rp);
              const float fp = t > 0 ? 1.f : 0.f, fn = t < SEQ - 1 ? 1.f : 0.f;
              const float c0 = bflo(uc), c1 = bfhi(uc);
              const float z0 = sigmoid_f(c0 + tab[704 + 2 * pr] * (bflo(up) * fp - c0) + tab[712 + 2 * pr] * (bflo(un) * fn - c0));
              const float z1 = sigmoid_f(c1 + tab[705 + 2 * pr] * (bfhi(up) * fp - c1) + tab[713 + 2 * pr] * (bfhi(un) * fn - c1));
              *(unsigned*)(SG + ((size_t)b * SEQ + t) * 256 + cg8) = cvt_pk_bf16(z0, z1); }
            { const int j = tid - 384, tok = j >> 2, qq = j & 3;
              const LAS float* rp = sl + SC_R * SC_ARR + tok * 64 + 16 * qq; const LAS float* kp = sl + SC_KD * SC_ARR + tok * 64 + 16 * qq; const LAS float* gp = tab + 912 + 16 * qq;
              float acc = 0.f;
#pragma unroll
              for (int i4 = 0; i4 < 4; ++i4) { const f32x4 r4 = *(const LAS f32x4*)(rp + 4 * i4), k4 = *(const LAS f32x4*)(kp + 4 * i4), g4 = *(const LAS f32x4*)(gp + 4 * i4);
                  acc += (r4[0] * k4[0] * g4[0] + r4[1] * k4[1] * g4[1]) + (r4[2] * k4[2] * g4[2] + r4[3] * k4[3] * g4[3]); }
              acc += dpp_f<0xB1>(acc); acc += dpp_f<0x4E>(acc);
              if (qq == 0) { const int sc = ch * SC_CH + tok; const int t = dir ? (SEQ - 1 - sc) : sc; SB[((size_t)dir * T + (size_t)b * SEQ + t) * 8 + h] = acc; } }
        }
        __syncthreads();
    }
}


#define XB_TMO      128
#define XB_XCNT(j)  (256  + 64 * (j))
#define XB_XSUB(j)  (1280 + 64 * (j))
#define XB_XGEN(j)  (2304 + 64 * (j))
#define XB_TOP      3328
#define XB_TOPGEN   3392
#define XB_SPIN_CAP (1u << 22)
__device__ __forceinline__ unsigned xb_ld(unsigned* p)              { return __hip_atomic_load(p, __ATOMIC_RELAXED, __HIP_MEMORY_SCOPE_AGENT); }
__device__ __forceinline__ unsigned xb_add(unsigned* p, unsigned v) { return __hip_atomic_fetch_add(p, v, __ATOMIC_RELAXED, __HIP_MEMORY_SCOPE_AGENT); }
__device__ __forceinline__ unsigned xb_xcc_id() { return (unsigned)__builtin_amdgcn_s_getreg((3 << 11) | 20) & 0xFu; }
#define XB_SPIN(cond, bar) do { unsigned _sp = 0; while (cond) { __builtin_amdgcn_s_sleep(1); \
    if ((++_sp & 255u) == 0u) { if (xb_ld(&(bar)[XB_TMO])) break; if (_sp > XB_SPIN_CAP) { atomicAdd(&(bar)[XB_TMO], 1u); break; } } } } while (0)
struct XcdBarrier { unsigned* bar; unsigned x; volatile LAS unsigned* st; };
__device__ __forceinline__ XcdBarrier xcd_barrier_post(unsigned* bar, volatile LAS unsigned* st) {
    XcdBarrier b; b.bar = bar; b.x = xb_xcc_id(); b.st = st;
    if (threadIdx.x == 0) (void)xb_add(&bar[XB_XCNT(b.x)], 1u);
    return b;
}
__device__ __forceinline__ void xcd_barrier_complete(unsigned* bar, unsigned x, unsigned& nloc, unsigned& nx) {
    const unsigned G = gridDim.x * gridDim.y * gridDim.z;
    unsigned sum, cnt, mine, sp = 0u;
    for (;;) {
        sum = 0u; cnt = 0u; mine = 0u;
#pragma unroll
        for (unsigned j = 0; j < 16; ++j) { const unsigned c = xb_ld(&bar[XB_XCNT(j)]); sum += c; cnt += (c > 0u) ? 1u : 0u; mine = (j == x) ? c : mine; }
        if (sum == G) break;
        __builtin_amdgcn_s_sleep(1);
        if ((++sp & 255u) == 0u) { if (xb_ld(&bar[XB_TMO])) break; if (sp > XB_SPIN_CAP) { atomicAdd(&bar[XB_TMO], 1u); break; } }
    }
    nloc = mine > 0u ? mine : 1u; nx = cnt > 0u ? cnt : 1u;
}
__device__ __forceinline__ void xcd_barrier(const XcdBarrier& b) {
    asm volatile("s_waitcnt vmcnt(0)" ::: "memory");
    __syncthreads();
    if (threadIdx.x == 0) {
        unsigned* bar = b.bar;
        __builtin_amdgcn_s_waitcnt(0);
        unsigned nloc = b.st[0], nx = b.st[1];
        if (nloc == 0u) { xcd_barrier_complete(bar, b.x, nloc, nx); b.st[0] = nloc; b.st[1] = nx; }
        const unsigned old = xb_add(&bar[XB_XSUB(b.x)], 1u);
        const unsigned gen = old / nloc;
        if (old + 1u == (gen + 1u) * nloc) {
            __builtin_amdgcn_fence(__ATOMIC_RELEASE, "agent");
            asm volatile("s_waitcnt vmcnt(0)" ::: "memory");
            const unsigned og = xb_add(&bar[XB_TOP], 1u);
            const unsigned tg = og / nx;
            if (og + 1u == (tg + 1u) * nx) xb_add(&bar[XB_TOPGEN], 1u);
            else XB_SPIN(xb_ld(&bar[XB_TOPGEN]) == tg, bar);
            __builtin_amdgcn_fence(__ATOMIC_ACQUIRE, "agent");
            xb_add(&bar[XB_XGEN(b.x)], 1u);
            asm volatile("s_waitcnt vmcnt(0)" ::: "memory");
        } else {
            XB_SPIN(xb_ld(&bar[XB_XGEN(b.x)]) == gen, bar);
            __builtin_amdgcn_fence(__ATOMIC_ACQUIRE, "agent");
            asm volatile("s_waitcnt vmcnt(0)" ::: "memory");
        }
    }
    __syncthreads();
}

#ifdef MK_DBG_STOP
#define DBG_STOP(k) do { if ((k) == MK_DBG_STOP && l == 0) { dbg_dump(p, ws0, bx * 512 + (int)threadIdx.x, G * 512); return; } } while (0)
__device__ __noinline__ void dbg_dump(const Params& p, unsigned char* ws, int gtid, int NGT) {
    const bf16_t* rwc = (const bf16_t*)(ws + WS_RWC); const bf16_t* c2 = (const bf16_t*)(ws + WS_C2); const bf16_t* yf = (const bf16_t*)(ws + WS_YF); const bf16_t* yb = (const bf16_t*)(ws + WS_YB);
    const bf16_t* sg = (const bf16_t*)(ws + WS_SG); const float* sb = (const float*)(ws + WS_SB); const bf16_t* hb = (const bf16_t*)(ws + WS_H);
    for (size_t i = gtid; i < (size_t)T * 1024; i += NGT) {
        const size_t m = i >> 10; const int c = (int)(i & 1023);
        float v = 0.f;
#if MK_DBG_WHAT == 0
        v = bflo(rwc[m * 2048 + 2 * c]) + bflo(rwc[m * 2048 + 2 * c + 1]);
#elif MK_DBG_WHAT == 1
        v = bflo(c2[m * 2304 + 2 * c]) + bflo(c2[m * 2304 + 2 * c + 1]) + (c < 256 ? bflo(c2[m * 2304 + 2048 + c]) : 0.f);
#elif MK_DBG_WHAT == 2
        v = (c < 512 ? bflo(yf[m * 512 + c]) : bflo(yb[m * 512 + c - 512]));
#elif MK_DBG_WHAT == 3
        v = (c < 256 ? bflo(sg[m * 256 + c]) : (c < 272 ? sb[((c - 256) >> 3) * (size_t)T * 8 + m * 8 + (c & 7)] : bflo(hb[m * 1024 + c])));
#elif MK_DBG_WHAT == 6
        v = bflo(((const bf16_t*)(ws + WS_WIN))[(size_t)(4352 + (m % 3072)) * 1024 + c]) + bflo(hb[m * 1024 + c]);
#elif MK_DBG_WHAT == 5
        v = bflo(((const bf16_t*)(ws + WS_GT))[m * 1024 + c]);
#elif MK_DBG_WHAT == 4
        v = bflo(rwc[(size_t)T * 1024 + m * 1024 + c]);
#endif
        p.out[i] = v;
    }
}
#else
#define DBG_STOP(k) do { } while (0)
#endif

#define L1_REFRESH() do { asm volatile("s_waitcnt vmcnt(0)" ::: "memory"); __builtin_amdgcn_fence(__ATOMIC_ACQUIRE, "agent"); asm volatile("s_waitcnt vmcnt(0)" ::: "memory"); } while (0)
#define PHASE_IDS() int tid = threadIdx.x; asm volatile("" : "+v"(tid)); const int lane = tid & 63, wave = __builtin_amdgcn_readfirstlane(tid >> 6); const int gw = vcu * 8 + wave, gtid = bx * 512 + tid; (void)lane; (void)gw; (void)gtid
#define Win_t ((bf16_t*)(ws + WS_WIN))
#define Wbr_t ((bf16_t*)(ws + WS_WBR))
#define Wout_t ((bf16_t*)(ws + WS_WOUT))
#define W1_t ((bf16_t*)(ws + WS_W1))
#define W2_t ((bf16_t*)(ws + WS_W2))
#define w2t ((bf16_t*)(ws + WS_W2T))
#define a2t ((bf16_t*)(ws + WS_A2T))
#define g2t ((bf16_t*)(ws + WS_G2T))
#define Hb ((bf16_t*)(ws + WS_H))
#define RWC ((bf16_t*)(ws + WS_RWC))
#define C2 ((bf16_t*)(ws + WS_C2))
#define YF ((bf16_t*)(ws + WS_YF))
#define YB ((bf16_t*)(ws + WS_YB))
#define SG ((bf16_t*)(ws + WS_SG))
#define VT ((bf16_t*)(ws + WS_VT))
#define SB ((float*)(ws + WS_SB))
#define Gt ((bf16_t*)(ws + WS_GT))
#define Mg ((bf16_t*)(ws + WS_MRG))
#define Ub ((bf16_t*)(ws + WS_U))
__global__ void __launch_bounds__(512, 2) fwd_megakernel(Params p) {
    extern __shared__ __attribute__((aligned(16))) unsigned char lds_raw[];
    LAS unsigned char* lds = (LAS unsigned char*)lds_raw;
    cg::grid_group grid = cg::this_grid();
    volatile LAS unsigned* misc = (volatile LAS unsigned*)(lds + 139264);
    if (threadIdx.x < 16) misc[threadIdx.x] = 0u;
    __syncthreads();
    XcdBarrier xbar = xcd_barrier_post((unsigned*)(p.ws + 65536), misc);
    grid.sync();
    const int G = gridDim.x, bx = blockIdx.x;
    const int vcu = (G % 8 == 0) ? (bx % 8) * (G / 8) + bx / 8 : bx;
    const int NGW = G * 8, NGT = G * 512;
    float* X = p.out;

    for (int l = 0; l < DEPTH; ++l) {
        const float* xin = (l == 0) ? p.in[0] : X;
        unsigned char* ws0 = p.ws; asm volatile("" : "+s"(ws0));
        GAS unsigned char* ws = (GAS unsigned char*)ws0;
        if (PHMASK & (1u << 0)) {
            PHASE_IDS();
            LAS float* scr = (LAS float*)(lds + wave * 8448);
            const float* w_in = p.in[2] + (size_t)l * D_MODEL * IN_COLS;
            const float* w_br = p.in[19] + (size_t)l * 3 * 512 * D_MODEL;
            const float* w_out = p.in[20] + (size_t)l * D_MODEL * D_MODEL;
            const float* w_m1 = p.in[22] + (size_t)l * D_MODEL * D_FF;
            const float* w_m2 = p.in[23] + (size_t)l * D_FF * D_MODEL;
            const float* rw_w2 = p.in[6] + (size_t)l * 2 * 64 * 512;
            const float* rw_a2 = p.in[8] + (size_t)l * 2 * 64 * 512;
            const float* rw_g2 = p.in[9] + (size_t)l * 128 * 512;
            constexpr int I_IN = 232 * 16, I_BR = 3 * 8 * 32, I_OUT = 16 * 32, I_M1 = 16 * 128, I_M2 = 64 * 32, I_L = 32, I_G = 32;
            constexpr int NITEMS = I_IN + I_BR + I_OUT + I_M1 + I_M2 + 2 * I_L + I_G;
            for (int it = gw; it < NITEMS; it += NGW) {
                int r = it;
                if (r < I_IN) { const int db = r % 232, kb = r / 232; int src;
                    if (db < 60) src = 32 * db;
                    else if (db < 64) {
                        const int c = lane & 7;
#pragma unroll
                        for (int j = 0; j < 4; ++j) { const int n = (lane >> 3) + 8 * j; *(u32x4*)(Win_t + (size_t)(32 * db + n) * D_MODEL + 64 * kb + 8 * c) = (u32x4){0u, 0u, 0u, 0u}; }
                        continue; }
                    else if (db < 112) src = 1920 + 32 * (db - 64);
                    else if (db < 136) { const int pp = 32 * (db - 112), tile = pp >> 8, c = pp & 255, bj = c >> 7, wc = (c & 127) >> 5; src = 3456 + tile * 256 + 64 * wc + 32 * bj; }
                    else src = 4224 + 32 * (db - 136);
                    transpose_item(w_in, IN_COLS, 64 * kb, src, Win_t, D_MODEL, 32 * db, scr, lane); continue; }
                r -= I_IN;
                if (r < I_BR) { const int bb = r / 256, q = r % 256, kb = q / 32, nb = q % 32;
                    transpose_item(w_br + (size_t)bb * 512 * D_MODEL, D_MODEL, 64 * kb, 32 * nb, Wbr_t + (size_t)bb * D_MODEL * 512, 512, 32 * nb, scr, lane); continue; }
                r -= I_BR;
                if (r < I_OUT) { transpose_item(w_out, D_MODEL, 64 * (r / 32), 32 * (r % 32), Wout_t, D_MODEL, 32 * (r % 32), scr, lane); continue; }
                r -= I_OUT;
                if (r < I_M1) { transpose_item(w_m1, D_FF, 64 * (r / 128), 32 * (r % 128), W1_t, D_MODEL, 32 * (r % 128), scr, lane); continue; }
                r -= I_M1;
                if (r < I_M2) { transpose_item(w_m2, D_MODEL, 64 * (r / 32), 32 * (r % 32), W2_t, D_FF, 32 * (r % 32), scr, lane); continue; }
                r -= I_M2;
                if (r < I_L) { const int dd = r / 16, nb = r % 16; transpose_item(rw_w2 + (size_t)dd * 64 * 512, 512, 0, 32 * nb, w2t + (size_t)dd * 512 * 64, 64, 32 * nb, scr, lane); continue; }
                r -= I_L;
                if (r < I_L) { const int dd = r / 16, nb = r % 16; transpose_item(rw_a2 + (size_t)dd * 64 * 512, 512, 0, 32 * nb, a2t + (size_t)dd * 512 * 64, 64, 32 * nb, scr, lane); continue; }
                r -= I_L;
                { const int kb = r / 16, nb = r % 16; transpose_item(rw_g2, 512, 64 * kb, 32 * nb, g2t, 256, 32 * nb, scr, lane); }
            }
            for (int i = gtid; i < 512 * 16; i += NGT) *(u32x4*)(g2t + (size_t)(i >> 4) * 256 + 128 + 8 * (i & 15)) = (u32x4){0u, 0u, 0u, 0u};
            if (l == 0) for (int i = gtid; i < T * 16; i += NGT) *(u32x4*)(SG + (size_t)(i >> 4) * 256 + 128 + 8 * (i & 15)) = (u32x4){0u, 0u, 0u, 0u};
            const float* g1 = p.in[1] + (size_t)l * D_MODEL;
            if (T % (2 * NGW) == 0) { for (int m = gw; m < T; m += 2 * NGW) rms_row2(xin + (size_t)m * D_MODEL, xin + (size_t)(m + NGW) * D_MODEL, g1, Hb + (size_t)m * D_MODEL, Hb + (size_t)(m + NGW) * D_MODEL, lane); }
            else { for (int m = gw; m < T; m += NGW) rms_row(xin + (size_t)m * D_MODEL, g1, Hb + (size_t)m * D_MODEL, lane); }
        }
        xcd_barrier(xbar);
        DBG_STOP(1);
        if (PHMASK & (1u << 1)) {
            pg8::StaticOrder S;
#ifndef SKIP_P2A
            { pg8::Gemm g{Hb, Win_t, T, 3584, D_MODEL, D_MODEL}; S.init(T, 3584, G, bx);
              pg8::EpiStore<0> E{RWC, LD_RWC, C2, LD_C2, 8}; pg8::gemm_phase(lds, g, S, E); }
#endif
#ifndef SKIP_P2B
            { pg8::Gemm g{Hb, Win_t + (size_t)3584 * D_MODEL, T, 768, D_MODEL, D_MODEL}; S.init(T, 768, G, bx);
              pg8::EpiAttn E{C2, VT, p.in[17] + l * 64, p.in[18] + l * 64}; pg8::gemm_phase(lds, g, S, E); }
#endif
        }
        xcd_barrier(xbar);
        DBG_STOP(2);
        if (PHMASK & (1u << 2)) {
            PHASE_IDS();
            const float* cvw = p.in[15] + (size_t)l * 3 * 512; const float* cvb = p.in[16] + (size_t)l * 512;
            ScanW sw{p.in[3] + (size_t)l * RW_COLS, p.in[4] + (size_t)l * RW_COLS, p.in[5] + (size_t)l * 1024, p.in[7] + (size_t)l * 1024,
                     p.in[10] + (size_t)l * 512, p.in[11] + (size_t)l * 512, p.in[12] + (size_t)l * 512, w2t, a2t};
#ifndef SKIP_SCAN
#ifdef MK_DUP_SCAN
            for (int u = vcu; u < 256; u += G) { scan_unit(lds, RWC, YF, YB, SG, SB, sw, u >> 4, (u >> 1) & 7, u & 1, C2, cvw, cvb, u); __syncthreads(); }
#endif
            for (int u = vcu; u < 256; u += G) { scan_unit(lds, RWC, YF, YB, SG, SB, sw, u >> 4, (u >> 1) & 7, u & 1, C2, cvw, cvb, u); __syncthreads(); }
#endif
#ifndef SKIP_ATTN
#ifdef MK_DUP_ATTN
            for (int u = vcu; u < 1024; u += G) { attn_unit(lds, C2, (bf16_t*)(ws + 892 * MiB), u >> 6, (u >> 5) & 1, u & 31); }
#endif
            for (int u = vcu; u < 1024; u += G) { attn_unit(lds, C2, nullptr, u >> 6, (u >> 5) & 1, u & 31); }
#endif
        }
        xcd_barrier(xbar);
        DBG_STOP(3);
        if (PHMASK & (1u << 3)) {
            PHASE_IDS();
            const float* mup = p.in[3] + (size_t)l * RW_COLS + 1024; const float* mun = p.in[4] + (size_t)l * RW_COLS + 1024;
            const float* lng = p.in[13] + (size_t)l * 512; const float* lnb = p.in[14] + (size_t)l * 512;
            for (int m = gw; m < T; m += NGW) {
                const int t = m & 4095, c0 = 8 * lane, hh = lane >> 3;
                float yf[8], yb[8], vc[8], vpv[8], vn[8], y[8];
                unpack8(*(const u32x4*)(YF + (size_t)m * 512 + c0), yf); unpack8(*(const u32x4*)(YB + (size_t)m * 512 + c0), yb);
                const bf16_t* rp = RWC + (size_t)m * LD_RWC + 1024 + c0;
                unpack8(*(const u32x4*)rp, vc);
                if (t > 0) unpack8(*(const u32x4*)(rp - LD_RWC), vpv); else {
#pragma unroll
                    for (int j = 0; j < 8; ++j) vpv[j] = 0.f; }
                if (t < SEQ - 1) unpack8(*(const u32x4*)(rp + LD_RWC), vn); else {
#pragma unroll
                    for (int j = 0; j < 8; ++j) vn[j] = 0.f; }
                float s = 0.f;
#pragma unroll
                for (int j = 0; j < 8; ++j) { y[j] = yf[j] + yb[j]; s += y[j]; }
                const float mean = red8(s) * (1.f / 64.f);
                float q = 0.f;
#pragma unroll
                for (int j = 0; j < 8; ++j) { y[j] -= mean; q += y[j] * y[j]; }
                const float rstd = __builtin_amdgcn_rsqf(red8(q) * (1.f / 64.f) + 64e-5f);
                const float bs = 0.5f * (SB[(size_t)m * 8 + hh] + SB[((size_t)T + m) * 8 + hh]);
                float o[8];
#pragma unroll
                for (int j = 0; j < 8; ++j) { const float zv = vc[j] + mup[c0 + j] * (vpv[j] - vc[j]) + mun[c0 + j] * (vn[j] - vc[j]);
                    o[j] = y[j] * rstd * lng[c0 + j] + lnb[c0 + j] + bs * zv; }
                *(u32x4*)(YF + (size_t)m * 512 + c0) = pack8(o);
            }
        }
        xcd_barrier(xbar);
        DBG_STOP(4);
        if (PHMASK & (1u << 4)) {
            pg8::StaticOrder S; pg8::Gemm g{SG, g2t, T, 512, 256, 256}; S.init(T, 512, G, bx);
            pg8::EpiMulInPlace E{YF, 512}; pg8::gemm_phase(lds, g, S, E);
        }
        xcd_barrier(xbar);
        DBG_STOP(5);
        if (PHMASK & (1u << 5)) {
            pg8::StaticOrder S; S.init(T, 1024, G, bx);
            const bf16_t* Wg = Win_t + (size_t)4352 * D_MODEL;
            if (P4_CALLS >= 1)
            { pg8::Gemm g{Hb, Wg, T, 1024, D_MODEL, D_MODEL}; pg8::EpiStore<MK_GATE_ACT> E{Gt, D_MODEL, Gt, D_MODEL, 1 << 20}; pg8::gemm_phase(lds, g, S, E); }
            L1_REFRESH();
            if (P4_CALLS >= 2)
            { pg8::Gemm g{YF, Wbr_t, T, 1024, 512, 512}; pg8::EpiBranch<true> E{Gt, Mg}; pg8::gemm_phase(lds, g, S, E); }
            if (P4_CALLS >= 3)
            { pg8::Gemm g{Hb, Wg + (size_t)1024 * D_MODEL, T, 1024, D_MODEL, D_MODEL}; pg8::EpiStore<1> E{Gt, D_MODEL, Gt, D_MODEL, 1 << 20}; pg8::gemm_phase(lds, g, S, E); }
            L1_REFRESH();
            if (P4_CALLS >= 4)
            { pg8::Gemm g{C2, Wbr_t + (size_t)1024 * 512, T, 1024, 512, LD_C2}; pg8::EpiBranch<false> E{Gt, Mg}; pg8::gemm_phase(lds, g, S, E); }
            if (P4_CALLS >= 5)
            { pg8::Gemm g{Hb, Wg + (size_t)2048 * D_MODEL, T, 1024, D_MODEL, D_MODEL}; pg8::EpiStore<1> E{Gt, D_MODEL, Gt, D_MODEL, 1 << 20}; pg8::gemm_phase(lds, g, S, E); }
            L1_REFRESH();
            if (P4_CALLS >= 6)
            { pg8::Gemm g{C2 + 1536, Wbr_t + (size_t)2048 * 512, T, 1024, 512, LD_C2}; pg8::EpiBranch<false> E{Gt, Mg}; pg8::gemm_phase(lds, g, S, E); }
        }
        xcd_barrier(xbar);
        DBG_STOP(6);
        if (PHMASK & (1u << 6)) {
            pg8::StaticOrder S; S.init(T, 1024, G, bx);
            pg8::Gemm g{Mg, Wout_t, T, 1024, D_MODEL, D_MODEL}; pg8::EpiResidual E{xin, X}; pg8::gemm_phase(lds, g, S, E);
        }
        xcd_barrier(xbar);
        DBG_STOP(7);
        if (PHMASK & (1u << 7)) {
            PHASE_IDS();
            const float* g2 = p.in[21] + (size_t)l * D_MODEL;
            if (T % (2 * NGW) == 0) { for (int m = gw; m < T; m += 2 * NGW) rms_row2(X + (size_t)m * D_MODEL, X + (size_t)(m + NGW) * D_MODEL, g2, Hb + (size_t)m * D_MODEL, Hb + (size_t)(m + NGW) * D_MODEL, lane); }
            else { for (int m = gw; m < T; m += NGW) rms_row(X + (size_t)m * D_MODEL, g2, Hb + (size_t)m * D_MODEL, lane); }
        }
        xcd_barrier(xbar);
        DBG_STOP(8);
        if (PHMASK & (1u << 8)) {
            pg8::StaticOrder S; S.init(T, D_FF, G, bx);
            pg8::Gemm g{Hb, W1_t, T, D_FF, D_MODEL, D_MODEL}; pg8::EpiStore<2> E{Ub, D_FF, Ub, D_FF, 1 << 20}; pg8::gemm_phase(lds, g, S, E);
#ifdef MK_DUP_P7
            pg8::gemm_phase(lds, g, S, E);
#endif
        }
        xcd_barrier(xbar);
        DBG_STOP(9);
        if (PHMASK & (1u << 9)) {
            pg8::StaticOrder S; S.init(T, 1024, G, bx);
            pg8::Gemm g{Ub, W2_t, T, 1024, D_FF, D_FF}; pg8::EpiResidual E{X, X}; pg8::gemm_phase(lds, g, S, E);
        }
        xcd_barrier(xbar);
        DBG_STOP(10);
    }
}

extern "C" void kernel_launch(void* const* d_in, const int* in_sizes, int n_in, void* d_out, int out_size, void* d_ws, size_t ws_size, hipStream_t stream) {
    static int grid = 0;
    if (grid == 0) {
        if (n_in != 24 || out_size != T * D_MODEL || ws_size < WS_END) { fprintf(stderr, "kernel_launch: unexpected shapes (n_in %d out %d ws %zu)\n", n_in, out_size, ws_size); grid = -1; return; }
        int dev = 0, cus = 0, per_cu = 0;
        hipGetDevice(&dev);
        hipDeviceGetAttribute(&cus, hipDeviceAttributeMultiprocessorCount, dev);
        hipFuncSetAttribute((const void*)fwd_megakernel, hipFuncAttributeMaxDynamicSharedMemorySize, LDS_BYTES);
        hipOccupancyMaxActiveBlocksPerMultiprocessor(&per_cu, (const void*)fwd_megakernel, 512, LDS_BYTES);
        if (per_cu < 1) { fprintf(stderr, "kernel_launch: occupancy query says %d blocks per CU\n", per_cu); per_cu = 1; }
        (void)hipGetLastError();
        grid = cus;
    }
    if (grid < 0) return;
    if (hipMemsetAsync(d_ws, 0, 1u << 20, stream) != hipSuccess) { fprintf(stderr, "kernel_launch: memset failed\n"); return; }
    Params p{};
    for (int i = 0; i < 24; ++i) p.in[i] = (const float*)d_in[i];
    p.out = (float*)d_out; p.ws = (unsigned char*)d_ws;
    void* args[] = {&p};
    hipError_t e = hipLaunchCooperativeKernel((const void*)fwd_megakernel, dim3(grid), dim3(512), args, LDS_BYTES, stream);
    if (e != hipSuccess) fprintf(stderr, "cooperative launch failed: %s (grid %d)\n", hipGetErrorString(e), grid);
}
```

```cpp
#include <hip/hip_runtime.h>
#include <hip/hip_cooperative_groups.h>
#include <cstdio>
#include <cstdint>
namespace cg = cooperative_groups;

#define LAS __attribute__((address_space(3)))
#define GAS __attribute__((address_space(1)))
typedef unsigned short bf16_t;
typedef short bf16x8 __attribute__((ext_vector_type(8)));
typedef short bf16x4 __attribute__((ext_vector_type(4)));
typedef float f32x2 __attribute__((ext_vector_type(2)));
typedef float f32x4 __attribute__((ext_vector_type(4)));
typedef float f32x16 __attribute__((ext_vector_type(16)));
typedef unsigned u32x2 __attribute__((ext_vector_type(2)));
typedef unsigned u32x4 __attribute__((ext_vector_type(4)));

constexpr int D_MODEL = 1024, BATCH = 16, SEQ = 4096, DEPTH = 4, D_FF = 4096;
constexpr int T = BATCH * SEQ;
constexpr int IN_COLS = 7296, RW_COLS = 1920;
constexpr int NWIN = 7424;
constexpr int LD_RWC = 2048, LD_C2 = 2304;
constexpr float LOG2E = 1.4426950408889634f;

constexpr size_t MiB = 1u << 20;
constexpr size_t WS_WIN = 2 * MiB, WS_WBR = 17 * MiB, WS_WOUT = 20 * MiB, WS_W1 = 22 * MiB, WS_W2 = 30 * MiB;
constexpr size_t WS_W2T = 38 * MiB, WS_A2T = 38 * MiB + 131072, WS_G2T = 38 * MiB + 262144;
constexpr size_t WS_H = 40 * MiB, WS_RWC = 168 * MiB, WS_C2 = 424 * MiB, WS_YF = 712 * MiB, WS_YB = 776 * MiB;
constexpr size_t WS_SG = 840 * MiB, WS_VT = 872 * MiB, WS_SB = 888 * MiB, WS_END = 892 * MiB;
#ifdef MK_GT_FRESH
constexpr size_t WS_GT = 892 * MiB;
#else
constexpr size_t WS_GT = WS_RWC;
#endif
constexpr size_t WS_MRG = WS_RWC + 128 * MiB, WS_U = WS_RWC;

#ifndef MK_GATE_ACT
#define MK_GATE_ACT 1
#endif
#ifndef MK_P4_CALLS
#define MK_P4_CALLS 6
#endif
constexpr int P4_CALLS = MK_P4_CALLS;
#ifndef MK_PHMASK
#define MK_PHMASK 0xffffffffu
#endif
constexpr unsigned PHMASK = MK_PHMASK;
constexpr int LDS_BYTES = 140288;

typedef __bf16 bf16x2_t __attribute__((ext_vector_type(2)));
__device__ __forceinline__ unsigned cvt_pk_bf16(float lo, float hi) { const f32x2 v = {lo, hi}; const bf16x2_t b = __builtin_convertvector(v, bf16x2_t); return __builtin_bit_cast(unsigned, b); }
__device__ __forceinline__ bf16_t f2bf(float f) { return (bf16_t)(cvt_pk_bf16(f, 0.f) & 0xffffu); }
__device__ __forceinline__ float bflo(unsigned u) { return __builtin_bit_cast(float, u << 16); }
__device__ __forceinline__ float bfhi(unsigned u) { return __builtin_bit_cast(float, u & 0xffff0000u); }
__device__ __forceinline__ void unpack8(const u32x4 v, float* f) { f[0] = bflo(v.x); f[1] = bfhi(v.x); f[2] = bflo(v.y); f[3] = bfhi(v.y); f[4] = bflo(v.z); f[5] = bfhi(v.z); f[6] = bflo(v.w); f[7] = bfhi(v.w); }
__device__ __forceinline__ u32x4 pack8(const float* f) { u32x4 w; w.x = cvt_pk_bf16(f[0], f[1]); w.y = cvt_pk_bf16(f[2], f[3]); w.z = cvt_pk_bf16(f[4], f[5]); w.w = cvt_pk_bf16(f[6], f[7]); return w; }
__device__ __forceinline__ float trans_settle(float x) { float r; asm volatile("s_nop 1\n\tv_mov_b32 %0, %1" : "=v"(r) : "v"(x)); return r; }
__device__ __forceinline__ float sigmoid_f(float x) { return __builtin_amdgcn_rcpf(1.f + __builtin_amdgcn_exp2f(-LOG2E * x)); }
__device__ __forceinline__ float tanh_f(float x) { return 1.f - 2.f * __builtin_amdgcn_rcpf(1.f + __builtin_amdgcn_exp2f(2.f * LOG2E * x)); }
__device__ __forceinline__ float wave_sum(float v) {
#pragma unroll
    for (int o = 1; o < 64; o <<= 1) v += __shfl_xor(v, o);
    return v;
}
template <int CTRL> __device__ __forceinline__ float dpp_f(float x) { return __builtin_bit_cast(float, __builtin_amdgcn_update_dpp(0, __builtin_bit_cast(int, x), CTRL, 0xf, 0xf, true)); }
__device__ __forceinline__ float red8(float x) { x += dpp_f<0xB1>(x); x += dpp_f<0x4E>(x); x += dpp_f<0x141>(x); return x; }
__device__ __forceinline__ float red8_nopack(float x) { x += dpp_f<0xB1>(x); asm volatile("" : "+v"(x)); x += dpp_f<0x4E>(x); asm volatile("" : "+v"(x)); x += dpp_f<0x141>(x); asm volatile("" : "+v"(x)); return x; }
__device__ __forceinline__ float red16(float x) { x = red8(x); x += dpp_f<0x140>(x); return x; }

namespace pg8 {
constexpr int BM = 256, BK = 64, HALF = 128, HTB = HALF * BK * 2, STAGE_BYTES = 8 * HTB, NXCD = 8, WGM = 8;
__host__ __device__ __forceinline__ int lds_byte(int r, int c) { const int st = (r >> 4) * 2 + (c >> 5), rr = r & 15, cc = c & 31, ob = rr * 64 + cc * 2; return st * 1024 + (ob ^ (((ob >> 9) & 1) << 5)); }
__host__ __device__ __forceinline__ void stage_rc(int b, int& R, int& C) { const int st = b / 1024, sb = b % 1024, swz = sb ^ (((sb >> 9) & 1) << 5); R = (st >> 1) * 16 + swz / 64; C = (st & 1) * 32 + (swz % 64) / 2; }
__host__ __device__ __forceinline__ int perm32(int rho) { const int n = rho >> 4, i = rho & 15; return 8 * (i >> 2) + 4 * n + (i & 3); }

struct Unit { int pm, pn; };
struct Gemm { const bf16_t* A; const bf16_t* Bt; int M, N, K, lda; };

struct StaticOrder {
    int nM, nN, nwg, G, c;
    __device__ void init(int M, int N, int G_, int c_) { nM = M / BM; nN = N / BM; nwg = nM * nN; G = G_; c = c_; }
    __device__ bool next(int i, Unit& u) const {
        const long L = (long)i * G + c; if (L >= nwg) return false;
        int wgid = (int)L; { const int q = nwg / NXCD, r = nwg % NXCD, xcd = wgid % NXCD, off = wgid / NXCD; wgid = (xcd < r ? xcd * (q + 1) : r * (q + 1) + (xcd - r) * q) + off; }
        const int nig = WGM * nN, gid = wgid / nig, fm = gid * WGM, gsz = (nM - fm) < WGM ? (nM - fm) : WGM;
        u.pm = fm + ((wgid % nig) % gsz); u.pn = (wgid % nig) / gsz; return true;
    }
};

template <class Epi>
__device__ __forceinline__ void gemm_phase(LAS unsigned char* lds, const Gemm g, const StaticOrder& S, const Epi& E) {
    int tid = threadIdx.x; asm volatile("" : "+v"(tid));
    const int wid = __builtin_amdgcn_readfirstlane(tid >> 6), lane = tid & 63, wr = wid >> 2, wc = wid & 3, fr = lane & 15, fq = lane >> 4;
    const int K = g.K, nt = K / BK, lda = g.lda;
    unsigned voffA[2], voffB[2];
#pragma unroll
    for (int i = 0; i < 2; ++i) { int R, C; stage_rc(tid * 16 + i * 8192, R, C); const int Rb = Epi::PERM ? ((R & ~31) + perm32(R & 31)) : R;
        voffA[i] = (unsigned)(R * lda + C) * 2u; voffB[i] = (unsigned)(Rb * K + C) * 2u; }
    const size_t kstep = (size_t)(BK * 2);
    const size_t hstepA = (size_t)HALF * lda * 2, hstepB = (size_t)HALF * K * 2;
    const size_t tstepA = 2 * hstepA, tstepB = 2 * hstepB;
    const unsigned ldsw = (unsigned)wid * 1024u;
    const int aoff = lds_byte(wr * 64 + fr, fq * 8), boff = lds_byte(wc * 32 + fr, fq * 8);
#define PG8_SA(b, h) (((b) * 2 + (h)) * HTB)
#define PG8_SB(b, h) ((4 + (b) * 2 + (h)) * HTB)
#define PG8_STAGE(bufoff, gbase, voff) do { _Pragma("unroll") for (int _i = 0; _i < 2; ++_i) \
        __builtin_amdgcn_global_load_lds((const unsigned*)((const char*)(gbase) + (voff)[_i]), (LAS unsigned*)(lds + (bufoff) + ldsw + _i * 8192), 16, 0, 0); } while (0)
#define PG8_LDA(dst, b, h) do { _Pragma("unroll") for (int m = 0; m < 4; ++m) _Pragma("unroll") for (int k = 0; k < 2; ++k) dst[m][k] = *(const LAS bf16x8*)(lds + PG8_SA(b, h) + aoff + m * 2048 + k * 1024); } while (0)
#define PG8_LDB(dst, b, h) do { _Pragma("unroll") for (int n = 0; n < 2; ++n) _Pragma("unroll") for (int k = 0; k < 2; ++k) dst[n][k] = *(const LAS bf16x8*)(lds + PG8_SB(b, h) + boff + n * 2048 + k * 1024); } while (0)
#define PG8_MMA(ai, bj, At, Bt) do { __builtin_amdgcn_s_setprio(1); _Pragma("unroll") for (int m = 0; m < 4; ++m) _Pragma("unroll") for (int n = 0; n < 2; ++n) _Pragma("unroll") for (int k = 0; k < 2; ++k) \
        acc[ai][bj][m][n] = __builtin_amdgcn_mfma_f32_16x16x32_bf16(Bt[n][k], At[m][k], acc[ai][bj][m][n], 0, 0, 0); __builtin_amdgcn_s_setprio(0); } while (0)
#define PG8_WAIT_V(n) asm volatile("s_waitcnt vmcnt(" #n ")" ::: "memory")
#define PG8_WAIT_L(n) asm volatile("s_waitcnt lgkmcnt(" #n ")" ::: "memory")
#define PG8_BAR __builtin_amdgcn_s_barrier()
#define PG8_SCHED __builtin_amdgcn_sched_barrier(0)
    Unit cur, nxt; int ui = 0;
    if (!S.next(0, cur)) return;
    f32x4 acc[2][2][4][2];
#pragma unroll
    for (int a = 0; a < 2; ++a)
#pragma unroll
        for (int b = 0; b < 2; ++b)
#pragma unroll
            for (int m = 0; m < 4; ++m)
#pragma unroll
                for (int n = 0; n < 2; ++n) acc[a][b][m][n] = (f32x4){0.f, 0.f, 0.f, 0.f};
    bf16x8 At[4][2], B0[2][2], B1[2][2];
    const char* cA = (const char*)g.A + (size_t)cur.pm * tstepA; const char* cB = (const char*)g.Bt + (size_t)cur.pn * tstepB;
    PG8_STAGE(PG8_SB(0, 0), cB, voffB); PG8_STAGE(PG8_SB(0, 1), cB + hstepB, voffB); PG8_STAGE(PG8_SA(0, 0), cA, voffA); PG8_STAGE(PG8_SA(0, 1), cA + hstepA, voffA);
    if (wr == 1) PG8_BAR;
    PG8_WAIT_V(2); PG8_BAR;
    PG8_STAGE(PG8_SB(1, 0), cB + kstep, voffB); PG8_STAGE(PG8_SA(1, 0), cA + kstep, voffA); PG8_STAGE(PG8_SB(1, 1), cB + hstepB + kstep, voffB);
    PG8_WAIT_V(6); PG8_BAR;
    for (;;) {
        const bool has_next = S.next(ui + 1, nxt);
        const char* nA = has_next ? (const char*)g.A + (size_t)nxt.pm * tstepA : cA; const char* nB = has_next ? (const char*)g.Bt + (size_t)nxt.pn * tstepB : cB;
#pragma nounroll
        for (int t = 0; t < nt; t += 2) {
            const bool last = (t == nt - 2);
            const char* a1 = cA + (size_t)(t + 1) * kstep;
            const char* a2 = last ? nA : cA + (size_t)(t + 2) * kstep; const char* b2 = last ? nB : cB + (size_t)(t + 2) * kstep;
            const char* a3 = a2 + kstep; const char* b3 = b2 + kstep;
            PG8_LDB(B0, 0, 0); PG8_LDB(B1, 0, 1); PG8_SCHED; PG8_LDA(At, 0, 0); PG8_STAGE(PG8_SA(1, 1), a1 + hstepA, voffA);
            PG8_WAIT_V(8); PG8_WAIT_L(0); PG8_BAR; PG8_MMA(0, 0, At, B0); PG8_MMA(0, 1, At, B1); PG8_BAR; PG8_SCHED;
            PG8_LDA(At, 0, 1); PG8_STAGE(PG8_SB(0, 0), b2, voffB); PG8_STAGE(PG8_SB(0, 1), b2 + hstepB, voffB); PG8_STAGE(PG8_SA(0, 0), a2, voffA);
            PG8_WAIT_V(8); PG8_WAIT_L(0); PG8_BAR; PG8_MMA(1, 0, At, B0); PG8_MMA(1, 1, At, B1); PG8_BAR; PG8_SCHED;
            PG8_LDB(B0, 1, 0); PG8_LDB(B1, 1, 1); PG8_SCHED; PG8_LDA(At, 1, 0); PG8_STAGE(PG8_SA(0, 1), a2 + hstepA, voffA);
            PG8_WAIT_V(8); PG8_WAIT_L(0); PG8_BAR; PG8_MMA(0, 0, At, B0); PG8_MMA(0, 1, At, B1); PG8_BAR; PG8_SCHED;
            PG8_LDA(At, 1, 1); PG8_STAGE(PG8_SB(1, 0), b3, voffB); PG8_STAGE(PG8_SB(1, 1), b3 + hstepB, voffB); PG8_STAGE(PG8_SA(1, 0), a3, voffA);
            PG8_WAIT_V(8); PG8_WAIT_L(0); PG8_BAR; PG8_MMA(1, 0, At, B0); PG8_MMA(1, 1, At, B1); PG8_BAR; PG8_SCHED;
        }
        if (wr == 0) PG8_BAR;
        E(acc, cur, wr, wc, fr, fq);
        if (!has_next) break;
#pragma unroll
        for (int a = 0; a < 2; ++a)
#pragma unroll
            for (int b = 0; b < 2; ++b)
#pragma unroll
                for (int m = 0; m < 4; ++m)
#pragma unroll
                    for (int n = 0; n < 2; ++n) acc[a][b][m][n] = (f32x4){0.f, 0.f, 0.f, 0.f};
        cur = nxt; cA = nA; cB = nB; ++ui;
        if (wr == 1) PG8_BAR;
    }
    PG8_WAIT_V(0);
    PG8_BAR;
#undef PG8_SA
#undef PG8_SB
#undef PG8_STAGE
#undef PG8_LDA
#undef PG8_LDB
#undef PG8_MMA
#undef PG8_WAIT_V
#undef PG8_WAIT_L
#undef PG8_BAR
#undef PG8_SCHED
}

#define EPI_FENCE() do { asm volatile("" ::: "memory"); __builtin_amdgcn_sched_barrier(0); } while (0)
template <int ACT> struct EpiStore {
    static constexpr bool PERM = true;
    bf16_t* O0; int ld0; bf16_t* O1; int ld1; int pn_split;
    __device__ __forceinline__ void operator()(const f32x4 (&acc)[2][2][4][2], const Unit& u, int wr, int wc, int fr, int fq) const {
        bf16_t* base; int ld, colt;
        if (u.pn < pn_split) { base = O0; ld = ld0; colt = u.pn * BM; } else { base = O1; ld = ld1; colt = (u.pn - pn_split) * BM; }
        const int row0 = u.pm * BM + wr * 64 + fr, col0 = colt + wc * 32 + 8 * fq;
#pragma unroll
        for (int ai = 0; ai < 2; ++ai)
#pragma unroll
            for (int m = 0; m < 4; ++m) { bf16_t* rowp = base + (size_t)(row0 + ai * HALF + m * 16) * ld + col0;
#pragma unroll
                for (int bj = 0; bj < 2; ++bj) { float v[8];
#pragma unroll
                    for (int j = 0; j < 4; ++j) { v[j] = acc[ai][bj][m][0][j]; v[4 + j] = acc[ai][bj][m][1][j]; }
#pragma unroll
                    for (int j = 0; j < 8; ++j) { if (ACT == 1) v[j] = sigmoid_f(v[j]); if (ACT == 2) { const float r = fmaxf(v[j], 0.f); v[j] = r * r; } }
                    *(u32x4*)(rowp + bj * HALF) = pack8(v); }
                EPI_FENCE(); }
    }
};
struct EpiResidual {
    static constexpr bool PERM = false;
    const float* xin; float* xout;
    __device__ __forceinline__ void operator()(const f32x4 (&acc)[2][2][4][2], const Unit& u, int wr, int wc, int fr, int fq) const {
        const int row0 = u.pm * BM + wr * 64 + fr, col0 = u.pn * BM + wc * 32 + 4 * fq;
#pragma unroll
        for (int ai = 0; ai < 2; ++ai)
#pragma unroll
            for (int m = 0; m < 4; ++m) { const size_t off = (size_t)(row0 + ai * HALF + m * 16) * D_MODEL + col0;
#pragma unroll
                for (int bj = 0; bj < 2; ++bj)
#pragma unroll
                    for (int n = 0; n < 2; ++n) { const f32x4 b = *(const f32x4*)(xin + off + bj * HALF + n * 16); *(f32x4*)(xout + off + bj * HALF + n * 16) = b + acc[ai][bj][m][n]; } }
    }
};
struct EpiMulInPlace {
    static constexpr bool PERM = true;
    bf16_t* Y; int ld;
    __device__ __forceinline__ void operator()(const f32x4 (&acc)[2][2][4][2], const Unit& u, int wr, int wc, int fr, int fq) const {
        const int row0 = u.pm * BM + wr * 64 + fr, col0 = u.pn * BM + wc * 32 + 8 * fq;
#pragma unroll
        for (int ai = 0; ai < 2; ++ai)
#pragma unroll
            for (int m = 0; m < 4; ++m) { bf16_t* rowp = Y + (size_t)(row0 + ai * HALF + m * 16) * ld + col0;
#pragma unroll
                for (int bj = 0; bj < 2; ++bj) { float y[8]; unpack8(*(const u32x4*)(rowp + bj * HALF), y);
#pragma unroll
                    for (int j = 0; j < 4; ++j) { y[j] *= acc[ai][bj][m][0][j]; y[4 + j] *= acc[ai][bj][m][1][j]; }
                    *(u32x4*)(rowp + bj * HALF) = pack8(y); }
                EPI_FENCE(); }
    }
};
template <bool FIRST> struct EpiBranch {
    static constexpr bool PERM = true;
    const bf16_t* Gt; bf16_t* Mg;
    __device__ __forceinline__ void operator()(const f32x4 (&acc)[2][2][4][2], const Unit& u, int wr, int wc, int fr, int fq) const {
        const int row0 = u.pm * BM + wr * 64 + fr, col0 = u.pn * BM + wc * 32 + 8 * fq;
#pragma unroll
        for (int ai = 0; ai < 2; ++ai) {
            u32x4 gq[4][2], mq[4][2];
#pragma unroll
            for (int m = 0; m < 4; ++m) { const size_t off = (size_t)(row0 + ai * HALF + m * 16) * D_MODEL + col0;
#pragma unroll
                for (int bj = 0; bj < 2; ++bj) { gq[m][bj] = *(const u32x4*)(Gt + off + bj * HALF); if (!FIRST) mq[m][bj] = *(const u32x4*)(Mg + off + bj * HALF); } }
#pragma unroll
            for (int m = 0; m < 4; ++m) { const size_t off = (size_t)(row0 + ai * HALF + m * 16) * D_MODEL + col0;
#pragma unroll
                for (int bj = 0; bj < 2; ++bj) { float gt[8], o[8]; unpack8(gq[m][bj], gt);
                    if (FIRST) {
#pragma unroll
                        for (int j = 0; j < 8; ++j) o[j] = 0.f;
                    } else unpack8(mq[m][bj], o);
#pragma unroll
                    for (int j = 0; j < 4; ++j) { o[j] += gt[j] * acc[ai][bj][m][0][j]; o[4 + j] += gt[4 + j] * acc[ai][bj][m][1][j]; }
                    *(u32x4*)(Mg + off + bj * HALF) = pack8(o); } }
            EPI_FENCE(); }
    }
};
struct EpiAttn {
    static constexpr bool PERM = false;
    bf16_t* C2; bf16_t* VT; const float* qg; const float* kg;
    __device__ __forceinline__ void operator()(const f32x4 (&acc)[2][2][4][2], const Unit& u, int wr, int wc, int fr, int fq) const {
        if (u.pn == 2 && wc >= 2) {
#pragma unroll
            for (int ai = 0; ai < 2; ++ai)
#pragma unroll
                for (int m = 0; m < 4; ++m) { const int row = u.pm * BM + ai * HALF + wr * 64 + m * 16 + fr;
                    bf16_t* rowp = C2 + (size_t)row * LD_C2 + 2048 + wc * 64 + 4 * fq;
#pragma unroll
                    for (int bj = 0; bj < 2; ++bj)
#pragma unroll
                        for (int n = 0; n < 2; ++n) { const f32x4 x = acc[ai][bj][m][n]; u32x2 w; w.x = cvt_pk_bf16(x[0], x[1]); w.y = cvt_pk_bf16(x[2], x[3]); *(u32x2*)(rowp + 32 * bj + 16 * n) = w; }
                    EPI_FENCE(); }
        } else {
            const bool isK = (u.pn == 2);
            int opq = 0; asm volatile("" : "+v"(opq));
            fq += opq; fr += opq;
            const float* gp = isK ? kg : qg;
            const int colbase = isK ? (2048 + wc * 64) : (1536 + (u.pn * 4 + wc) * 64);
            const float sc = isK ? 1.f : 0.125f * LOG2E;
            float gv[2][2][4], invf[4];
#pragma unroll
            for (int bj = 0; bj < 2; ++bj)
#pragma unroll
                for (int n = 0; n < 2; ++n)
#pragma unroll
                    for (int j = 0; j < 4; ++j) gv[bj][n][j] = gp[32 * bj + 16 * n + 4 * fq + j] * sc;
#pragma unroll
            for (int j = 0; j < 4; ++j) invf[j] = __builtin_amdgcn_exp2f(-(float)(4 * fq + j) * (13.287712379549449f / 16.f));
#pragma unroll
            for (int ai = 0; ai < 2; ++ai)
#pragma unroll
                for (int m = 0; m < 4; ++m) { const int row = u.pm * BM + ai * HALF + wr * 64 + m * 16 + fr; const int t = row & 4095;
                    float ss = 0.f;
#pragma unroll
                    for (int bj = 0; bj < 2; ++bj)
#pragma unroll
                        for (int n = 0; n < 2; ++n) { const f32x4 x = acc[ai][bj][m][n]; ss += (x[0] * x[0] + x[1] * x[1]) + (x[2] * x[2] + x[3] * x[3]); }
                    ss += __shfl_xor(ss, 16); ss += __shfl_xor(ss, 32);
                    const float rinv = __builtin_amdgcn_rsqf(ss * (1.f / 64.f) + 1e-6f);
                    bf16_t* rowp = C2 + (size_t)row * LD_C2 + colbase + 4 * fq;
#pragma unroll
                    for (int bj = 0; bj < 2; ++bj) { const float pos = (float)(bj ? (t & 63) : (t >> 6)); float o1[4], o2[4];
#pragma unroll
                        for (int j = 0; j < 4; ++j) { const float ang = pos * invf[j], c = __cosf(ang), s = __sinf(ang);
                            const float x1 = acc[ai][bj][m][0][j] * rinv * gv[bj][0][j], x2 = acc[ai][bj][m][1][j] * rinv * gv[bj][1][j];
                            o1[j] = x1 * c - x2 * s; o2[j] = x2 * c + x1 * s; }
                        u32x2 w1, w2; w1.x = cvt_pk_bf16(o1[0], o1[1]); w1.y = cvt_pk_bf16(o1[2], o1[3]); w2.x = cvt_pk_bf16(o2[0], o2[1]); w2.y = cvt_pk_bf16(o2[2], o2[3]);
                        *(u32x2*)(rowp + 32 * bj) = w1; *(u32x2*)(rowp + 32 * bj + 16) = w2; }
                    EPI_FENCE(); }
        }
    }
};
}

struct Params { const float* in[24]; float* out; unsigned char* ws; };

__device__ __forceinline__ void transpose_item(const float* W, int ldw, int k0, int n_src, bf16_t* WT, int ldt, int dst_row0, LAS float* scr, int lane) {
#pragma unroll 8
    for (int i = 0; i < 32; ++i) { const int kk = 2 * i + (lane >> 5); scr[kk * 33 + (lane & 31)] = W[(size_t)(k0 + kk) * ldw + n_src + (lane & 31)]; }
    asm volatile("s_waitcnt lgkmcnt(0)" ::: "memory");
    const int c = lane & 7;
#pragma unroll
    for (int j = 0; j < 4; ++j) { const int n = (lane >> 3) + 8 * j; const LAS float* s = scr + (8 * c) * 33 + n;
        u32x4 o; o.x = cvt_pk_bf16(s[0 * 33], s[1 * 33]); o.y = cvt_pk_bf16(s[2 * 33], s[3 * 33]); o.z = cvt_pk_bf16(s[4 * 33], s[5 * 33]); o.w = cvt_pk_bf16(s[6 * 33], s[7 * 33]);
        *(u32x4*)(WT + (size_t)(dst_row0 + n) * ldt + k0 + 8 * c) = o; }
    asm volatile("s_waitcnt lgkmcnt(0)" ::: "memory");
}
__device__ __forceinline__ void rms_row2(const float* xrow0, const float* xrow1, const float* g, bf16_t* orow0, bf16_t* orow1, int lane) {
    const f32x4* xr0 = (const f32x4*)xrow0 + lane; const f32x4* xr1 = (const f32x4*)xrow1 + lane; const f32x4* gr = (const f32x4*)g + lane;
    f32x4 v0[4], v1[4]; float s0 = 0.f, s1 = 0.f;
#pragma unroll
    for (int j = 0; j < 4; ++j) { v0[j] = xr0[64 * j]; v1[j] = xr1[64 * j]; }
#pragma unroll
    for (int j = 0; j < 4; ++j) { s0 += (v0[j].x * v0[j].x + v0[j].y * v0[j].y) + (v0[j].z * v0[j].z + v0[j].w * v0[j].w); s1 += (v1[j].x * v1[j].x + v1[j].y * v1[j].y) + (v1[j].z * v1[j].z + v1[j].w * v1[j].w); }
    const float inv0 = __builtin_amdgcn_rsqf(wave_sum(s0) * (1.f / D_MODEL) + 1e-6f), inv1 = __builtin_amdgcn_rsqf(wave_sum(s1) * (1.f / D_MODEL) + 1e-6f);
    u32x2* o0 = (u32x2*)orow0 + lane; u32x2* o1 = (u32x2*)orow1 + lane;
#pragma unroll
    for (int j = 0; j < 4; ++j) { const f32x4 gg = gr[64 * j]; u32x2 w;
        w.x = cvt_pk_bf16(v0[j].x * inv0 * gg.x, v0[j].y * inv0 * gg.y); w.y = cvt_pk_bf16(v0[j].z * inv0 * gg.z, v0[j].w * inv0 * gg.w); o0[64 * j] = w;
        w.x = cvt_pk_bf16(v1[j].x * inv1 * gg.x, v1[j].y * inv1 * gg.y); w.y = cvt_pk_bf16(v1[j].z * inv1 * gg.z, v1[j].w * inv1 * gg.w); o1[64 * j] = w; }
}
__device__ __forceinline__ void rms_row(const float* xrow, const float* g, bf16_t* orow, int lane) {
    const f32x4* xr = (const f32x4*)xrow + lane; const f32x4* gr = (const f32x4*)g + lane;
    f32x4 v[4]; float s = 0.f;
#pragma unroll
    for (int j = 0; j < 4; ++j) { v[j] = xr[64 * j]; s += (v[j].x * v[j].x + v[j].y * v[j].y) + (v[j].z * v[j].z + v[j].w * v[j].w); }
    const float inv = __builtin_amdgcn_rsqf(wave_sum(s) * (1.f / D_MODEL) + 1e-6f);
    u32x2* o8 = (u32x2*)orow + lane;
#pragma unroll
    for (int j = 0; j < 4; ++j) { const f32x4 gg = gr[64 * j]; u32x2 w; w.x = cvt_pk_bf16(v[j].x * inv * gg.x, v[j].y * inv * gg.y); w.y = cvt_pk_bf16(v[j].z * inv * gg.z, v[j].w * inv * gg.w); o8[64 * j] = w; }
}

constexpr int AT_KSTR = 72, AT_VSTR = 68;
constexpr int AT_KBYTES = 64 * AT_KSTR * 2, AT_VBYTES = 64 * AT_VSTR * 2;
__device__ __forceinline__ void vt_write(LAS unsigned char* p, const u32x4 v) {
    *(LAS unsigned short*)(p + 0 * (AT_VSTR * 2)) = (unsigned short)(v.x & 0xffffu); *(LAS unsigned short*)(p + 1 * (AT_VSTR * 2)) = (unsigned short)(v.x >> 16);
    *(LAS unsigned short*)(p + 2 * (AT_VSTR * 2)) = (unsigned short)(v.y & 0xffffu); *(LAS unsigned short*)(p + 3 * (AT_VSTR * 2)) = (unsigned short)(v.y >> 16);
    *(LAS unsigned short*)(p + 4 * (AT_VSTR * 2)) = (unsigned short)(v.z & 0xffffu); *(LAS unsigned short*)(p + 5 * (AT_VSTR * 2)) = (unsigned short)(v.z >> 16);
    *(LAS unsigned short*)(p + 6 * (AT_VSTR * 2)) = (unsigned short)(v.w & 0xffffu); *(LAS unsigned short*)(p + 7 * (AT_VSTR * 2)) = (unsigned short)(v.w >> 16);
}
__device__ __forceinline__ void attn_tile(LAS unsigned char* lds, int cur, int r32, int hi, const bf16x8 (&qf)[4], float& mref, float& lrun, f32x16& o0, f32x16& o1) {
        const LAS unsigned char* kb = lds + cur * AT_KBYTES + r32 * (AT_KSTR * 2) + hi * 16;
        f32x16 p0, p1;
        { const float nm = -mref;
#pragma unroll
          for (int r = 0; r < 16; ++r) { p0[r] = nm; p1[r] = nm; } }
#pragma unroll
        for (int d0 = 0; d0 < 4; ++d0) {
            const bf16x8 a0 = *(const LAS bf16x8*)(kb + d0 * 32), a1 = *(const LAS bf16x8*)(kb + 32 * (AT_KSTR * 2) + d0 * 32);
            p0 = __builtin_amdgcn_mfma_f32_32x32x16_bf16(a0, qf[d0], p0, 0, 0, 0);
            p1 = __builtin_amdgcn_mfma_f32_32x32x16_bf16(a1, qf[d0], p1, 0, 0, 0);
        }
        float mx = __builtin_fmaxf(__builtin_fmaxf(p0[0], p1[0]), p0[1]);
        mx = __builtin_fmaxf(__builtin_fmaxf(mx, p1[1]), p0[2]);
#pragma unroll
        for (int r = 2; r < 14; r += 2) { mx = __builtin_fmaxf(__builtin_fmaxf(mx, p1[r]), p0[r + 1]); mx = __builtin_fmaxf(__builtin_fmaxf(mx, p1[r + 1]), p0[r + 2]); }
        mx = __builtin_fmaxf(__builtin_fmaxf(mx, p1[14]), p0[15]); mx = __builtin_fmaxf(mx, p1[15]);
        mx = __builtin_fmaxf(mx, __shfl_xor(mx, 32));
        if (__builtin_expect(__any(mx > 8.0f), 0)) {
            const float dl = __builtin_fmaxf(mx, 0.f), f = __builtin_amdgcn_exp2f(-dl);
            mref += dl; lrun *= f;
#pragma unroll
            for (int r = 0; r < 16; ++r) { p0[r] -= dl; p1[r] -= dl; o0[r] *= f; o1[r] *= f; }
        }
        f32x2 ls2 = {0.f, 0.f};
#pragma unroll
        for (int r = 0; r < 16; r += 2) {
            p0[r] = __builtin_amdgcn_exp2f(p0[r]); p0[r + 1] = __builtin_amdgcn_exp2f(p0[r + 1]); p1[r] = __builtin_amdgcn_exp2f(p1[r]); p1[r + 1] = __builtin_amdgcn_exp2f(p1[r + 1]);
            ls2 += (f32x2){p0[r], p0[r + 1]}; ls2 += (f32x2){p1[r], p1[r + 1]};
        }
        lrun += ls2.x + ls2.y;
        bf16x8 pf[4];
        { u32x4 w;
          w.x = cvt_pk_bf16(p0[0], p0[1]); w.y = cvt_pk_bf16(p0[2], p0[3]); w.z = cvt_pk_bf16(p0[4], p0[5]); w.w = cvt_pk_bf16(p0[6], p0[7]); pf[0] = __builtin_bit_cast(bf16x8, w);
          w.x = cvt_pk_bf16(p0[8], p0[9]); w.y = cvt_pk_bf16(p0[10], p0[11]); w.z = cvt_pk_bf16(p0[12], p0[13]); w.w = cvt_pk_bf16(p0[14], p0[15]); pf[1] = __builtin_bit_cast(bf16x8, w);
          w.x = cvt_pk_bf16(p1[0], p1[1]); w.y = cvt_pk_bf16(p1[2], p1[3]); w.z = cvt_pk_bf16(p1[4], p1[5]); w.w = cvt_pk_bf16(p1[6], p1[7]); pf[2] = __builtin_bit_cast(bf16x8, w);
          w.x = cvt_pk_bf16(p1[8], p1[9]); w.y = cvt_pk_bf16(p1[10], p1[11]); w.z = cvt_pk_bf16(p1[12], p1[13]); w.w = cvt_pk_bf16(p1[14], p1[15]); pf[3] = __builtin_bit_cast(bf16x8, w); }
        const LAS unsigned char* vb = lds + 2 * AT_KBYTES + cur * AT_VBYTES + r32 * (AT_VSTR * 2) + hi * 8;
#pragma unroll
        for (int s = 0; s < 4; ++s) {
            const int koff = ((s >> 1) * 32 + (s & 1) * 16) * 2;
            const u32x2 l0 = *(const LAS u32x2*)(vb + koff), h0 = *(const LAS u32x2*)(vb + koff + 16);
            const u32x2 l1 = *(const LAS u32x2*)(vb + 32 * (AT_VSTR * 2) + koff), h1 = *(const LAS u32x2*)(vb + 32 * (AT_VSTR * 2) + koff + 16);
            const bf16x8 a0 = __builtin_bit_cast(bf16x8, (u32x4){l0.x, l0.y, h0.x, h0.y}), a1 = __builtin_bit_cast(bf16x8, (u32x4){l1.x, l1.y, h1.x, h1.y});
            o0 = __builtin_amdgcn_mfma_f32_32x32x16_bf16(a0, pf[s], o0, 0, 0, 0);
            o1 = __builtin_amdgcn_mfma_f32_32x32x16_bf16(a1, pf[s], o1, 0, 0, 0);
        }
}
__device__ __forceinline__ void attn_unit(LAS unsigned char* lds, bf16_t* C2, bf16_t* Odummy, int b, int kvh, int qb) {
    int tid = threadIdx.x; asm volatile("" : "+v"(tid));
    const int lane = tid & 63, r32 = lane & 31, hi = lane >> 5, wid = __builtin_amdgcn_readfirstlane(tid >> 6);
    const int g = wid & 3, th = wid >> 2, head = kvh * 4 + g;
    const size_t rowbase = (size_t)b * SEQ;
    const int tok0 = qb * 128 + th * 64;
    bf16_t* qrowA = C2 + (rowbase + tok0 + r32) * LD_C2 + 1536 + head * 64;
    bf16_t* qrowB = qrowA + (size_t)32 * LD_C2;
    bf16x8 qfA[4], qfB[4];
#pragma unroll
    for (int d0 = 0; d0 < 4; ++d0) { qfA[d0] = *(const bf16x8*)(qrowA + d0 * 16 + hi * 8); qfB[d0] = *(const bf16x8*)(qrowB + d0 * 16 + hi * 8); }
    const int srow = tid >> 3, sch = tid & 7;
    const bf16_t* ksrc = C2 + (rowbase + srow) * LD_C2 + 2048 + kvh * 64 + sch * 8;
    const bf16_t* vsrc = ksrc + 128;
    LAS unsigned char* kdst = lds + srow * (AT_KSTR * 2) + sch * 16;
    LAS unsigned char* vdst = lds + 2 * AT_KBYTES + (8 * sch) * (AT_VSTR * 2) + srow * 2;
    u32x4 kregA = *(const u32x4*)ksrc, vregA = *(const u32x4*)vsrc, kregB, vregB;
    *(LAS u32x4*)kdst = kregA; vt_write(vdst, vregA);
    kregA = *(const u32x4*)(ksrc + (size_t)64 * LD_C2); vregA = *(const u32x4*)(vsrc + (size_t)64 * LD_C2);
    __syncthreads();
    f32x16 oA0 = {}, oA1 = {}, oB0 = {}, oB1 = {};
    float mrefA = 0.f, lrunA = 0.f, mrefB = 0.f, lrunB = 0.f;
#define AT_STEP(kt, cur, KW, VW, KL, VL) { \
        if ((kt) + 2 < SEQ / 64) { KL = *(const u32x4*)(ksrc + (size_t)((kt) + 2) * 64 * LD_C2); VL = *(const u32x4*)(vsrc + (size_t)((kt) + 2) * 64 * LD_C2); } \
        attn_tile(lds, cur, r32, hi, qfA, mrefA, lrunA, oA0, oA1); \
        __builtin_amdgcn_sched_barrier(0); \
        attn_tile(lds, cur, r32, hi, qfB, mrefB, lrunB, oB0, oB1); \
        __builtin_amdgcn_sched_barrier(0); \
        if ((kt) + 1 < SEQ / 64) { *(LAS u32x4*)(kdst + ((cur) ^ 1) * AT_KBYTES) = KW; vt_write(vdst + ((cur) ^ 1) * AT_VBYTES, VW); } \
        __syncthreads(); }
    for (int kt = 0; kt < SEQ / 64; kt += 2) {
        AT_STEP(kt, 0, kregA, vregA, kregB, vregB);
        AT_STEP(kt + 1, 1, kregB, vregB, kregA, vregA);
    }
#undef AT_STEP
#pragma unroll
    for (int blk = 0; blk < 2; ++blk) {
        float lr = blk ? lrunB : lrunA; lr += __shfl_xor(lr, 32);
        const float rl = __builtin_amdgcn_rcpf(lr);
        const f32x16& o0 = blk ? oB0 : oA0; const f32x16& o1 = blk ? oB1 : oA1;
        bf16_t* qrow = blk ? qrowB : qrowA;
        bf16_t* orow = Odummy ? Odummy + (rowbase + tok0 + 32 * blk + r32) * 512 + head * 64 : qrow;
#pragma unroll
        for (int g4 = 0; g4 < 4; ++g4) {
            u32x2 w0, w1;
            w0.x = cvt_pk_bf16(o0[4 * g4] * rl, o0[4 * g4 + 1] * rl); w0.y = cvt_pk_bf16(o0[4 * g4 + 2] * rl, o0[4 * g4 + 3] * rl);
            w1.x = cvt_pk_bf16(o1[4 * g4] * rl, o1[4 * g4 + 1] * rl); w1.y = cvt_pk_bf16(o1[4 * g4 + 2] * rl, o1[4 * g4 + 3] * rl);
            *(u32x2*)(orow + 8 * g4 + 4 * hi) = w0; *(u32x2*)(orow + 32 + 8 * g4 + 4 * hi) = w1;
        }
    }
}

__device__ __forceinline__ void conv_item(bf16_t* C2, const float* cvw, const float* cvb, int idx) {
    const int m = idx >> 6, c0 = (idx & 63) * 8, t = m & 4095;
    bf16_t* rp = C2 + (size_t)m * LD_C2 + c0;
    const bf16_t* rpp = (t > 0) ? rp - LD_C2 : rp; const bf16_t* rpn = (t < SEQ - 1) ? rp + LD_C2 : rp;
    const float fp = (t > 0) ? 1.f : 0.f, fn = (t < SEQ - 1) ? 1.f : 0.f;
    float bg[8], c[8], x[8], a[8], bq[8], a2[8], b2[8], o[8];
    unpack8(*(const u32x4*)rp, bg); unpack8(*(const u32x4*)(rp + 512), c); unpack8(*(const u32x4*)(rp + 1024), x);
    unpack8(*(const u32x4*)(rpp + 512), a); unpack8(*(const u32x4*)(rpp + 1024), bq); unpack8(*(const u32x4*)(rpn + 512), a2); unpack8(*(const u32x4*)(rpn + 1024), b2);
#pragma unroll
    for (int j = 0; j < 8; ++j) o[j] = bg[j] * (cvb[c0 + j] + cvw[c0 + j] * (a[j] * bq[j] * fp) + cvw[512 + c0 + j] * (c[j] * x[j]) + cvw[1024 + c0 + j] * (a2[j] * b2[j] * fn));
    *(u32x4*)rp = pack8(o);
}
constexpr int SC_CH = 32;
constexpr int SC_ARR = SC_CH * 64;
constexpr int SC_R = 0, SC_W = 1, SC_KD = 2, SC_V = 3, SC_KK = 4, SC_KKA = 5, SC_ZK = 6, SC_NARR = 7;
constexpr int SC_SLOT = SC_NARR * SC_ARR;
constexpr int SC_BW_OFF = 4096, SC_BA_OFF = 4096 + 9216;
constexpr int SC_TAB = 2 * SC_SLOT;
__device__ __forceinline__ void scan_rv(LAS float* sl, const LAS float* tab, const bf16_t* RWC, int b, int h, int dir, int chunk, int tok, int qq) {
    const int sc = chunk * SC_CH + tok, t = dir ? (SEQ - 1 - sc) : sc;
    const bf16_t* rp = RWC + ((size_t)b * SEQ + t) * LD_RWC;
    const bf16_t* rpp = (t > 0) ? rp - LD_RWC : rp; const bf16_t* rpn = (t < SEQ - 1) ? rp + LD_RWC : rp;
    const float fp = (t > 0) ? 1.f : 0.f, fn = (t < SEQ - 1) ? 1.f : 0.f;
    u32x4 qc[4], qp[4], qn[4];
#pragma unroll
    for (int i = 0; i < 4; ++i) { const int cb = (i >> 1) * 1024 + h * 64 + 16 * qq + 8 * (i & 1);
        qc[i] = *(const u32x4*)(rp + cb); qp[i] = *(const u32x4*)(rpp + cb); qn[i] = *(const u32x4*)(rpn + cb); }
#pragma unroll
    for (int i = 0; i < 4; ++i) { float c[8], p[8], n[8], z[8]; unpack8(qc[i], c); unpack8(qp[i], p); unpack8(qn[i], n);
        const LAS float* mp = tab + (i >> 1) * 128 + 16 * qq + 8 * (i & 1); const LAS float* mn = mp + 320;
#pragma unroll
        for (int j = 0; j < 8; ++j) z[j] = c[j] + mp[j] * (p[j] * fp - c[j]) + mn[j] * (n[j] * fn - c[j]);
        LAS float* dst = sl + ((i >> 1) ? SC_V : SC_R) * SC_ARR + tok * 64 + 16 * qq + 8 * (i & 1);
        *(LAS f32x4*)dst = (f32x4){z[0], z[1], z[2], z[3]}; *(LAS f32x4*)(dst + 4) = (f32x4){z[4], z[5], z[6], z[7]}; }
}
struct ScanW { const float *mu_prev, *mu_next, *w0, *a0, *k_k, *k_a, *r_k; const bf16_t *w2t, *a2t; };

__device__ __forceinline__ void scan_produce(LAS float* sl, LAS float* tab, const bf16_t* RWC, bf16_t* SG, float* SB, const ScanW& sw, const float* mu_gd_p, const float* mu_gd_n,
                                             int b, int h, int dir, int chunk, int sub, int lane) {
    asm volatile("" : "+v"(lane));
    const int tok = lane & 15, q = lane >> 4;
    const int tokidx = 16 * sub + tok;
    const int sc = chunk * SC_CH + tokidx;
    const int t = dir ? (SEQ - 1 - sc) : sc;
    const bf16_t* rp = RWC + ((size_t)b * SEQ + t) * LD_RWC;
    const bool hasp = t > 0, hasn = t < SEQ - 1;
    const bf16_t* rpp = hasp ? rp - LD_RWC : rp;
    const bf16_t* rpn = hasn ? rp + LD_RWC : rp;
    const float fp = hasp ? 1.f : 0.f, fn = hasn ? 1.f : 0.f;
    u32x4 Lc[6], Lp[6], Ln[6];
#pragma unroll
    for (int G = 1; G < 2; ++G)
#pragma unroll
        for (int hf = 0; hf < 2; ++hf) { const int cb = G * 512 + h * 64 + 16 * q + 8 * hf;
            Lc[2 * G + hf] = *(const u32x4*)(rp + cb); Lp[2 * G + hf] = *(const u32x4*)(rpp + cb); Ln[2 * G + hf] = *(const u32x4*)(rpn + cb); }
    u32x4 Mc[5], Mp[5], Mn[5];
#pragma unroll
    for (int i = 0; i < 4; ++i) { const int cb = 1536 + (i >> 1) * 128 + dir * 64 + 32 * (i & 1) + 8 * q;
        Mc[i] = *(const u32x4*)(rp + cb); Mp[i] = *(const u32x4*)(rpp + cb); Mn[i] = *(const u32x4*)(rpn + cb); }
    float zk[16];
#pragma unroll
    for (int G = 1; G < 2; ++G) {
        float z[16];
#pragma unroll
        for (int hf = 0; hf < 2; ++hf) {
            float c[8], p[8], n[8];
            unpack8(Lc[2 * G + hf], c); unpack8(Lp[2 * G + hf], p); unpack8(Ln[2 * G + hf], n);
            const LAS float* mp = tab + G * 64 + 16 * q + 8 * hf; const LAS float* mn = mp + 320;
#pragma unroll
            for (int j = 0; j < 8; ++j) z[8 * hf + j] = c[j] + mp[j] * (p[j] * fp - c[j]) + mn[j] * (n[j] * fn - c[j]);
        }
        LAS float* dst = sl + (G == 0 ? SC_R : (G == 1 ? SC_ZK : SC_V)) * SC_ARR + tokidx * 64 + 16 * q;
#pragma unroll
        for (int j4 = 0; j4 < 4; ++j4) *(LAS f32x4*)(dst + 4 * j4) = (f32x4){z[4 * j4], z[4 * j4 + 1], z[4 * j4 + 2], z[4 * j4 + 3]};
        if (G == 1) {
#pragma unroll
            for (int j = 0; j < 16; ++j) zk[j] = z[j];
        }
    }
    {
        const LAS float* kkt = tab + 640 + 16 * q;
        float kr[16], ss = 0.f;
#pragma unroll
        for (int j = 0; j < 16; ++j) { kr[j] = zk[j] * kkt[j]; ss += kr[j] * kr[j]; }
        ss += __shfl_xor(ss, 16); ss += __shfl_xor(ss, 32);
        const float inv = 1.f / fmaxf(sqrtf(ss), 1e-12f);
        LAS float* dst = sl + SC_KK * SC_ARR + tokidx * 64 + 16 * q;
#pragma unroll
        for (int j4 = 0; j4 < 4; ++j4) *(LAS f32x4*)(dst + 4 * j4) = (f32x4){kr[4 * j4] * inv, kr[4 * j4 + 1] * inv, kr[4 * j4 + 2] * inv, kr[4 * j4 + 3] * inv};
    }
    bf16x8 Awd[2], Aad[2];
#pragma unroll
    for (int i = 0; i < 4; ++i) {
        const int G = 3 + (i >> 1), ks = i & 1;
        float c[8], p[8], n[8], z[8];
        unpack8(Mc[i], c); unpack8(Mp[i], p); unpack8(Mn[i], n);
        const LAS float* mp = tab + G * 64 + 32 * ks + 8 * q; const LAS float* mn = mp + 320;
#pragma unroll
        for (int j = 0; j < 8; ++j) { z[j] = c[j] + mp[j] * (p[j] * fp - c[j]) + mn[j] * (n[j] * fn - c[j]); if (G == 3) z[j] = tanh_f(z[j]); }
        const bf16x8 fr8 = __builtin_bit_cast(bf16x8, pack8(z));
        if (G == 3) Awd[ks] = fr8; else Aad[ks] = fr8;
    }
    asm volatile("s_waitcnt lgkmcnt(0)" ::: "memory");
    f32x4 aw[4], aa[4];
    float w0r[4], a0r[4], kar[4];
#pragma unroll
    for (int nb = 0; nb < 4; ++nb) {
        const int cl = 16 * nb + (lane & 15);
        const LAS unsigned char* wp = (const LAS unsigned char*)tab + SC_BW_OFF + cl * 144 + 16 * (lane >> 4); const LAS unsigned char* ap = wp + (SC_BA_OFF - SC_BW_OFF);
        const bf16x8 bw0 = *(const LAS bf16x8*)wp, bw1 = *(const LAS bf16x8*)(wp + 64), ba0 = *(const LAS bf16x8*)ap, ba1 = *(const LAS bf16x8*)(ap + 64);
        w0r[nb] = tab[720 + cl]; a0r[nb] = tab[784 + cl]; kar[nb] = tab[848 + cl];
        aw[nb] = __builtin_amdgcn_mfma_f32_16x16x32_bf16(Awd[0], bw0, (f32x4){0.f, 0.f, 0.f, 0.f}, 0, 0, 0);
        aw[nb] = __builtin_amdgcn_mfma_f32_16x16x32_bf16(Awd[1], bw1, aw[nb], 0, 0, 0);
        aa[nb] = __builtin_amdgcn_mfma_f32_16x16x32_bf16(Aad[0], ba0, (f32x4){0.f, 0.f, 0.f, 0.f}, 0, 0, 0);
        aa[nb] = __builtin_amdgcn_mfma_f32_16x16x32_bf16(Aad[1], ba1, aa[nb], 0, 0, 0);
    }
#pragma unroll
    for (int nb = 0; nb < 4; ++nb)
#pragma unroll
        for (int rg = 0; rg < 4; ++rg) {
            const int ti = 16 * sub + 4 * q + rg, c = 16 * nb + (lane & 15), o = ti * 64 + c;
            const float dec = trans_settle(__builtin_amdgcn_exp2f(-0.6065306597126334f * LOG2E * sigmoid_f(aw[nb][rg] + w0r[nb])));
            const float a = sigmoid_f(aa[nb][rg] + a0r[nb]);
            const float zkv = sl[SC_ZK * SC_ARR + o], kkv = sl[SC_KK * SC_ARR + o];
            const float kd = zkv * (1.f + (a - 1.f) * kar[nb]);
            sl[SC_W * SC_ARR + o] = dec; sl[SC_KD * SC_ARR + o] = kd; sl[SC_KKA * SC_ARR + o] = kkv * a;
        }
}

__device__ __forceinline__ void scan_unit(LAS unsigned char* lds, const bf16_t* RWC, bf16_t* YF, bf16_t* YB, bf16_t* SG, float* SB, const ScanW& sw, int b, int h, int dir,
                                          bf16_t* C2cv, const float* cvw, const float* cvb, int unit) {
    int tid = threadIdx.x; asm volatile("" : "+v"(tid));
    const int lane = tid & 63, wid = __builtin_amdgcn_readfirstlane(tid >> 6);
    LAS float* fl = (LAS float*)lds;
    LAS float* tab = fl + SC_TAB;
    for (int i = tid; i < 976; i += 512) {
        float v;
        if (i < 640) { const int pn = i / 320, r = i % 320, G = r / 64, ch = r % 64;
            const int col = (G < 3) ? (G * 512 + h * 64 + ch) : (1536 + (G - 3) * 128 + dir * 64 + ch);
            v = (pn ? sw.mu_next : sw.mu_prev)[col]; }
        else if (i < 704) v = sw.k_k[h * 64 + (i - 640)];
        else if (i < 720) { const int j = i - 704; v = ((j >> 3) ? sw.mu_next : sw.mu_prev)[1792 + 8 * (2 * h + dir) + (j & 7)]; }
        else { const int k = i - 720, which = k >> 6, c = k & 63;
            v = which == 0 ? sw.w0[dir * 512 + h * 64 + c] : (which == 1 ? sw.a0[dir * 512 + h * 64 + c] : (which == 2 ? sw.k_a[h * 64 + c] : sw.r_k[h * 64 + c])); }
        tab[i] = v;
    }
    { const int row = tid >> 3, chunk = tid & 7; const size_t src = ((size_t)(dir * 512 + h * 64 + row)) * 64 + chunk * 8;
      *(LAS u32x4*)((LAS unsigned char*)tab + SC_BW_OFF + row * 144 + chunk * 16) = *(const u32x4*)(sw.w2t + src);
      *(LAS u32x4*)((LAS unsigned char*)tab + SC_BA_OFF + row * 144 + chunk * 16) = *(const u32x4*)(sw.a2t + src); }
    __syncthreads();
    if (wid >= 4 && wid < 6) scan_produce(fl, tab, RWC, SG, SB, sw, sw.mu_prev + 1792, sw.mu_next + 1792, b, h, dir, 0, wid - 4, lane);
    else if (wid >= 6) scan_rv(fl, tab, RWC, b, h, dir, 0, (tid - 384) >> 2, (tid - 384) & 3);
    __syncthreads();
    const int vp = tid >> 3, kq = tid & 7;
    f32x2 S0[4], S1[4];
#pragma unroll
    for (int i = 0; i < 4; ++i) { S0[i] = (f32x2){0.f, 0.f}; S1[i] = (f32x2){0.f, 0.f}; }
    bf16_t* Y = dir ? YB : YF;
    for (int ch = 0; ch < SEQ / SC_CH; ++ch) {
        LAS float* sl = fl + (ch & 1) * SC_SLOT;
        if (wid < 4) {
            const LAS float* base = sl + 8 * kq;
            const LAS float* vbase = sl + SC_V * SC_ARR + 2 * vp;
            f32x4 nkk0, nkk1, nw0, nw1, nka0, nka1, nkd0, nkd1, nr0, nr1; f32x2 nvv;
#define SC_LOAD(s_) do { const LAS float* p_ = base + (s_) * 64; \
                nkk0 = *(const LAS f32x4*)(p_ + SC_KK * SC_ARR); nkk1 = *(const LAS f32x4*)(p_ + SC_KK * SC_ARR + 4); \
                nw0 = *(const LAS f32x4*)(p_ + SC_W * SC_ARR); nw1 = *(const LAS f32x4*)(p_ + SC_W * SC_ARR + 4); \
                nka0 = *(const LAS f32x4*)(p_ + SC_KKA * SC_ARR); nka1 = *(const LAS f32x4*)(p_ + SC_KKA * SC_ARR + 4); \
                nkd0 = *(const LAS f32x4*)(p_ + SC_KD * SC_ARR); nkd1 = *(const LAS f32x4*)(p_ + SC_KD * SC_ARR + 4); \
                nr0 = *(const LAS f32x4*)(p_ + SC_R * SC_ARR); nr1 = *(const LAS f32x4*)(p_ + SC_R * SC_ARR + 4); \
                nvv = *(const LAS f32x2*)(vbase + (s_) * 64); } while (0)
            SC_LOAD(0);
#pragma unroll 2
            for (int s = 0; s < SC_CH; ++s) {
                f32x2 kk[4], w[4], ka[4], kd[4], r[4];
                kk[0] = nkk0.xy; kk[1] = nkk0.zw; kk[2] = nkk1.xy; kk[3] = nkk1.zw;
                w[0] = nw0.xy; w[1] = nw0.zw; w[2] = nw1.xy; w[3] = nw1.zw;
                ka[0] = nka0.xy; ka[1] = nka0.zw; ka[2] = nka1.xy; ka[3] = nka1.zw;
                kd[0] = nkd0.xy; kd[1] = nkd0.zw; kd[2] = nkd1.xy; kd[3] = nkd1.zw;
                r[0] = nr0.xy; r[1] = nr0.zw; r[2] = nr1.xy; r[3] = nr1.zw;
                const f32x2 vv = nvv;
                SC_LOAD((s + 1) & (SC_CH - 1));
                f32x2 t0 = S0[0] * kk[0], t1 = S1[0] * kk[0];
#pragma unroll
                for (int i = 1; i < 4; ++i) { t0 = S0[i] * kk[i] + t0; t1 = S1[i] * kk[i] + t1; }
                const float sa0 = red8(t0.x + t0.y), sa1 = red8(t1.x + t1.y);
                const f32x2 n0 = (f32x2){-sa0, -sa0}, n1 = (f32x2){-sa1, -sa1}, v0 = (f32x2){vv.x, vv.x}, v1 = (f32x2){vv.y, vv.y};
                f32x2 y0 = (f32x2){0.f, 0.f}, y1 = (f32x2){0.f, 0.f};
#pragma unroll
                for (int i = 0; i < 4; ++i) {
                    S0[i] = S0[i] * w[i] + (v0 * kd[i] + n0 * ka[i]);
                    S1[i] = S1[i] * w[i] + (v1 * kd[i] + n1 * ka[i]);
                    y0 = S0[i] * r[i] + y0; y1 = S1[i] * r[i] + y1;
                }
                float yp0 = y0.x + y0.y, yp1 = y1.x + y1.y; asm volatile("" : "+v"(yp0));
                const float ys0 = red8_nopack(yp0), ys1 = red8(yp1);
                if (kq == 0) { const int sc = ch * SC_CH + s; const int t = dir ? (SEQ - 1 - sc) : sc;
                    *(unsigned*)(Y + ((size_t)b * SEQ + t) * 512 + h * 64 + 2 * vp) = cvt_pk_bf16(ys0, ys1); }
            }
#undef SC_LOAD
        } else if (wid < 6) {
            if (ch + 1 < SEQ / SC_CH) scan_produce(fl + ((ch + 1) & 1) * SC_SLOT, tab, RWC, SG, SB, sw, sw.mu_prev + 1792, sw.mu_next + 1792, b, h, dir, ch + 1, wid - 4, lane);
        } else {
            if (ch + 1 < SEQ / SC_CH) scan_rv(fl + ((ch + 1) & 1) * SC_SLOT, tab, RWC, b, h, dir, ch + 1, (tid - 384) >> 2, (tid - 384) & 3);
            conv_item(C2cv, cvw, cvb, unit * 16384 + ch * 128 + (tid - 384));
            { const int j = tid - 384, tok = j >> 2, pr = j & 3, sc = ch * SC_CH + tok, t = dir ? (SEQ - 1 - sc) : sc, cg8 = 8 * (2 * h + dir) + 2 * pr;
              const bf16_t* rp = RWC + ((size_t)b * SEQ + t) * LD_RWC + 1792 + cg8;
              const unsigned uc = *(const unsigned*)rp, up = *(const unsigned*)(t > 0 ? rp - LD_RWC : rp), un = *(const unsigned*)(t < SEQ - 1 ? rp + LD_RWC : rp);
              const float fp = t > 0 ? 1.f : 0.f, fn = t < SEQ - 1 ? 1.f : 0.f;
              const float c0 = bflo(uc), c1 = bfhi(uc);
              const float z0 = sigmoid_f(c0 + tab[704 + 2 * pr] * (bflo(up) * fp - c0) + tab[712 + 2 * pr] * (bflo(un) * fn - c0));
              const float z1 = sigmoid_f(c1 + tab[705 + 2 * pr] * (bfhi(up) * fp - c1) + tab[713 + 2 * pr] * (bfhi(un) * fn - c1));
              *(unsigned*)(SG + ((size_t)b * SEQ + t) * 256 + cg8) = cvt_pk_bf16(z0, z1); }
            { const int j = tid - 384, tok = j >> 2, qq = j & 3;
              const LAS float* rp = sl + SC_R * SC_ARR + tok * 64 + 16 * qq; const LAS float* kp = sl + SC_KD * SC_ARR + tok * 64 + 16 * qq; const LAS float* gp = tab + 912 + 16 * qq;
              float acc = 0.f;
#pragma unroll
              for (int i4 = 0; i4 < 4; ++i4) { const f32x4 r4 = *(const LAS f32x4*)(rp + 4 * i4), k4 = *(const LAS f32x4*)(kp + 4 * i4), g4 = *(const LAS f32x4*)(gp + 4 * i4);
                  acc += (r4[0] * k4[0] * g4[0] + r4[1] * k4[1] * g4[1]) + (r4[2] * k4[2] * g4[2] + r4[3] * k4[3] * g4[3]); }
              acc += dpp_f<0xB1>(acc); acc += dpp_f<0x4E>(acc);
              if (qq == 0) { const int sc = ch * SC_CH + tok; const int t = dir ? (SEQ - 1 - sc) : sc; SB[((size_t)dir * T + (size_t)b * SEQ + t) * 8 + h] = acc; } }
        }
        __syncthreads();
    }
}


#define XB_TMO      128
#define XB_XCNT(j)  (256  + 64 * (j))
#define XB_XSUB(j)  (1280 + 64 * (j))
#define XB_XGEN(j)  (2304 + 64 * (j))
#define XB_TOP      3328
#define XB_TOPGEN   3392
#define XB_SPIN_CAP (1u << 22)
__device__ __forceinline__ unsigned xb_ld(unsigned* p)              { return __hip_atomic_load(p, __ATOMIC_RELAXED, __HIP_MEMORY_SCOPE_AGENT); }
__device__ __forceinline__ unsigned xb_add(unsigned* p, unsigned v) { return __hip_atomic_fetch_add(p, v, __ATOMIC_RELAXED, __HIP_MEMORY_SCOPE_AGENT); }
__device__ __forceinline__ unsigned xb_xcc_id() { return (unsigned)__builtin_amdgcn_s_getreg((3 << 11) | 20) & 0xFu; }
#define XB_SPIN(cond, bar) do { unsigned _sp = 0; while (cond) { __builtin_amdgcn_s_sleep(1); \
    if ((++_sp & 255u) == 0u) { if (xb_ld(&(bar)[XB_TMO])) break; if (_sp > XB_SPIN_CAP) { atomicAdd(&(bar)[XB_TMO], 1u); break; } } } } while (0)
struct XcdBarrier { unsigned* bar; unsigned x; volatile LAS unsigned* st; };
__device__ __forceinline__ XcdBarrier xcd_barrier_post(unsigned* bar, volatile LAS unsigned* st) {
    XcdBarrier b; b.bar = bar; b.x = xb_xcc_id(); b.st = st;
    if (threadIdx.x == 0) (void)xb_add(&bar[XB_XCNT(b.x)], 1u);
    return b;
}
__device__ __forceinline__ void xcd_barrier_complete(unsigned* bar, unsigned x, unsigned& nloc, unsigned& nx) {
    const unsigned G = gridDim.x * gridDim.y * gridDim.z;
    unsigned sum, cnt, mine, sp = 0u;
    for (;;) {
        sum = 0u; cnt = 0u; mine = 0u;
#pragma unroll
        for (unsigned j = 0; j < 16; ++j) { const unsigned c = xb_ld(&bar[XB_XCNT(j)]); sum += c; cnt += (c > 0u) ? 1u : 0u; mine = (j == x) ? c : mine; }
        if (sum == G) break;
        __builtin_amdgcn_s_sleep(1);
        if ((++sp & 255u) == 0u) { if (xb_ld(&bar[XB_TMO])) break; if (sp > XB_SPIN_CAP) { atomicAdd(&bar[XB_TMO], 1u); break; } }
    }
    nloc = mine > 0u ? mine : 1u; nx = cnt > 0u ? cnt : 1u;
}
__device__ __forceinline__ void xcd_barrier(const XcdBarrier& b) {
    asm volatile("s_waitcnt vmcnt(0)" ::: "memory");
    __syncthreads();
    if (threadIdx.x == 0) {
        unsigned* bar = b.bar;
        __builtin_amdgcn_s_waitcnt(0);
        unsigned nloc = b.st[0], nx = b.st[1];
        if (nloc == 0u) { xcd_barrier_complete(bar, b.x, nloc, nx); b.st[0] = nloc; b.st[1] = nx; }
        const unsigned old = xb_add(&bar[XB_XSUB(b.x)], 1u);
        const unsigned gen = old / nloc;
        if (old + 1u == (gen + 1u) * nloc) {
            __builtin_amdgcn_fence(__ATOMIC_RELEASE, "agent");
            asm volatile("s_waitcnt vmcnt(0)" ::: "memory");
            const unsigned og = xb_add(&bar[XB_TOP], 1u);
            const unsigned tg = og / nx;
            if (og + 1u == (tg + 1u) * nx) xb_add(&bar[XB_TOPGEN], 1u);
            else XB_SPIN(xb_ld(&bar[XB_TOPGEN]) == tg, bar);
            __builtin_amdgcn_fence(__ATOMIC_ACQUIRE, "agent");
            xb_add(&bar[XB_XGEN(b.x)], 1u);
            asm volatile("s_waitcnt vmcnt(0)" ::: "memory");
        } else {
            XB_SPIN(xb_ld(&bar[XB_XGEN(b.x)]) == gen, bar);
            __builtin_amdgcn_fence(__ATOMIC_ACQUIRE, "agent");
            asm volatile("s_waitcnt vmcnt(0)" ::: "memory");
        }
    }
    __syncthreads();
}

#ifdef MK_DBG_STOP
#define DBG_STOP(k) do { if ((k) == MK_DBG_STOP && l == 0) { dbg_dump(p, ws0, bx * 512 + (int)threadIdx.x, G * 512); return; } } while (0)
__device__ __noinline__ void dbg_dump(const Params& p, unsigned char* ws, int gtid, int NGT) {
    const bf16_t* rwc = (const bf16_t*)(ws + WS_RWC); const bf16_t* c2 = (const bf16_t*)(ws + WS_C2); const bf16_t* yf = (const bf16_t*)(ws + WS_YF); const bf16_t* yb = (const bf16_t*)(ws + WS_YB);
    const bf16_t* sg = (const bf16_t*)(ws + WS_SG); const float* sb = (const float*)(ws + WS_SB); const bf16_t* hb = (const bf16_t*)(ws + WS_H);
    for (size_t i = gtid; i < (size_t)T * 1024; i += NGT) {
        const size_t m = i >> 10; const int c = (int)(i & 1023);
        float v = 0.f;
#if MK_DBG_WHAT == 0
        v = bflo(rwc[m * 2048 + 2 * c]) + bflo(rwc[m * 2048 + 2 * c + 1]);
#elif MK_DBG_WHAT == 1
        v = bflo(c2[m * 2304 + 2 * c]) + bflo(c2[m * 2304 + 2 * c + 1]) + (c < 256 ? bflo(c2[m * 2304 + 2048 + c]) : 0.f);
#elif MK_DBG_WHAT == 2
        v = (c < 512 ? bflo(yf[m * 512 + c]) : bflo(yb[m * 512 + c - 512]));
#elif MK_DBG_WHAT == 3
        v = (c < 256 ? bflo(sg[m * 256 + c]) : (c < 272 ? sb[((c - 256) >> 3) * (size_t)T * 8 + m * 8 + (c & 7)] : bflo(hb[m * 1024 + c])));
#elif MK_DBG_WHAT == 6
        v = bflo(((const bf16_t*)(ws + WS_WIN))[(size_t)(4352 + (m % 3072)) * 1024 + c]) + bflo(hb[m * 1024 + c]);
#elif MK_DBG_WHAT == 5
        v = bflo(((const bf16_t*)(ws + WS_GT))[m * 1024 + c]);
#elif MK_DBG_WHAT == 4
        v = bflo(rwc[(size_t)T * 1024 + m * 1024 + c]);
#endif
        p.out[i] = v;
    }
}
#else
#define DBG_STOP(k) do { } while (0)
#endif

#define L1_REFRESH() do { asm volatile("s_waitcnt vmcnt(0)" ::: "memory"); __builtin_amdgcn_fence(__ATOMIC_ACQUIRE, "agent"); asm volatile("s_waitcnt vmcnt(0)" ::: "memory"); } while (0)
#define PHASE_IDS() int tid = threadIdx.x; asm volatile("" : "+v"(tid)); const int lane = tid & 63, wave = __builtin_amdgcn_readfirstlane(tid >> 6); const int gw = vcu * 8 + wave, gtid = bx * 512 + tid; (void)lane; (void)gw; (void)gtid
#define Win_t ((bf16_t*)(ws + WS_WIN))
#define Wbr_t ((bf16_t*)(ws + WS_WBR))
#define Wout_t ((bf16_t*)(ws + WS_WOUT))
#define W1_t ((bf16_t*)(ws + WS_W1))
#define W2_t ((bf16_t*)(ws + WS_W2))
#define w2t ((bf16_t*)(ws + WS_W2T))
#define a2t ((bf16_t*)(ws + WS_A2T))
#define g2t ((bf16_t*)(ws + WS_G2T))
#define Hb ((bf16_t*)(ws + WS_H))
#define RWC ((bf16_t*)(ws + WS_RWC))
#define C2 ((bf16_t*)(ws + WS_C2))
#define YF ((bf16_t*)(ws + WS_YF))
#define YB ((bf16_t*)(ws + WS_YB))
#define SG ((bf16_t*)(ws + WS_SG))
#define VT ((bf16_t*)(ws + WS_VT))
#define SB ((float*)(ws + WS_SB))
#define Gt ((bf16_t*)(ws + WS_GT))
#define Mg ((bf16_t*)(ws + WS_MRG))
#define Ub ((bf16_t*)(ws + WS_U))
__global__ void __launch_bounds__(512, 2) fwd_megakernel(Params p) {
    extern __shared__ __attribute__((aligned(16))) unsigned char lds_raw[];
    LAS unsigned char* lds = (LAS unsigned char*)lds_raw;
    cg::grid_group grid = cg::this_grid();
    volatile LAS unsigned* misc = (volatile LAS unsigned*)(lds + 139264);
    if (threadIdx.x < 16) misc[threadIdx.x] = 0u;
    __syncthreads();
    XcdBarrier xbar = xcd_barrier_post((unsigned*)(p.ws + 65536), misc);
    grid.sync();
    const int G = gridDim.x, bx = blockIdx.x;
    const int vcu = (G % 8 == 0) ? (bx % 8) * (G / 8) + bx / 8 : bx;
    const int NGW = G * 8, NGT = G * 512;
    float* X = p.out;

    for (int l = 0; l < DEPTH; ++l) {
        const float* xin = (l == 0) ? p.in[0] : X;
        unsigned char* ws0 = p.ws; asm volatile("" : "+s"(ws0));
        GAS unsigned char* ws = (GAS unsigned char*)ws0;
        if (PHMASK & (1u << 0)) {
            PHASE_IDS();
            LAS float* scr = (LAS float*)(lds + wave * 8448);
            const float* w_in = p.in[2] + (size_t)l * D_MODEL * IN_COLS;
            const float* w_br = p.in[19] + (size_t)l * 3 * 512 * D_MODEL;
            const float* w_out = p.in[20] + (size_t)l * D_MODEL * D_MODEL;
            const float* w_m1 = p.in[22] + (size_t)l * D_MODEL * D_FF;
            const float* w_m2 = p.in[23] + (size_t)l * D_FF * D_MODEL;
            const float* rw_w2 = p.in[6] + (size_t)l * 2 * 64 * 512;
            const float* rw_a2 = p.in[8] + (size_t)l * 2 * 64 * 512;
            const float* rw_g2 = p.in[9] + (size_t)l * 128 * 512;
            constexpr int I_IN = 232 * 16, I_BR = 3 * 8 * 32, I_OUT = 16 * 32, I_M1 = 16 * 128, I_M2 = 64 * 32, I_L = 32, I_G = 32;
            constexpr int NITEMS = I_IN + I_BR + I_OUT + I_M1 + I_M2 + 2 * I_L + I_G;
            for (int it = gw; it < NITEMS; it += NGW) {
                int r = it;
                if (r < I_IN) { const int db = r % 232, kb = r / 232; int src;
                    if (db < 60) src = 32 * db;
                    else if (db < 64) {
                        const int c = lane & 7;
#pragma unroll
                        for (int j = 0; j < 4; ++j) { const int n = (lane >> 3) + 8 * j; *(u32x4*)(Win_t + (size_t)(32 * db + n) * D_MODEL + 64 * kb + 8 * c) = (u32x4){0u, 0u, 0u, 0u}; }
                        continue; }
                    else if (db < 112) src = 1920 + 32 * (db - 64);
                    else if (db < 136) { const int pp = 32 * (db - 112), tile = pp >> 8, c = pp & 255, bj = c >> 7, wc = (c & 127) >> 5; src = 3456 + tile * 256 + 64 * wc + 32 * bj; }
                    else src = 4224 + 32 * (db - 136);
                    transpose_item(w_in, IN_COLS, 64 * kb, src, Win_t, D_MODEL, 32 * db, scr, lane); continue; }
                r -= I_IN;
                if (r < I_BR) { const int bb = r / 256, q = r % 256, kb = q / 32, nb = q % 32;
                    transpose_item(w_br + (size_t)bb * 512 * D_MODEL, D_MODEL, 64 * kb, 32 * nb, Wbr_t + (size_t)bb * D_MODEL * 512, 512, 32 * nb, scr, lane); continue; }
                r -= I_BR;
                if (r < I_OUT) { transpose_item(w_out, D_MODEL, 64 * (r / 32), 32 * (r % 32), Wout_t, D_MODEL, 32 * (r % 32), scr, lane); continue; }
                r -= I_OUT;
                if (r < I_M1) { transpose_item(w_m1, D_FF, 64 * (r / 128), 32 * (r % 128), W1_t, D_MODEL, 32 * (r % 128), scr, lane); continue; }
                r -= I_M1;
                if (r < I_M2) { transpose_item(w_m2, D_MODEL, 64 * (r / 32), 32 * (r % 32), W2_t, D_FF, 32 * (r % 32), scr, lane); continue; }
                r -= I_M2;
                if (r < I_L) { const int dd = r / 16, nb = r % 16; transpose_item(rw_w2 + (size_t)dd * 64 * 512, 512, 0, 32 * nb, w2t + (size_t)dd * 512 * 64, 64, 32 * nb, scr, lane); continue; }
                r -= I_L;
                if (r < I_L) { const int dd = r / 16, nb = r % 16; transpose_item(rw_a2 + (size_t)dd * 64 * 512, 512, 0, 32 * nb, a2t + (size_t)dd * 512 * 64, 64, 32 * nb, scr, lane); continue; }
                r -= I_L;
                { const int kb = r / 16, nb = r % 16; transpose_item(rw_g2, 512, 64 * kb, 32 * nb, g2t, 256, 32 * nb, scr, lane); }
            }
            for (int i = gtid; i < 512 * 16; i += NGT) *(u32x4*)(g2t + (size_t)(i >> 4) * 256 + 128 + 8 * (i & 15)) = (u32x4){0u, 0u, 0u, 0u};
            if (l == 0) for (int i = gtid; i < T * 16; i += NGT) *(u32x4*)(SG + (size_t)(i >> 4) * 256 + 128 + 8 * (i & 15)) = (u32x4){0u, 0u, 0u, 0u};
            const float* g1 = p.in[1] + (size_t)l * D_MODEL;
            if (T % (2 * NGW) == 0) { for (int m = gw; m < T; m += 2 * NGW) rms_row2(xin + (size_t)m * D_MODEL, xin + (size_t)(m + NGW) * D_MODEL, g1, Hb + (size_t)m * D_MODEL, Hb + (size_t)(m + NGW) * D_MODEL, lane); }
            else { for (int m = gw; m < T; m += NGW) rms_row(xin + (size_t)m * D_MODEL, g1, Hb + (size_t)m * D_MODEL, lane); }
        }
        xcd_barrier(xbar);
        DBG_STOP(1);
        if (PHMASK & (1u << 1)) {
            pg8::StaticOrder S;
#ifndef SKIP_P2A
            { pg8::Gemm g{Hb, Win_t, T, 3584, D_MODEL, D_MODEL}; S.init(T, 3584, G, bx);
              pg8::EpiStore<0> E{RWC, LD_RWC, C2, LD_C2, 8}; pg8::gemm_phase(lds, g, S, E); }
#endif
#ifndef SKIP_P2B
            { pg8::Gemm g{Hb, Win_t + (size_t)3584 * D_MODEL, T, 768, D_MODEL, D_MODEL}; S.init(T, 768, G, bx);
              pg8::EpiAttn E{C2, VT, p.in[17] + l * 64, p.in[18] + l * 64}; pg8::gemm_phase(lds, g, S, E); }
#endif
        }
        xcd_barrier(xbar);
        DBG_STOP(2);
        if (PHMASK & (1u << 2)) {
            PHASE_IDS();
            const float* cvw = p.in[15] + (size_t)l * 3 * 512; const float* cvb = p.in[16] + (size_t)l * 512;
            ScanW sw{p.in[3] + (size_t)l * RW_COLS, p.in[4] + (size_t)l * RW_COLS, p.in[5] + (size_t)l * 1024, p.in[7] + (size_t)l * 1024,
                     p.in[10] + (size_t)l * 512, p.in[11] + (size_t)l * 512, p.in[12] + (size_t)l * 512, w2t, a2t};
#ifndef SKIP_SCAN
#ifdef MK_DUP_SCAN
            for (int u = vcu; u < 256; u += G) { scan_unit(lds, RWC, YF, YB, SG, SB, sw, u >> 4, (u >> 1) & 7, u & 1, C2, cvw, cvb, u); __syncthreads(); }
#endif
            for (int u = vcu; u < 256; u += G) { scan_unit(lds, RWC, YF, YB, SG, SB, sw, u >> 4, (u >> 1) & 7, u & 1, C2, cvw, cvb, u); __syncthreads(); }
#endif
#ifndef SKIP_ATTN
#ifdef MK_DUP_ATTN
            for (int u = vcu; u < 1024; u += G) { attn_unit(lds, C2, (bf16_t*)(ws + 892 * MiB), u >> 6, (u >> 5) & 1, u & 31); }
#endif
            for (int u = vcu; u < 1024; u += G) { attn_unit(lds, C2, nullptr, u >> 6, (u >> 5) & 1, u & 31); }
#endif
        }
        xcd_barrier(xbar);
        DBG_STOP(3);
        if (PHMASK & (1u << 3)) {
            PHASE_IDS();
            const float* mup = p.in[3] + (size_t)l * RW_COLS + 1024; const float* mun = p.in[4] + (size_t)l * RW_COLS + 1024;
            const float* lng = p.in[13] + (size_t)l * 512; const float* lnb = p.in[14] + (size_t)l * 512;
            for (int m = gw; m < T; m += NGW) {
                const int t = m & 4095, c0 = 8 * lane, hh = lane >> 3;
                float yf[8], yb[8], vc[8], vpv[8], vn[8], y[8];
                unpack8(*(const u32x4*)(YF + (size_t)m * 512 + c0), yf); unpack8(*(const u32x4*)(YB + (size_t)m * 512 + c0), yb);
                const bf16_t* rp = RWC + (size_t)m * LD_RWC + 1024 + c0;
                unpack8(*(const u32x4*)rp, vc);
                if (t > 0) unpack8(*(const u32x4*)(rp - LD_RWC), vpv); else {
#pragma unroll
                    for (int j = 0; j < 8; ++j) vpv[j] = 0.f; }
                if (t < SEQ - 1) unpack8(*(const u32x4*)(rp + LD_RWC), vn); else {
#pragma unroll
                    for (int j = 0; j < 8; ++j) vn[j] = 0.f; }
                float s = 0.f;
#pragma unroll
                for (int j = 0; j < 8; ++j) { y[j] = yf[j] + yb[j]; s += y[j]; }
                const float mean = red8(s) * (1.f / 64.f);
                float q = 0.f;
#pragma unroll
                for (int j = 0; j < 8; ++j) { y[j] -= mean; q += y[j] * y[j]; }
                const float rstd = __builtin_amdgcn_rsqf(red8(q) * (1.f / 64.f) + 64e-5f);
                const float bs = 0.5f * (SB[(size_t)m * 8 + hh] + SB[((size_t)T + m) * 8 + hh]);
                float o[8];
#pragma unroll
                for (int j = 0; j < 8; ++j) { const float zv = vc[j] + mup[c0 + j] * (vpv[j] - vc[j]) + mun[c0 + j] * (vn[j] - vc[j]);
                    o[j] = y[j] * rstd * lng[c0 + j] + lnb[c0 + j] + bs * zv; }
                *(u32x4*)(YF + (size_t)m * 512 + c0) = pack8(o);
            }
        }
        xcd_barrier(xbar);
        DBG_STOP(4);
        if (PHMASK & (1u << 4)) {
            pg8::StaticOrder S; pg8::Gemm g{SG, g2t, T, 512, 256, 256}; S.init(T, 512, G, bx);
            pg8::EpiMulInPlace E{YF, 512}; pg8::gemm_phase(lds, g, S, E);
        }
        xcd_barrier(xbar);
        DBG_STOP(5);
        if (PHMASK & (1u << 5)) {
            pg8::StaticOrder S; S.init(T, 1024, G, bx);
            const bf16_t* Wg = Win_t + (size_t)4352 * D_MODEL;
            if (P4_CALLS >= 1)
            { pg8::Gemm g{Hb, Wg, T, 1024, D_MODEL, D_MODEL}; pg8::EpiStore<MK_GATE_ACT> E{Gt, D_MODEL, Gt, D_MODEL, 1 << 20}; pg8::gemm_phase(lds, g, S, E); }
            L1_REFRESH();
            if (P4_CALLS >= 2)
            { pg8::Gemm g{YF, Wbr_t, T, 1024, 512, 512}; pg8::EpiBranch<true> E{Gt, Mg}; pg8::gemm_phase(lds, g, S, E); }
            if (P4_CALLS >= 3)
            { pg8::Gemm g{Hb, Wg + (size_t)1024 * D_MODEL, T, 1024, D_MODEL, D_MODEL}; pg8::EpiStore<1> E{Gt, D_MODEL, Gt, D_MODEL, 1 << 20}; pg8::gemm_phase(lds, g, S, E); }
            L1_REFRESH();
            if (P4_CALLS >= 4)
            { pg8::Gemm g{C2, Wbr_t + (size_t)1024 * 512, T, 1024, 512, LD_C2}; pg8::EpiBranch<false> E{Gt, Mg}; pg8::gemm_phase(lds, g, S, E); }
            if (P4_CALLS >= 5)
            { pg8::Gemm g{Hb, Wg + (size_t)2048 * D_MODEL, T, 1024, D_MODEL, D_MODEL}; pg8::EpiStore<1> E{Gt, D_MODEL, Gt, D_MODEL, 1 << 20}; pg8::gemm_phase(lds, g, S, E); }
            L1_REFRESH();
            if (P4_CALLS >= 6)
            { pg8::Gemm g{C2 + 1536, Wbr_t + (size_t)2048 * 512, T, 1024, 512, LD_C2}; pg8::EpiBranch<false> E{Gt, Mg}; pg8::gemm_phase(lds, g, S, E); }
        }
        xcd_barrier(xbar);
        DBG_STOP(6);
        if (PHMASK & (1u << 6)) {
            pg8::StaticOrder S; S.init(T, 1024, G, bx);
            pg8::Gemm g{Mg, Wout_t, T, 1024, D_MODEL, D_MODEL}; pg8::EpiResidual E{xin, X}; pg8::gemm_phase(lds, g, S, E);
        }
        xcd_barrier(xbar);
        DBG_STOP(7);
        if (PHMASK & (1u << 7)) {
            PHASE_IDS();
            const float* g2 = p.in[21] + (size_t)l * D_MODEL;
            if (T % (2 * NGW) == 0) { for (int m = gw; m < T; m += 2 * NGW) rms_row2(X + (size_t)m * D_MODEL, X + (size_t)(m + NGW) * D_MODEL, g2, Hb + (size_t)m * D_MODEL, Hb + (size_t)(m + NGW) * D_MODEL, lane); }
            else { for (int m = gw; m < T; m += NGW) rms_row(X + (size_t)m * D_MODEL, g2, Hb + (size_t)m * D_MODEL, lane); }
        }
        xcd_barrier(xbar);
        DBG_STOP(8);
        if (PHMASK & (1u << 8)) {
            pg8::StaticOrder S; S.init(T, D_FF, G, bx);
            pg8::Gemm g{Hb, W1_t, T, D_FF, D_MODEL, D_MODEL}; pg8::EpiStore<2> E{Ub, D_FF, Ub, D_FF, 1 << 20}; pg8::gemm_phase(lds, g, S, E);
#ifdef MK_DUP_P7
            pg8::gemm_phase(lds, g, S, E);
#endif
        }
        xcd_barrier(xbar);
        DBG_STOP(9);
        if (PHMASK & (1u << 9)) {
            pg8::StaticOrder S; S.init(T, 1024, G, bx);
            pg8::Gemm g{Ub, W2_t, T, 1024, D_FF, D_FF}; pg8::EpiResidual E{X, X}; pg8::gemm_phase(lds, g, S, E);
        }
        xcd_barrier(xbar);
        DBG_STOP(10);
    }
}

extern "C" void kernel_launch(void* const* d_in, const int* in_sizes, int n_in, void* d_out, int out_size, void* d_ws, size_t ws_size, hipStream_t stream) {
    static int grid = 0;
    if (grid == 0) {
        if (n_in != 24 || out_size != T * D_MODEL || ws_size < WS_END) { fprintf(stderr, "kernel_launch: unexpected shapes (n_in %d out %d ws %zu)\n", n_in, out_size, ws_size); grid = -1; return; }
        int dev = 0, cus = 0, per_cu = 0;
        hipGetDevice(&dev);
        hipDeviceGetAttribute(&cus, hipDeviceAttributeMultiprocessorCount, dev);
        hipFuncSetAttribute((const void*)fwd_megakernel, hipFuncAttributeMaxDynamicSharedMemorySize, LDS_BYTES);
        hipOccupancyMaxActiveBlocksPerMultiprocessor(&per_cu, (const void*)fwd_megakernel, 512, LDS_BYTES);
        if (per_cu < 1) { fprintf(stderr, "kernel_launch: occupancy query says %d blocks per CU\n", per_cu); per_cu = 1; }
        (void)hipGetLastError();
        grid = cus;
    }
    if (grid < 0) return;
    if (hipMemsetAsync(d_ws, 0, 1u << 20, stream) != hipSuccess) { fprintf(stderr, "kernel_launch: memset failed\n"); return; }
    Params p{};
    for (int i = 0; i < 24; ++i) p.in[i] = (const float*)d_in[i];
    p.out = (float*)d_out; p.ws = (unsigned char*)d_ws;
    void* args[] = {&p};
    hipError_t e = hipLaunchCooperativeKernel((const void*)fwd_megakernel, dim3(grid), dim3(512), args, LDS_BYTES, stream);
    if (e != hipSuccess) fprintf(stderr, "cooperative launch failed: %s (grid %d)\n", hipGetErrorString(e), grid);
}
```

```cpp
#include <hip/hip_runtime.h>
#include <hip/hip_cooperative_groups.h>
#include <cstdio>
#include <cstdint>
namespace cg = cooperative_groups;

#define LAS __attribute__((address_space(3)))
#define GAS __attribute__((address_space(1)))
typedef unsigned short bf16_t;
typedef short bf16x8 __attribute__((ext_vector_type(8)));
typedef short bf16x4 __attribute__((ext_vector_type(4)));
typedef float f32x2 __attribute__((ext_vector_type(2)));
typedef float f32x4 __attribute__((ext_vector_type(4)));
typedef float f32x16 __attribute__((ext_vector_type(16)));
typedef unsigned u32x2 __attribute__((ext_vector_type(2)));
typedef unsigned u32x4 __attribute__((ext_vector_type(4)));

constexpr int D_MODEL = 1024, BATCH = 16, SEQ = 4096, DEPTH = 4, D_FF = 4096;
constexpr int T = BATCH * SEQ;
constexpr int IN_COLS = 7296, RW_COLS = 1920;
constexpr int NWIN = 7424;
constexpr int LD_RWC = 2048, LD_C2 = 2304;
constexpr float LOG2E = 1.4426950408889634f;

constexpr size_t MiB = 1u << 20;
constexpr size_t WS_WIN = 2 * MiB, WS_WBR = 17 * MiB, WS_WOUT = 20 * MiB, WS_W1 = 22 * MiB, WS_W2 = 30 * MiB;
constexpr size_t WS_W2T = 38 * MiB, WS_A2T = 38 * MiB + 131072, WS_G2T = 38 * MiB + 262144;
constexpr size_t WS_H = 40 * MiB, WS_RWC = 168 * MiB, WS_C2 = 424 * MiB, WS_YF = 712 * MiB, WS_YB = 776 * MiB;
constexpr size_t WS_SG = 840 * MiB, WS_VT = 872 * MiB, WS_SB = 888 * MiB, WS_END = 892 * MiB;
#ifdef MK_GT_FRESH
constexpr size_t WS_GT = 892 * MiB;
#else
constexpr size_t WS_GT = WS_RWC;
#endif
constexpr size_t WS_MRG = WS_RWC + 128 * MiB, WS_U = WS_RWC;

#ifndef MK_GATE_ACT
#define MK_GATE_ACT 1
#endif
#ifndef MK_P4_CALLS
#define MK_P4_CALLS 6
#endif
constexpr int P4_CALLS = MK_P4_CALLS;
#ifndef MK_PHMASK
#define MK_PHMASK 0xffffffffu
#endif
constexpr unsigned PHMASK = MK_PHMASK;
constexpr int LDS_BYTES = 140288;

typedef __bf16 bf16x2_t __attribute__((ext_vector_type(2)));
__device__ __forceinline__ unsigned cvt_pk_bf16(float lo, float hi) { const f32x2 v = {lo, hi}; const bf16x2_t b = __builtin_convertvector(v, bf16x2_t); return __builtin_bit_cast(unsigned, b); }
__device__ __forceinline__ bf16_t f2bf(float f) { return (bf16_t)(cvt_pk_bf16(f, 0.f) & 0xffffu); }
__device__ __forceinline__ float bflo(unsigned u) { return __builtin_bit_cast(float, u << 16); }
__device__ __forceinline__ float bfhi(unsigned u) { return __builtin_bit_cast(float, u & 0xffff0000u); }
__device__ __forceinline__ void unpack8(const u32x4 v, float* f) { f[0] = bflo(v.x); f[1] = bfhi(v.x); f[2] = bflo(v.y); f[3] = bfhi(v.y); f[4] = bflo(v.z); f[5] = bfhi(v.z); f[6] = bflo(v.w); f[7] = bfhi(v.w); }
__device__ __forceinline__ u32x4 pack8(const float* f) { u32x4 w; w.x = cvt_pk_bf16(f[0], f[1]); w.y = cvt_pk_bf16(f[2], f[3]); w.z = cvt_pk_bf16(f[4], f[5]); w.w = cvt_pk_bf16(f[6], f[7]); return w; }
__device__ __forceinline__ float trans_settle(float x) { float r; asm volatile("s_nop 1\n\tv_mov_b32 %0, %1" : "=v"(r) : "v"(x)); return r; }
__device__ __forceinline__ float sigmoid_f(float x) { return __builtin_amdgcn_rcpf(1.f + __builtin_amdgcn_exp2f(-LOG2E * x)); }
__device__ __forceinline__ float tanh_f(float x) { return 1.f - 2.f * __builtin_amdgcn_rcpf(1.f + __builtin_amdgcn_exp2f(2.f * LOG2E * x)); }
__device__ __forceinline__ float wave_sum(float v) {
#pragma unroll
    for (int o = 1; o < 64; o <<= 1) v += __shfl_xor(v, o);
    return v;
}
template <int CTRL> __device__ __forceinline__ float dpp_f(float x) { return __builtin_bit_cast(float, __builtin_amdgcn_update_dpp(0, __builtin_bit_cast(int, x), CTRL, 0xf, 0xf, true)); }
__device__ __forceinline__ float red8(float x) { x += dpp_f<0xB1>(x); x += dpp_f<0x4E>(x); x += dpp_f<0x141>(x); return x; }
__device__ __forceinline__ float red8_nopack(float x) { x += dpp_f<0xB1>(x); asm volatile("" : "+v"(x)); x += dpp_f<0x4E>(x); asm volatile("" : "+v"(x)); x += dpp_f<0x141>(x); asm volatile("" : "+v"(x)); return x; }
__device__ __forceinline__ float red16(float x) { x = red8(x); x += dpp_f<0x140>(x); return x; }

namespace pg8 {
constexpr int BM = 256, BK = 64, HALF = 128, HTB = HALF * BK * 2, STAGE_BYTES = 8 * HTB, NXCD = 8, WGM = 8;
__host__ __device__ __forceinline__ int lds_byte(int r, int c) { const int st = (r >> 4) * 2 + (c >> 5), rr = r & 15, cc = c & 31, ob = rr * 64 + cc * 2; return st * 1024 + (ob ^ (((ob >> 9) & 1) << 5)); }
__host__ __device__ __forceinline__ void stage_rc(int b, int& R, int& C) { const int st = b / 1024, sb = b % 1024, swz = sb ^ (((sb >> 9) & 1) << 5); R = (st >> 1) * 16 + swz / 64; C = (st & 1) * 32 + (swz % 64) / 2; }
__host__ __device__ __forceinline__ int perm32(int rho) { const int n = rho >> 4, i = rho & 15; return 8 * (i >> 2) + 4 * n + (i & 3); }

struct Unit { int pm, pn; };
struct Gemm { const bf16_t* A; const bf16_t* Bt; int M, N, K, lda; };

struct StaticOrder {
    int nM, nN, nwg, G, c;
    __device__ void init(int M, int N, int G_, int c_) { nM = M / BM; nN = N / BM; nwg = nM * nN; G = G_; c = c_; }
    __device__ bool next(int i, Unit& u) const {
        const long L = (long)i * G + c; if (L >= nwg) return false;
        int wgid = (int)L; { const int q = nwg / NXCD, r = nwg % NXCD, xcd = wgid % NXCD, off = wgid / NXCD; wgid = (xcd < r ? xcd * (q + 1) : r * (q + 1) + (xcd - r) * q) + off; }
        const int nig = WGM * nN, gid = wgid / nig, fm = gid * WGM, gsz = (nM - fm) < WGM ? (nM - fm) : WGM;
        u.pm = fm + ((wgid % nig) % gsz); u.pn = (wgid % nig) / gsz; return true;
    }
};

template <class Epi>
__device__ __forceinline__ void gemm_phase(LAS unsigned char* lds, const Gemm g, const StaticOrder& S, const Epi& E) {
    int tid = threadIdx.x; asm volatile("" : "+v"(tid));
    const int wid = __builtin_amdgcn_readfirstlane(tid >> 6), lane = tid & 63, wr = wid >> 2, wc = wid & 3, fr = lane & 15, fq = lane >> 4;
    const int K = g.K, nt = K / BK, lda = g.lda;
    unsigned voffA[2], voffB[2];
#pragma unroll
    for (int i = 0; i < 2; ++i) { int R, C; stage_rc(tid * 16 + i * 8192, R, C); const int Rb = Epi::PERM ? ((R & ~31) + perm32(R & 31)) : R;
        voffA[i] = (unsigned)(R * lda + C) * 2u; voffB[i] = (unsigned)(Rb * K + C) * 2u; }
    const size_t kstep = (size_t)(BK * 2);
    const size_t hstepA = (size_t)HALF * lda * 2, hstepB = (size_t)HALF * K * 2;
    const size_t tstepA = 2 * hstepA, tstepB = 2 * hstepB;
    const unsigned ldsw = (unsigned)wid * 1024u;
    const int aoff = lds_byte(wr * 64 + fr, fq * 8), boff = lds_byte(wc * 32 + fr, fq * 8);
#define PG8_SA(b, h) (((b) * 2 + (h)) * HTB)
#define PG8_SB(b, h) ((4 + (b) * 2 + (h)) * HTB)
#define PG8_STAGE(bufoff, gbase, voff) do { _Pragma("unroll") for (int _i = 0; _i < 2; ++_i) \
        __builtin_amdgcn_global_load_lds((const unsigned*)((const char*)(gbase) + (voff)[_i]), (LAS unsigned*)(lds + (bufoff) + ldsw + _i * 8192), 16, 0, 0); } while (0)
#define PG8_LDA(dst, b, h) do { _Pragma("unroll") for (int m = 0; m < 4; ++m) _Pragma("unroll") for (int k = 0; k < 2; ++k) dst[m][k] = *(const LAS bf16x8*)(lds + PG8_SA(b, h) + aoff + m * 2048 + k * 1024); } while (0)
#define PG8_LDB(dst, b, h) do { _Pragma("unroll") for (int n = 0; n < 2; ++n) _Pragma("unroll") for (int k = 0; k < 2; ++k) dst[n][k] = *(const LAS bf16x8*)(lds + PG8_SB(b, h) + boff + n * 2048 + k * 1024); } while (0)
#define PG8_MMA(ai, bj, At, Bt) do { __builtin_amdgcn_s_setprio(1); _Pragma("unroll") for (int m = 0; m < 4; ++m) _Pragma("unroll") for (int n = 0; n < 2; ++n) _Pragma("unroll") for (int k = 0; k < 2; ++k) \
        acc[ai][bj][m][n] = __builtin_amdgcn_mfma_f32_16x16x32_bf16(Bt[n][k], At[m][k], acc[ai][bj][m][n], 0, 0, 0); __builtin_amdgcn_s_setprio(0); } while (0)
#define PG8_WAIT_V(n) asm volatile("s_waitcnt vmcnt(" #n ")" ::: "memory")
#define PG8_WAIT_L(n) asm volatile("s_waitcnt lgkmcnt(" #n ")" ::: "memory")
#define PG8_BAR __builtin_amdgcn_s_barrier()
#define PG8_SCHED __builtin_amdgcn_sched_barrier(0)
    Unit cur, nxt; int ui = 0;
    if (!S.next(0, cur)) return;
    f32x4 acc[2][2][4][2];
#pragma unroll
    for (int a = 0; a < 2; ++a)
#pragma unroll
        for (int b = 0; b < 2; ++b)
#pragma unroll
            for (int m = 0; m < 4; ++m)
#pragma unroll
                for (int n = 0; n < 2; ++n) acc[a][b][m][n] = (f32x4){0.f, 0.f, 0.f, 0.f};
    bf16x8 At[4][2], B0[2][2], B1[2][2];
    const char* cA = (const char*)g.A + (size_t)cur.pm * tstepA; const char* cB = (const char*)g.Bt + (size_t)cur.pn * tstepB;
    PG8_STAGE(PG8_SB(0, 0), cB, voffB); PG8_STAGE(PG8_SB(0, 1), cB + hstepB, voffB); PG8_STAGE(PG8_SA(0, 0), cA, voffA); PG8_STAGE(PG8_SA(0, 1), cA + hstepA, voffA);
    if (wr == 1) PG8_BAR;
    PG8_WAIT_V(2); PG8_BAR;
    PG8_STAGE(PG8_SB(1, 0), cB + kstep, voffB); PG8_STAGE(PG8_SA(1, 0), cA + kstep, voffA); PG8_STAGE(PG8_SB(1, 1), cB + hstepB + kstep, voffB);
    PG8_WAIT_V(6); PG8_BAR;
    for (;;) {
        const bool has_next = S.next(ui + 1, nxt);
        const char* nA = has_next ? (const char*)g.A + (size_t)nxt.pm * tstepA : cA; const char* nB = has_next ? (const char*)g.Bt + (size_t)nxt.pn * tstepB : cB;
#pragma nounroll
        for (int t = 0; t < nt; t += 2) {
            const bool last = (t == nt - 2);
            const char* a1 = cA + (size_t)(t + 1) * kstep;
            const char* a2 = last ? nA : cA + (size_t)(t + 2) * kstep; const char* b2 = last ? nB : cB + (size_t)(t + 2) * kstep;
            const char* a3 = a2 + kstep; const char* b3 = b2 + kstep;
            PG8_LDB(B0, 0, 0); PG8_LDB(B1, 0, 1); PG8_SCHED; PG8_LDA(At, 0, 0); PG8_STAGE(PG8_SA(1, 1), a1 + hstepA, voffA);
            PG8_WAIT_V(8); PG8_WAIT_L(0); PG8_BAR; PG8_MMA(0, 0, At, B0); PG8_MMA(0, 1, At, B1); PG8_BAR; PG8_SCHED;
            PG8_LDA(At, 0, 1); PG8_STAGE(PG8_SB(0, 0), b2, voffB); PG8_STAGE(PG8_SB(0, 1), b2 + hstepB, voffB); PG8_STAGE(PG8_SA(0, 0), a2, voffA);
            PG8_WAIT_V(8); PG8_WAIT_L(0); PG8_BAR; PG8_MMA(1, 0, At, B0); PG8_MMA(1, 1, At, B1); PG8_BAR; PG8_SCHED;
            PG8_LDB(B0, 1, 0); PG8_LDB(B1, 1, 1); PG8_SCHED; PG8_LDA(At, 1, 0); PG8_STAGE(PG8_SA(0, 1), a2 + hstepA, voffA);
            PG8_WAIT_V(8); PG8_WAIT_L(0); PG8_BAR; PG8_MMA(0, 0, At, B0); PG8_MMA(0, 1, At, B1); PG8_BAR; PG8_SCHED;
            PG8_LDA(At, 1, 1); PG8_STAGE(PG8_SB(1, 0), b3, voffB); PG8_STAGE(PG8_SB(1, 1), b3 + hstepB, voffB); PG8_STAGE(PG8_SA(1, 0), a3, voffA);
            PG8_WAIT_V(8); PG8_WAIT_L(0); PG8_BAR; PG8_MMA(1, 0, At, B0); PG8_MMA(1, 1, At, B1); PG8_BAR; PG8_SCHED;
        }
        if (wr == 0) PG8_BAR;
        E(acc, cur, wr, wc, fr, fq);
        if (!has_next) break;
#pragma unroll
        for (int a = 0; a < 2; ++a)
#pragma unroll
            for (int b = 0; b < 2; ++b)
#pragma unroll
                for (int m = 0; m < 4; ++m)
#pragma unroll
                    for (int n = 0; n < 2; ++n) acc[a][b][m][n] = (f32x4){0.f, 0.f, 0.f, 0.f};
        cur = nxt; cA = nA; cB = nB; ++ui;
        if (wr == 1) PG8_BAR;
    }
    PG8_WAIT_V(0);
    PG8_BAR;
#undef PG8_SA
#undef PG8_SB
#undef PG8_STAGE
#undef PG8_LDA
#undef PG8_LDB
#undef PG8_MMA
#undef PG8_WAIT_V
#undef PG8_WAIT_L
#undef PG8_BAR
#undef PG8_SCHED
}

#define EPI_FENCE() do { asm volatile("" ::: "memory"); __builtin_amdgcn_sched_barrier(0); } while (0)
template <int ACT> struct EpiStore {
    static constexpr bool PERM = true;
    bf16_t* O0; int ld0; bf16_t* O1; int ld1; int pn_split;
    __device__ __forceinline__ void operator()(const f32x4 (&acc)[2][2][4][2], const Unit& u, int wr, int wc, int fr, int fq) const {
        bf16_t* base; int ld, colt;
        if (u.pn < pn_split) { base = O0; ld = ld0; colt = u.pn * BM; } else { base = O1; ld = ld1; colt = (u.pn - pn_split) * BM; }
        const int row0 = u.pm * BM + wr * 64 + fr, col0 = colt + wc * 32 + 8 * fq;
#pragma unroll
        for (int ai = 0; ai < 2; ++ai)
#pragma unroll
            for (int m = 0; m < 4; ++m) { bf16_t* rowp = base + (size_t)(row0 + ai * HALF + m * 16) * ld + col0;
#pragma unroll
                for (int bj = 0; bj < 2; ++bj) { float v[8];
#pragma unroll
                    for (int j = 0; j < 4; ++j) { v[j] = acc[ai][bj][m][0][j]; v[4 + j] = acc[ai][bj][m][1][j]; }
#pragma unroll
                    for (int j = 0; j < 8; ++j) { if (ACT == 1) v[j] = sigmoid_f(v[j]); if (ACT == 2) { const float r = fmaxf(v[j], 0.f); v[j] = r * r; } }
                    *(u32x4*)(rowp + bj * HALF) = pack8(v); }
                EPI_FENCE(); }
    }
};
struct EpiResidual {
    static constexpr bool PERM = false;
    const float* xin; float* xout;
    __device__ __forceinline__ void operator()(const f32x4 (&acc)[2][2][4][2], const Unit& u, int wr, int wc, int fr, int fq) const {
        const int row0 = u.pm * BM + wr * 64 + fr, col0 = u.pn * BM + wc * 32 + 4 * fq;
#pragma unroll
        for (int ai = 0; ai < 2; ++ai)
#pragma unroll
            for (int m = 0; m < 4; ++m) { const size_t off = (size_t)(row0 + ai * HALF + m * 16) * D_MODEL + col0;
#pragma unroll
                for (int bj = 0; bj < 2; ++bj)
#pragma unroll
                    for (int n = 0; n < 2; ++n) { const f32x4 b = *(const f32x4*)(xin + off + bj * HALF + n * 16); *(f32x4*)(xout + off + bj * HALF + n * 16) = b + acc[ai][bj][m][n]; } }
    }
};
struct EpiMulInPlace {
    static constexpr bool PERM = true;
    bf16_t* Y; int ld;
    __device__ __forceinline__ void operator()(const f32x4 (&acc)[2][2][4][2], const Unit& u, int wr, int wc, int fr, int fq) const {
        const int row0 = u.pm * BM + wr * 64 + fr, col0 = u.pn * BM + wc * 32 + 8 * fq;
#pragma unroll
        for (int ai = 0; ai < 2; ++ai)
#pragma unroll
            for (int m = 0; m < 4; ++m) { bf16_t* rowp = Y + (size_t)(row0 + ai * HALF + m * 16) * ld + col0;
#pragma unroll
                for (int bj = 0; bj < 2; ++bj) { float y[8]; unpack8(*(const u32x4*)(rowp + bj * HALF), y);
#pragma unroll
                    for (int j = 0; j < 4; ++j) { y[j] *= acc[ai][bj][m][0][j]; y[4 + j] *= acc[ai][bj][m][1][j]; }
                    *(u32x4*)(rowp + bj * HALF) = pack8(y); }
                EPI_FENCE(); }
    }
};
template <bool FIRST> struct EpiBranch {
    static constexpr bool PERM = true;
    const bf16_t* Gt; bf16_t* Mg;
    __device__ __forceinline__ void operator()(const f32x4 (&acc)[2][2][4][2], const Unit& u, int wr, int wc, int fr, int fq) const {
        const int row0 = u.pm * BM + wr * 64 + fr, col0 = u.pn * BM + wc * 32 + 8 * fq;
#pragma unroll
        for (int ai = 0; ai < 2; ++ai) {
            u32x4 gq[4][2], mq[4][2];
#pragma unroll
            for (int m = 0; m < 4; ++m) { const size_t off = (size_t)(row0 + ai * HALF + m * 16) * D_MODEL + col0;
#pragma unroll
                for (int bj = 0; bj < 2; ++bj) { gq[m][bj] = *(const u32x4*)(Gt + off + bj * HALF); if (!FIRST) mq[m][bj] = *(const u32x4*)(Mg + off + bj * HALF); } }
#pragma unroll
            for (int m = 0; m < 4; ++m) { const size_t off = (size_t)(row0 + ai * HALF + m * 16) * D_MODEL + col0;
#pragma unroll
                for (int bj = 0; bj < 2; ++bj) { float gt[8], o[8]; unpack8(gq[m][bj], gt);
                    if (FIRST) {
#pragma unroll
                        for (int j = 0; j < 8; ++j) o[j] = 0.f;
                    } else unpack8(mq[m][bj], o);
#pragma unroll
                    for (int j = 0; j < 4; ++j) { o[j] += gt[j] * acc[ai][bj][m][0][j]; o[4 + j] += gt[4 + j] * acc[ai][bj][m][1][j]; }
                    *(u32x4*)(Mg + off + bj * HALF) = pack8(o); } }
            EPI_FENCE(); }
    }
};
struct EpiAttn {
    static constexpr bool PERM = false;
    bf16_t* C2; bf16_t* VT; const float* qg; const float* kg;
    __device__ __forceinline__ void operator()(const f32x4 (&acc)[2][2][4][2], const Unit& u, int wr, int wc, int fr, int fq) const {
        if (u.pn == 2 && wc >= 2) {
#pragma unroll
            for (int ai = 0; ai < 2; ++ai)
#pragma unroll
                for (int m = 0; m < 4; ++m) { const int row = u.pm * BM + ai * HALF + wr * 64 + m * 16 + fr;
                    bf16_t* rowp = C2 + (size_t)row * LD_C2 + 2048 + wc * 64 + 4 * fq;
#pragma unroll
                    for (int bj = 0; bj < 2; ++bj)
#pragma unroll
                        for (int n = 0; n < 2; ++n) { const f32x4 x = acc[ai][bj][m][n]; u32x2 w; w.x = cvt_pk_bf16(x[0], x[1]); w.y = cvt_pk_bf16(x[2], x[3]); *(u32x2*)(rowp + 32 * bj + 16 * n) = w; }
                    EPI_FENCE(); }
        } else {
            const bool isK = (u.pn == 2);
            int opq = 0; asm volatile("" : "+v"(opq));
            fq += opq; fr += opq;
            const float* gp = isK ? kg : qg;
            const int colbase = isK ? (2048 + wc * 64) : (1536 + (u.pn * 4 + wc) * 64);
            const float sc = isK ? 1.f : 0.125f * LOG2E;
            float gv[2][2][4], invf[4];
#pragma unroll
            for (int bj = 0; bj < 2; ++bj)
#pragma unroll
                for (int n = 0; n < 2; ++n)
#pragma unroll
                    for (int j = 0; j < 4; ++j) gv[bj][n][j] = gp[32 * bj + 16 * n + 4 * fq + j] * sc;
#pragma unroll
            for (int j = 0; j < 4; ++j) invf[j] = __builtin_amdgcn_exp2f(-(float)(4 * fq + j) * (13.287712379549449f / 16.f));
#pragma unroll
            for (int ai = 0; ai < 2; ++ai)
#pragma unroll
                for (int m = 0; m < 4; ++m) { const int row = u.pm * BM + ai * HALF + wr * 64 + m * 16 + fr; const int t = row & 4095;
                    float ss = 0.f;
#pragma unroll
                    for (int bj = 0; bj < 2; ++bj)
#pragma unroll
                        for (int n = 0; n < 2; ++n) { const f32x4 x = acc[ai][bj][m][n]; ss += (x[0] * x[0] + x[1] * x[1]) + (x[2] * x[2] + x[3] * x[3]); }
                    ss += __shfl_xor(ss, 16); ss += __shfl_xor(ss, 32);
                    const float rinv = __builtin_amdgcn_rsqf(ss * (1.f / 64.f) + 1e-6f);
                    bf16_t* rowp = C2 + (size_t)row * LD_C2 + colbase + 4 * fq;
#pragma unroll
                    for (int bj = 0; bj < 2; ++bj) { const float pos = (float)(bj ? (t & 63) : (t >> 6)); float o1[4], o2[4];
#pragma unroll
                        for (int j = 0; j < 4; ++j) { const float ang = pos * invf[j], c = __cosf(ang), s = __sinf(ang);
                            const float x1 = acc[ai][bj][m][0][j] * rinv * gv[bj][0][j], x2 = acc[ai][bj][m][1][j] * rinv * gv[bj][1][j];
                            o1[j] = x1 * c - x2 * s; o2[j] = x2 * c + x1 * s; }
                        u32x2 w1, w2; w1.x = cvt_pk_bf16(o1[0], o1[1]); w1.y = cvt_pk_bf16(o1[2], o1[3]); w2.x = cvt_pk_bf16(o2[0], o2[1]); w2.y = cvt_pk_bf16(o2[2], o2[3]);
                        *(u32x2*)(rowp + 32 * bj) = w1; *(u32x2*)(rowp + 32 * bj + 16) = w2; }
                    EPI_FENCE(); }
        }
    }
};
}

struct Params { const float* in[24]; float* out; unsigned char* ws; };

__device__ __forceinline__ void transpose_item(const float* W, int ldw, int k0, int n_src, bf16_t* WT, int ldt, int dst_row0, LAS float* scr, int lane) {
#pragma unroll 8
    for (int i = 0; i < 32; ++i) { const int kk = 2 * i + (lane >> 5); scr[kk * 33 + (lane & 31)] = W[(size_t)(k0 + kk) * ldw + n_src + (lane & 31)]; }
    asm volatile("s_waitcnt lgkmcnt(0)" ::: "memory");
    const int c = lane & 7;
#pragma unroll
    for (int j = 0; j < 4; ++j) { const int n = (lane >> 3) + 8 * j; const LAS float* s = scr + (8 * c) * 33 + n;
        u32x4 o; o.x = cvt_pk_bf16(s[0 * 33], s[1 * 33]); o.y = cvt_pk_bf16(s[2 * 33], s[3 * 33]); o.z = cvt_pk_bf16(s[4 * 33], s[5 * 33]); o.w = cvt_pk_bf16(s[6 * 33], s[7 * 33]);
        *(u32x4*)(WT + (size_t)(dst_row0 + n) * ldt + k0 + 8 * c) = o; }
    asm volatile("s_waitcnt lgkmcnt(0)" ::: "memory");
}
__device__ __forceinline__ void rms_row2(const float* xrow0, const float* xrow1, const float* g, bf16_t* orow0, bf16_t* orow1, int lane) {
    const f32x4* xr0 = (const f32x4*)xrow0 + lane; const f32x4* xr1 = (const f32x4*)xrow1 + lane; const f32x4* gr = (const f32x4*)g + lane;
    f32x4 v0[4], v1[4]; float s0 = 0.f, s1 = 0.f;
#pragma unroll
    for (int j = 0; j < 4; ++j) { v0[j] = xr0[64 * j]; v1[j] = xr1[64 * j]; }
#pragma unroll
    for (int j = 0; j < 4; ++j) { s0 += (v0[j].x * v0[j].x + v0[j].y * v0[j].y) + (v0[j].z * v0[j].z + v0[j].w * v0[j].w); s1 += (v1[j].x * v1[j].x + v1[j].y * v1[j].y) + (v1[j].z * v1[j].z + v1[j].w * v1[j].w); }
    const float inv0 = __builtin_amdgcn_rsqf(wave_sum(s0) * (1.f / D_MODEL) + 1e-6f), inv1 = __builtin_amdgcn_rsqf(wave_sum(s1) * (1.f / D_MODEL) + 1e-6f);
    u32x2* o0 = (u32x2*)orow0 + lane; u32x2* o1 = (u32x2*)orow1 + lane;
#pragma unroll
    for (int j = 0; j < 4; ++j) { const f32x4 gg = gr[64 * j]; u32x2 w;
        w.x = cvt_pk_bf16(v0[j].x * inv0 * gg.x, v0[j].y * inv0 * gg.y); w.y = cvt_pk_bf16(v0[j].z * inv0 * gg.z, v0[j].w * inv0 * gg.w); o0[64 * j] = w;
        w.x = cvt_pk_bf16(v1[j].x * inv1 * gg.x, v1[j].y * inv1 * gg.y); w.y = cvt_pk_bf16(v1[j].z * inv1 * gg.z, v1[j].w * inv1 * gg.w); o1[64 * j] = w; }
}
__device__ __forceinline__ void rms_row(const float* xrow, const float* g, bf16_t* orow, int lane) {
    const f32x4* xr = (const f32x4*)xrow + lane; const f32x4* gr = (const f32x4*)g + lane;
    f32x4 v[4]; float s = 0.f;
#pragma unroll
    for (int j = 0; j < 4; ++j) { v[j] = xr[64 * j]; s += (v[j].x * v[j].x + v[j].y * v[j].y) + (v[j].z * v[j].z + v[j].w * v[j].w); }
    const float inv = __builtin_amdgcn_rsqf(wave_sum(s) * (1.f / D_MODEL) + 1e-6f);
    u32x2* o8 = (u32x2*)orow + lane;
#pragma unroll
    for (int j = 0; j < 4; ++j) { const f32x4 gg = gr[64 * j]; u32x2 w; w.x = cvt_pk_bf16(v[j].x * inv * gg.x, v[j].y * inv * gg.y); w.y = cvt_pk_bf16(v[j].z * inv * gg.z, v[j].w * inv * gg.w); o8[64 * j] = w; }
}

constexpr int AT_KSTR = 72, AT_VSTR = 68;
constexpr int AT_KBYTES = 64 * AT_KSTR * 2, AT_VBYTES = 64 * AT_VSTR * 2;
__device__ __forceinline__ void vt_write(LAS unsigned char* p, const u32x4 v) {
    *(LAS unsigned short*)(p + 0 * (AT_VSTR * 2)) = (unsigned short)(v.x & 0xffffu); *(LAS unsigned short*)(p + 1 * (AT_VSTR * 2)) = (unsigned short)(v.x >> 16);
    *(LAS unsigned short*)(p + 2 * (AT_VSTR * 2)) = (unsigned short)(v.y & 0xffffu); *(LAS unsigned short*)(p + 3 * (AT_VSTR * 2)) = (unsigned short)(v.y >> 16);
    *(LAS unsigned short*)(p + 4 * (AT_VSTR * 2)) = (unsigned short)(v.z & 0xffffu); *(LAS unsigned short*)(p + 5 * (AT_VSTR * 2)) = (unsigned short)(v.z >> 16);
    *(LAS unsigned short*)(p + 6 * (AT_VSTR * 2)) = (unsigned short)(v.w & 0xffffu); *(LAS unsigned short*)(p + 7 * (AT_VSTR * 2)) = (unsigned short)(v.w >> 16);
}
__device__ __forceinline__ void attn_tile(LAS unsigned char* lds, int cur, int r32, int hi, const bf16x8 (&qf)[4], float& mref, float& lrun, f32x16& o0, f32x16& o1) {
        const LAS unsigned char* kb = lds + cur * AT_KBYTES + r32 * (AT_KSTR * 2) + hi * 16;
        f32x16 p0, p1;
        { const float nm = -mref;
#pragma unroll
          for (int r = 0; r < 16; ++r) { p0[r] = nm; p1[r] = nm; } }
#pragma unroll
        for (int d0 = 0; d0 < 4; ++d0) {
            const bf16x8 a0 = *(const LAS bf16x8*)(kb + d0 * 32), a1 = *(const LAS bf16x8*)(kb + 32 * (AT_KSTR * 2) + d0 * 32);
            p0 = __builtin_amdgcn_mfma_f32_32x32x16_bf16(a0, qf[d0], p0, 0, 0, 0);
            p1 = __builtin_amdgcn_mfma_f32_32x32x16_bf16(a1, qf[d0], p1, 0, 0, 0);
        }
        float mx = __builtin_fmaxf(__builtin_fmaxf(p0[0], p1[0]), p0[1]);
        mx = __builtin_fmaxf(__builtin_fmaxf(mx, p1[1]), p0[2]);
#pragma unroll
        for (int r = 2; r < 14; r += 2) { mx = __builtin_fmaxf(__builtin_fmaxf(mx, p1[r]), p0[r + 1]); mx = __builtin_fmaxf(__builtin_fmaxf(mx, p1[r + 1]), p0[r + 2]); }
        mx = __builtin_fmaxf(__builtin_fmaxf(mx, p1[14]), p0[15]); mx = __builtin_fmaxf(mx, p1[15]);
        mx = __builtin_fmaxf(mx, __shfl_xor(mx, 32));
        if (__builtin_expect(__any(mx > 8.0f), 0)) {
            const float dl = __builtin_fmaxf(mx, 0.f), f = __builtin_amdgcn_exp2f(-dl);
            mref += dl; lrun *= f;
#pragma unroll
            for (int r = 0; r < 16; ++r) { p0[r] -= dl; p1[r] -= dl; o0[r] *= f; o1[r] *= f; }
        }
        f32x2 ls2 = {0.f, 0.f};
#pragma unroll
        for (int r = 0; r < 16; r += 2) {
            p0[r] = __builtin_amdgcn_exp2f(p0[r]); p0[r + 1] = __builtin_amdgcn_exp2f(p0[r + 1]); p1[r] = __builtin_amdgcn_exp2f(p1[r]); p1[r + 1] = __builtin_amdgcn_exp2f(p1[r + 1]);
            ls2 += (f32x2){p0[r], p0[r + 1]}; ls2 += (f32x2){p1[r], p1[r + 1]};
        }
        lrun += ls2.x + ls2.y;
        bf16x8 pf[4];
        { u32x4 w;
          w.x = cvt_pk_bf16(p0[0], p0[1]); w.y = cvt_pk_bf16(p0[2], p0[3]); w.z = cvt_pk_bf16(p0[4], p0[5]); w.w = cvt_pk_bf16(p0[6], p0[7]); pf[0] = __builtin_bit_cast(bf16x8, w);
          w.x = cvt_pk_bf16(p0[8], p0[9]); w.y = cvt_pk_bf16(p0[10], p0[11]); w.z = cvt_pk_bf16(p0[12], p0[13]); w.w = cvt_pk_bf16(p0[14], p0[15]); pf[1] = __builtin_bit_cast(bf16x8, w);
          w.x = cvt_pk_bf16(p1[0], p1[1]); w.y = cvt_pk_bf16(p1[2], p1[3]); w.z = cvt_pk_bf16(p1[4], p1[5]); w.w = cvt_pk_bf16(p1[6], p1[7]); pf[2] = __builtin_bit_cast(bf16x8, w);
          w.x = cvt_pk_bf16(p1[8], p1[9]); w.y = cvt_pk_bf16(p1[10], p1[11]); w.z = cvt_pk_bf16(p1[12], p1[13]); w.w = cvt_pk_bf16(p1[14], p1[15]); pf[3] = __builtin_bit_cast(bf16x8, w); }
        const LAS unsigned char* vb = lds + 2 * AT_KBYTES + cur * AT_VBYTES + r32 * (AT_VSTR * 2) + hi * 8;
#pragma unroll
        for (int s = 0; s < 4; ++s) {
            const int koff = ((s >> 1) * 32 + (s & 1) * 16) * 2;
            const u32x2 l0 = *(const LAS u32x2*)(vb + koff), h0 = *(const LAS u32x2*)(vb + koff + 16);
            const u32x2 l1 = *(const LAS u32x2*)(vb + 32 * (AT_VSTR * 2) + koff), h1 = *(const LAS u32x2*)(vb + 32 * (AT_VSTR * 2) + koff + 16);
            const bf16x8 a0 = __builtin_bit_cast(bf16x8, (u32x4){l0.x, l0.y, h0.x, h0.y}), a1 = __builtin_bit_cast(bf16x8, (u32x4){l1.x, l1.y, h1.x, h1.y});
            o0 = __builtin_amdgcn_mfma_f32_32x32x16_bf16(a0, pf[s], o0, 0, 0, 0);
            o1 = __builtin_amdgcn_mfma_f32_32x32x16_bf16(a1, pf[s], o1, 0, 0, 0);
        }
}
__device__ __forceinline__ void attn_unit(LAS unsigned char* lds, bf16_t* C2, bf16_t* Odummy, int b, int kvh, int qb) {
    int tid = threadIdx.x; asm volatile("" : "+v"(tid));
    const int lane = tid & 63, r32 = lane & 31, hi = lane >> 5, wid = __builtin_amdgcn_readfirstlane(tid >> 6);
    const int g = wid & 3, th = wid >> 2, head = kvh * 4 + g;
    const size_t rowbase = (size_t)b * SEQ;
    const int tok0 = qb * 128 + th * 64;
    bf16_t* qrowA = C2 + (rowbase + tok0 + r32) * LD_C2 + 1536 + head * 64;
    bf16_t* qrowB = qrowA + (size_t)32 * LD_C2;
    bf16x8 qfA[4], qfB[4];
#pragma unroll
    for (int d0 = 0; d0 < 4; ++d0) { qfA[d0] = *(const bf16x8*)(qrowA + d0 * 16 + hi * 8); qfB[d0] = *(const bf16x8*)(qrowB + d0 * 16 + hi * 8); }
    const int srow = tid >> 3, sch = tid & 7;
    const bf16_t* ksrc = C2 + (rowbase + srow) * LD_C2 + 2048 + kvh * 64 + sch * 8;
    const bf16_t* vsrc = ksrc + 128;
    LAS unsigned char* kdst = lds + srow * (AT_KSTR * 2) + sch * 16;
    LAS unsigned char* vdst = lds + 2 * AT_KBYTES + (8 * sch) * (AT_VSTR * 2) + srow * 2;
    u32x4 kregA = *(const u32x4*)ksrc, vregA = *(const u32x4*)vsrc, kregB, vregB;
    *(LAS u32x4*)kdst = kregA; vt_write(vdst, vregA);
    kregA = *(const u32x4*)(ksrc + (size_t)64 * LD_C2); vregA = *(const u32x4*)(vsrc + (size_t)64 * LD_C2);
    __syncthreads();
    f32x16 oA0 = {}, oA1 = {}, oB0 = {}, oB1 = {};
    float mrefA = 0.f, lrunA = 0.f, mrefB = 0.f, lrunB = 0.f;
#define AT_STEP(kt, cur, KW, VW, KL, VL) { \
        if ((kt) + 2 < SEQ / 64) { KL = *(const u32x4*)(ksrc + (size_t)((kt) + 2) * 64 * LD_C2); VL = *(const u32x4*)(vsrc + (size_t)((kt) + 2) * 64 * LD_C2); } \
        attn_tile(lds, cur, r32, hi, qfA, mrefA, lrunA, oA0, oA1); \
        __builtin_amdgcn_sched_barrier(0); \
        attn_tile(lds, cur, r32, hi, qfB, mrefB, lrunB, oB0, oB1); \
        __builtin_amdgcn_sched_barrier(0); \
        if ((kt) + 1 < SEQ / 64) { *(LAS u32x4*)(kdst + ((cur) ^ 1) * AT_KBYTES) = KW; vt_write(vdst + ((cur) ^ 1) * AT_VBYTES, VW); } \
        __syncthreads(); }
    for (int kt = 0; kt < SEQ / 64; kt += 2) {
        AT_STEP(kt, 0, kregA, vregA, kregB, vregB);
        AT_STEP(kt + 1, 1, kregB, vregB, kregA, vregA);
    }
#undef AT_STEP
#pragma unroll
    for (int blk = 0; blk < 2; ++blk) {
        float lr = blk ? lrunB : lrunA; lr += __shfl_xor(lr, 32);
        const float rl = __builtin_amdgcn_rcpf(lr);
        const f32x16& o0 = blk ? oB0 : oA0; const f32x16& o1 = blk ? oB1 : oA1;
        bf16_t* qrow = blk ? qrowB : qrowA;
        bf16_t* orow = Odummy ? Odummy + (rowbase + tok0 + 32 * blk + r32) * 512 + head * 64 : qrow;
#pragma unroll
        for (int g4 = 0; g4 < 4; ++g4) {
            u32x2 w0, w1;
            w0.x = cvt_pk_bf16(o0[4 * g4] * rl, o0[4 * g4 + 1] * rl); w0.y = cvt_pk_bf16(o0[4 * g4 + 2] * rl, o0[4 * g4 + 3] * rl);
            w1.x = cvt_pk_bf16(o1[4 * g4] * rl, o1[4 * g4 + 1] * rl); w1.y = cvt_pk_bf16(o1[4 * g4 + 2] * rl, o1[4 * g4 + 3] * rl);
            *(u32x2*)(orow + 8 * g4 + 4 * hi) = w0; *(u32x2*)(orow + 32 + 8 * g4 + 4 * hi) = w1;
        }
    }
}

__device__ __forceinline__ void conv_item(bf16_t* C2, const float* cvw, const float* cvb, int idx) {
    const int m = idx >> 6, c0 = (idx & 63) * 8, t = m & 4095;
    bf16_t* rp = C2 + (size_t)m * LD_C2 + c0;
    const bf16_t* rpp = (t > 0) ? rp - LD_C2 : rp; const bf16_t* rpn = (t < SEQ - 1) ? rp + LD_C2 : rp;
    const float fp = (t > 0) ? 1.f : 0.f, fn = (t < SEQ - 1) ? 1.f : 0.f;
    float bg[8], c[8], x[8], a[8], bq[8], a2[8], b2[8], o[8];
    unpack8(*(const u32x4*)rp, bg); unpack8(*(const u32x4*)(rp + 512), c); unpack8(*(const u32x4*)(rp + 1024), x);
    unpack8(*(const u32x4*)(rpp + 512), a); unpack8(*(const u32x4*)(rpp + 1024), bq); unpack8(*(const u32x4*)(rpn + 512), a2); unpack8(*(const u32x4*)(rpn + 1024), b2);
#pragma unroll
    for (int j = 0; j < 8; ++j) o[j] = bg[j] * (cvb[c0 + j] + cvw[c0 + j] * (a[j] * bq[j] * fp) + cvw[512 + c0 + j] * (c[j] * x[j]) + cvw[1024 + c0 + j] * (a2[j] * b2[j] * fn));
    *(u32x4*)rp = pack8(o);
}
constexpr int SC_CH = 32;
constexpr int SC_ARR = SC_CH * 64;
constexpr int SC_R = 0, SC_W = 1, SC_KD = 2, SC_V = 3, SC_KK = 4, SC_KKA = 5, SC_ZK = 6, SC_NARR = 7;
constexpr int SC_SLOT = SC_NARR * SC_ARR;
constexpr int SC_BW_OFF = 4096, SC_BA_OFF = 4096 + 9216;
constexpr int SC_TAB = 2 * SC_SLOT;
__device__ __forceinline__ void scan_rv(LAS float* sl, const LAS float* tab, const bf16_t* RWC, int b, int h, int dir, int chunk, int tok, int qq) {
    const int sc = chunk * SC_CH + tok, t = dir ? (SEQ - 1 - sc) : sc;
    const bf16_t* rp = RWC + ((size_t)b * SEQ + t) * LD_RWC;
    const bf16_t* rpp = (t > 0) ? rp - LD_RWC : rp; const bf16_t* rpn = (t < SEQ - 1) ? rp + LD_RWC : rp;
    const float fp = (t > 0) ? 1.f : 0.f, fn = (t < SEQ - 1) ? 1.f : 0.f;
    u32x4 qc[4], qp[4], qn[4];
#pragma unroll
    for (int i = 0; i < 4; ++i) { const int cb = (i >> 1) * 1024 + h * 64 + 16 * qq + 8 * (i & 1);
        qc[i] = *(const u32x4*)(rp + cb); qp[i] = *(const u32x4*)(rpp + cb); qn[i] = *(const u32x4*)(rpn + cb); }
#pragma unroll
    for (int i = 0; i < 4; ++i) { float c[8], p[8], n[8], z[8]; unpack8(qc[i], c); unpack8(qp[i], p); unpack8(qn[i], n);
        const LAS float* mp = tab + (i >> 1) * 128 + 16 * qq + 8 * (i & 1); const LAS float* mn = mp + 320;
#pragma unroll
        for (int j = 0; j < 8; ++j) z[j] = c[j] + mp[j] * (p[j] * fp - c[j]) + mn[j] * (n[j] * fn - c[j]);
        LAS float* dst = sl + ((i >> 1) ? SC_V : SC_R) * SC_ARR + tok * 64 + 16 * qq + 8 * (i & 1);
        *(LAS f32x4*)dst = (f32x4){z[0], z[1], z[2], z[3]}; *(LAS f32x4*)(dst + 4) = (f32x4){z[4], z[5], z[6], z[7]}; }
}
struct ScanW { const float *mu_prev, *mu_next, *w0, *a0, *k_k, *k_a, *r_k; const bf16_t *w2t, *a2t; };

__device__ __forceinline__ void scan_produce(LAS float* sl, LAS float* tab, const bf16_t* RWC, bf16_t* SG, float* SB, const ScanW& sw, const float* mu_gd_p, const float* mu_gd_n,
                                             int b, int h, int dir, int chunk, int sub, int lane) {
    asm volatile("" : "+v"(lane));
    const int tok = lane & 15, q = lane >> 4;
    const int tokidx = 16 * sub + tok;
    const int sc = chunk * SC_CH + tokidx;
    const int t = dir ? (SEQ - 1 - sc) : sc;
    const bf16_t* rp = RWC + ((size_t)b * SEQ + t) * LD_RWC;
    const bool hasp = t > 0, hasn = t < SEQ - 1;
    const bf16_t* rpp = hasp ? rp - LD_RWC : rp;
    const bf16_t* rpn = hasn ? rp + LD_RWC : rp;
    const float fp = hasp ? 1.f : 0.f, fn = hasn ? 1.f : 0.f;
    u32x4 Lc[6], Lp[6], Ln[6];
#pragma unroll
    for (int G = 1; G < 2; ++G)
#pragma unroll
        for (int hf = 0; hf < 2; ++hf) { const int cb = G * 512 + h * 64 + 16 * q + 8 * hf;
            Lc[2 * G + hf] = *(const u32x4*)(rp + cb); Lp[2 * G + hf] = *(const u32x4*)(rpp + cb); Ln[2 * G + hf] = *(const u32x4*)(rpn + cb); }
    u32x4 Mc[5], Mp[5], Mn[5];
#pragma unroll
    for (int i = 0; i < 4; ++i) { const int cb = 1536 + (i >> 1) * 128 + dir * 64 + 32 * (i & 1) + 8 * q;
        Mc[i] = *(const u32x4*)(rp + cb); Mp[i] = *(const u32x4*)(rpp + cb); Mn[i] = *(const u32x4*)(rpn + cb); }
    float zk[16];
#pragma unroll
    for (int G = 1; G < 2; ++G) {
        float z[16];
#pragma unroll
        for (int hf = 0; hf < 2; ++hf) {
            float c[8], p[8], n[8];
            unpack8(Lc[2 * G + hf], c); unpack8(Lp[2 * G + hf], p); unpack8(Ln[2 * G + hf], n);
            const LAS float* mp = tab + G * 64 + 16 * q + 8 * hf; const LAS float* mn = mp + 320;
#pragma unroll
            for (int j = 0; j < 8; ++j) z[8 * hf + j] = c[j] + mp[j] * (p[j] * fp - c[j]) + mn[j] * (n[j] * fn - c[j]);
        }
        LAS float* dst = sl + (G == 0 ? SC_R : (G == 1 ? SC_ZK : SC_V)) * SC_ARR + tokidx * 64 + 16 * q;
#pragma unroll
        for (int j4 = 0; j4 < 4; ++j4) *(LAS f32x4*)(dst + 4 * j4) = (f32x4){z[4 * j4], z[4 * j4 + 1], z[4 * j4 + 2], z[4 * j4 + 3]};
        if (G == 1) {
#pragma unroll
            for (int j = 0; j < 16; ++j) zk[j] = z[j];
        }
    }
    {
        const LAS float* kkt = tab + 640 + 16 * q;
        float kr[16], ss = 0.f;
#pragma unroll
        for (int j = 0; j < 16; ++j) { kr[j] = zk[j] * kkt[j]; ss += kr[j] * kr[j]; }
        ss += __shfl_xor(ss, 16); ss += __shfl_xor(ss, 32);
        const float inv = 1.f / fmaxf(sqrtf(ss), 1e-12f);
        LAS float* dst = sl + SC_KK * SC_ARR + tokidx * 64 + 16 * q;
#pragma unroll
        for (int j4 = 0; j4 < 4; ++j4) *(LAS f32x4*)(dst + 4 * j4) = (f32x4){kr[4 * j4] * inv, kr[4 * j4 + 1] * inv, kr[4 * j4 + 2] * inv, kr[4 * j4 + 3] * inv};
    }
    bf16x8 Awd[2], Aad[2];
#pragma unroll
    for (int i = 0; i < 4; ++i) {
        const int G = 3 + (i >> 1), ks = i & 1;
        float c[8], p[8], n[8], z[8];
        unpack8(Mc[i], c); unpack8(Mp[i], p); unpack8(Mn[i], n);
        const LAS float* mp = tab + G * 64 + 32 * ks + 8 * q; const LAS float* mn = mp + 320;
#pragma unroll
        for (int j = 0; j < 8; ++j) { z[j] = c[j] + mp[j] * (p[j] * fp - c[j]) + mn[j] * (n[j] * fn - c[j]); if (G == 3) z[j] = tanh_f(z[j]); }
        const bf16x8 fr8 = __builtin_bit_cast(bf16x8, pack8(z));
        if (G == 3) Awd[ks] = fr8; else Aad[ks] = fr8;
    }
    asm volatile("s_waitcnt lgkmcnt(0)" ::: "memory");
    f32x4 aw[4], aa[4];
    float w0r[4], a0r[4], kar[4];
#pragma unroll
    for (int nb = 0; nb < 4; ++nb) {
        const int cl = 16 * nb + (lane & 15);
        const LAS unsigned char* wp = (const LAS unsigned char*)tab + SC_BW_OFF + cl * 144 + 16 * (lane >> 4); const LAS unsigned char* ap = wp + (SC_BA_OFF - SC_BW_OFF);
        const bf16x8 bw0 = *(const LAS bf16x8*)wp, bw1 = *(const LAS bf16x8*)(wp + 64), ba0 = *(const LAS bf16x8*)ap, ba1 = *(const LAS bf16x8*)(ap + 64);
        w0r[nb] = tab[720 + cl]; a0r[nb] = tab[784 + cl]; kar[nb] = tab[848 + cl];
        aw[nb] = __builtin_amdgcn_mfma_f32_16x16x32_bf16(Awd[0], bw0, (f32x4){0.f, 0.f, 0.f, 0.f}, 0, 0, 0);
        aw[nb] = __builtin_amdgcn_mfma_f32_16x16x32_bf16(Awd[1], bw1, aw[nb], 0, 0, 0);
        aa[nb] = __builtin_amdgcn_mfma_f32_16x16x32_bf16(Aad[0], ba0, (f32x4){0.f, 0.f, 0.f, 0.f}, 0, 0, 0);
        aa[nb] = __builtin_amdgcn_mfma_f32_16x16x32_bf16(Aad[1], ba1, aa[nb], 0, 0, 0);
    }
#pragma unroll
    for (int nb = 0; nb < 4; ++nb)
#pragma unroll
        for (int rg = 0; rg < 4; ++rg) {
            const int ti = 16 * sub + 4 * q + rg, c = 16 * nb + (lane & 15), o = ti * 64 + c;
            const float dec = trans_settle(__builtin_amdgcn_exp2f(-0.6065306597126334f * LOG2E * sigmoid_f(aw[nb][rg] + w0r[nb])));
            const float a = sigmoid_f(aa[nb][rg] + a0r[nb]);
            const float zkv = sl[SC_ZK * SC_ARR + o], kkv = sl[SC_KK * SC_ARR + o];
            const float kd = zkv * (1.f + (a - 1.f) * kar[nb]);
            sl[SC_W * SC_ARR + o] = dec; sl[SC_KD * SC_ARR + o] = kd; sl[SC_KKA * SC_ARR + o] = kkv * a;
        }
}

__device__ __forceinline__ void scan_unit(LAS unsigned char* lds, const bf16_t* RWC, bf16_t* YF, bf16_t* YB, bf16_t* SG, float* SB, const ScanW& sw, int b, int h, int dir,
                                          bf16_t* C2cv, const float* cvw, const float* cvb, int unit) {
    int tid = threadIdx.x; asm volatile("" : "+v"(tid));
    const int lane = tid & 63, wid = __builtin_amdgcn_readfirstlane(tid >> 6);
    LAS float* fl = (LAS float*)lds;
    LAS float* tab = fl + SC_TAB;
    for (int i = tid; i < 976; i += 512) {
        float v;
        if (i < 640) { const int pn = i / 320, r = i % 320, G = r / 64, ch = r % 64;
            const int col = (G < 3) ? (G * 512 + h * 64 + ch) : (1536 + (G - 3) * 128 + dir * 64 + ch);
            v = (pn ? sw.mu_next : sw.mu_prev)[col]; }
        else if (i < 704) v = sw.k_k[h * 64 + (i - 640)];
        else if (i < 720) { const int j = i - 704; v = ((j >> 3) ? sw.mu_next : sw.mu_prev)[1792 + 8 * (2 * h + dir) + (j & 7)]; }
        else { const int k = i - 720, which = k >> 6, c = k & 63;
            v = which == 0 ? sw.w0[dir * 512 + h * 64 + c] : (which == 1 ? sw.a0[dir * 512 + h * 64 + c] : (which == 2 ? sw.k_a[h * 64 + c] : sw.r_k[h * 64 + c])); }
        tab[i] = v;
    }
    { const int row = tid >> 3, chunk = tid & 7; const size_t src = ((size_t)(dir * 512 + h * 64 + row)) * 64 + chunk * 8;
      *(LAS u32x4*)((LAS unsigned char*)tab + SC_BW_OFF + row * 144 + chunk * 16) = *(const u32x4*)(sw.w2t + src);
      *(LAS u32x4*)((LAS unsigned char*)tab + SC_BA_OFF + row * 144 + chunk * 16) = *(const u32x4*)(sw.a2t + src); }
    __syncthreads();
    if (wid >= 4 && wid < 6) scan_produce(fl, tab, RWC, SG, SB, sw, sw.mu_prev + 1792, sw.mu_next + 1792, b, h, dir, 0, wid - 4, lane);
    else if (wid >= 6) scan_rv(fl, tab, RWC, b, h, dir, 0, (tid - 384) >> 2, (tid - 384) & 3);
    __syncthreads();
    const int vp = tid >> 3, kq = tid & 7;
    f32x2 S0[4], S1[4];
#pragma unroll
    for (int i = 0; i < 4; ++i) { S0[i] = (f32x2){0.f, 0.f}; S1[i] = (f32x2){0.f, 0.f}; }
    bf16_t* Y = dir ? YB : YF;
    bf16_t* yptr = Y + ((size_t)b * SEQ + (dir ? SEQ - 1 : 0)) * 512 + h * 64 + 2 * vp;
    const long ystep = dir ? -512L : 512L;
    for (int ch = 0; ch < SEQ / SC_CH; ++ch) {
        LAS float* sl = fl + (ch & 1) * SC_SLOT;
        if (wid < 4) {
            const LAS float* base = sl + 8 * kq;
            const LAS float* vbase = sl + SC_V * SC_ARR + 2 * vp;
            f32x4 nkk0, nkk1, nw0, nw1, nka0, nka1, nkd0, nkd1, nr0, nr1; f32x2 nvv;
#define SC_LOAD(s_) do { const LAS float* p_ = base + (s_) * 64; \
                nkk0 = *(const LAS f32x4*)(p_ + SC_KK * SC_ARR); nkk1 = *(const LAS f32x4*)(p_ + SC_KK * SC_ARR + 4); \
                nw0 = *(const LAS f32x4*)(p_ + SC_W * SC_ARR); nw1 = *(const LAS f32x4*)(p_ + SC_W * SC_ARR + 4); \
                nka0 = *(const LAS f32x4*)(p_ + SC_KKA * SC_ARR); nka1 = *(const LAS f32x4*)(p_ + SC_KKA * SC_ARR + 4); \
                nkd0 = *(const LAS f32x4*)(p_ + SC_KD * SC_ARR); nkd1 = *(const LAS f32x4*)(p_ + SC_KD * SC_ARR + 4); \
                nr0 = *(const LAS f32x4*)(p_ + SC_R * SC_ARR); nr1 = *(const LAS f32x4*)(p_ + SC_R * SC_ARR + 4); \
                nvv = *(const LAS f32x2*)(vbase + (s_) * 64); } while (0)
            SC_LOAD(0);
#pragma unroll 2
            for (int s = 0; s < SC_CH; ++s) {
                f32x2 kk[4], w[4], ka[4], kd[4], r[4];
                kk[0] = nkk0.xy; kk[1] = nkk0.zw; kk[2] = nkk1.xy; kk[3] = nkk1.zw;
                w[0] = nw0.xy; w[1] = nw0.zw; w[2] = nw1.xy; w[3] = nw1.zw;
                ka[0] = nka0.xy; ka[1] = nka0.zw; ka[2] = nka1.xy; ka[3] = nka1.zw;
                kd[0] = nkd0.xy; kd[1] = nkd0.zw; kd[2] = nkd1.xy; kd[3] = nkd1.zw;
                r[0] = nr0.xy; r[1] = nr0.zw; r[2] = nr1.xy; r[3] = nr1.zw;
                const f32x2 vv = nvv;
                SC_LOAD((s + 1) & (SC_CH - 1));
                f32x2 t0 = S0[0] * kk[0], t1 = S1[0] * kk[0];
#pragma unroll
                for (int i = 1; i < 4; ++i) { t0 = S0[i] * kk[i] + t0; t1 = S1[i] * kk[i] + t1; }
                const float sa0 = red8(t0.x + t0.y), sa1 = red8(t1.x + t1.y);
                const f32x2 n0 = (f32x2){-sa0, -sa0}, n1 = (f32x2){-sa1, -sa1}, v0 = (f32x2){vv.x, vv.x}, v1 = (f32x2){vv.y, vv.y};
                f32x2 y0 = (f32x2){0.f, 0.f}, y1 = (f32x2){0.f, 0.f};
#pragma unroll
                for (int i = 0; i < 4; ++i) {
                    S0[i] = S0[i] * w[i] + (v0 * kd[i] + n0 * ka[i]);
                    S1[i] = S1[i] * w[i] + (v1 * kd[i] + n1 * ka[i]);
                    y0 = S0[i] * r[i] + y0; y1 = S1[i] * r[i] + y1;
                }
                float yp0 = y0.x + y0.y, yp1 = y1.x + y1.y; asm volatile("" : "+v"(yp0));
                const float ys0 = red8_nopack(yp0), ys1 = red8(yp1);
                if (kq == 0) *(unsigned*)yptr = cvt_pk_bf16(ys0, ys1);
                yptr += ystep;
            }
#undef SC_LOAD
        } else if (wid < 6) {
            if (ch + 1 < SEQ / SC_CH) scan_produce(fl + ((ch + 1) & 1) * SC_SLOT, tab, RWC, SG, SB, sw, sw.mu_prev + 1792, sw.mu_next + 1792, b, h, dir, ch + 1, wid - 4, lane);
        } else {
            if (ch + 1 < SEQ / SC_CH) scan_rv(fl + ((ch + 1) & 1) * SC_SLOT, tab, RWC, b, h, dir, ch + 1, (tid - 384) >> 2, (tid - 384) & 3);
            conv_item(C2cv, cvw, cvb, unit * 16384 + ch * 128 + (tid - 384));
            { const int j = tid - 384, tok = j >> 2, pr = j & 3, sc = ch * SC_CH + tok, t = dir ? (SEQ - 1 - sc) : sc, cg8 = 8 * (2 * h + dir) + 2 * pr;
              const bf16_t* rp = RWC + ((size_t)b * SEQ + t) * LD_RWC + 1792 + cg8;
              const unsigned uc = *(const unsigned*)rp, up = *(const unsigned*)(t > 0 ? rp - LD_RWC : rp), un = *(const unsigned*)(t < SEQ - 1 ? rp + LD_RWC : rp);
              const float fp = t > 0 ? 1.f : 0.f, fn = t < SEQ - 1 ? 1.f : 0.f;
              const float c0 = bflo(uc), c1 = bfhi(uc);
              const float z0 = sigmoid_f(c0 + tab[704 + 2 * pr] * (bflo(up) * fp - c0) + tab[712 + 2 * pr] * (bflo(un) * fn - c0));
              const float z1 = sigmoid_f(c1 + tab[705 + 2 * pr] * (bfhi(up) * fp - c1) + tab[713 + 2 * pr] * (bfhi(un) * fn - c1));
              *(unsigned*)(SG + ((size_t)b * SEQ + t) * 256 + cg8) = cvt_pk_bf16(z0, z1); }
            { const int j = tid - 384, tok = j >> 2, qq = j & 3;
              const LAS float* rp = sl + SC_R * SC_ARR + tok * 64 + 16 * qq; const LAS float* kp = sl + SC_KD * SC_ARR + tok * 64 + 16 * qq; const LAS float* gp = tab + 912 + 16 * qq;
              float acc = 0.f;
#pragma unroll
              for (int i4 = 0; i4 < 4; ++i4) { const f32x4 r4 = *(const LAS f32x4*)(rp + 4 * i4), k4 = *(const LAS f32x4*)(kp + 4 * i4), g4 = *(const LAS f32x4*)(gp + 4 * i4);
                  acc += (r4[0] * k4[0] * g4[0] + r4[1] * k4[1] * g4[1]) + (r4[2] * k4[2] * g4[2] + r4[3] * k4[3] * g4[3]); }
              acc += dpp_f<0xB1>(acc); acc += dpp_f<0x4E>(acc);
              if (qq == 0) { const int sc = ch * SC_CH + tok; const int t = dir ? (SEQ - 1 - sc) : sc; SB[((size_t)dir * T + (size_t)b * SEQ + t) * 8 + h] = acc; } }
        }
        __syncthreads();
    }
}


#define XB_TMO      128
#define XB_XCNT(j)  (256  + 64 * (j))
#define XB_XSUB(j)  (1280 + 64 * (j))
#define XB_XGEN(j)  (2304 + 64 * (j))
#define XB_TOP      3328
#define XB_TOPGEN   3392
#define XB_SPIN_CAP (1u << 22)
__device__ __forceinline__ unsigned xb_ld(unsigned* p)              { return __hip_atomic_load(p, __ATOMIC_RELAXED, __HIP_MEMORY_SCOPE_AGENT); }
__device__ __forceinline__ unsigned xb_add(unsigned* p, unsigned v) { return __hip_atomic_fetch_add(p, v, __ATOMIC_RELAXED, __HIP_MEMORY_SCOPE_AGENT); }
__device__ __forceinline__ unsigned xb_xcc_id() { return (unsigned)__builtin_amdgcn_s_getreg((3 << 11) | 20) & 0xFu; }
#define XB_SPIN(cond, bar) do { unsigned _sp = 0; while (cond) { __builtin_amdgcn_s_sleep(1); \
    if ((++_sp & 255u) == 0u) { if (xb_ld(&(bar)[XB_TMO])) break; if (_sp > XB_SPIN_CAP) { atomicAdd(&(bar)[XB_TMO], 1u); break; } } } } while (0)
struct XcdBarrier { unsigned* bar; unsigned x; volatile LAS unsigned* st; };
__device__ __forceinline__ XcdBarrier xcd_barrier_post(unsigned* bar, volatile LAS unsigned* st) {
    XcdBarrier b; b.bar = bar; b.x = xb_xcc_id(); b.st = st;
    if (threadIdx.x == 0) (void)xb_add(&bar[XB_XCNT(b.x)], 1u);
    return b;
}
__device__ __forceinline__ void xcd_barrier_complete(unsigned* bar, unsigned x, unsigned& nloc, unsigned& nx) {
    const unsigned G = gridDim.x * gridDim.y * gridDim.z;
    unsigned sum, cnt, mine, sp = 0u;
    for (;;) {
        sum = 0u; cnt = 0u; mine = 0u;
#pragma unroll
        for (unsigned j = 0; j < 16; ++j) { const unsigned c = xb_ld(&bar[XB_XCNT(j)]); sum += c; cnt += (c > 0u) ? 1u : 0u; mine = (j == x) ? c : mine; }
        if (sum == G) break;
        __builtin_amdgcn_s_sleep(1);
        if ((++sp & 255u) == 0u) { if (xb_ld(&bar[XB_TMO])) break; if (sp > XB_SPIN_CAP) { atomicAdd(&bar[XB_TMO], 1u); break; } }
    }
    nloc = mine > 0u ? mine : 1u; nx = cnt > 0u ? cnt : 1u;
}
__device__ __forceinline__ void xcd_barrier(const XcdBarrier& b) {
    asm volatile("s_waitcnt vmcnt(0)" ::: "memory");
    __syncthreads();
    if (threadIdx.x == 0) {
        unsigned* bar = b.bar;
        __builtin_amdgcn_s_waitcnt(0);
        unsigned nloc = b.st[0], nx = b.st[1];
        if (nloc == 0u) { xcd_barrier_complete(bar, b.x, nloc, nx); b.st[0] = nloc; b.st[1] = nx; }
        const unsigned old = xb_add(&bar[XB_XSUB(b.x)], 1u);
        const unsigned gen = old / nloc;
        if (old + 1u == (gen + 1u) * nloc) {
            __builtin_amdgcn_fence(__ATOMIC_RELEASE, "agent");
            asm volatile("s_waitcnt vmcnt(0)" ::: "memory");
            const unsigned og = xb_add(&bar[XB_TOP], 1u);
            const unsigned tg = og / nx;
            if (og + 1u == (tg + 1u) * nx) xb_add(&bar[XB_TOPGEN], 1u);
            else XB_SPIN(xb_ld(&bar[XB_TOPGEN]) == tg, bar);
            __builtin_amdgcn_fence(__ATOMIC_ACQUIRE, "agent");
            xb_add(&bar[XB_XGEN(b.x)], 1u);
            asm volatile("s_waitcnt vmcnt(0)" ::: "memory");
        } else {
            XB_SPIN(xb_ld(&bar[XB_XGEN(b.x)]) == gen, bar);
            __builtin_amdgcn_fence(__ATOMIC_ACQUIRE, "agent");
            asm volatile("s_waitcnt vmcnt(0)" ::: "memory");
        }
    }
    __syncthreads();
}

#ifdef MK_DBG_STOP
#define DBG_STOP(k) do { if ((k) == MK_DBG_STOP && l == 0) { dbg_dump(p, ws0, bx * 512 + (int)threadIdx.x, G * 512); return; } } while (0)
__device__ __noinline__ void dbg_dump(const Params& p, unsigned char* ws, int gtid, int NGT) {
    const bf16_t* rwc = (const bf16_t*)(ws + WS_RWC); const bf16_t* c2 = (const bf16_t*)(ws + WS_C2); const bf16_t* yf = (const bf16_t*)(ws + WS_YF); const bf16_t* yb = (const bf16_t*)(ws + WS_YB);
    const bf16_t* sg = (const bf16_t*)(ws + WS_SG); const float* sb = (const float*)(ws + WS_SB); const bf16_t* hb = (const bf16_t*)(ws + WS_H);
    for (size_t i = gtid; i < (size_t)T * 1024; i += NGT) {
        const size_t m = i >> 10; const int c = (int)(i & 1023);
        float v = 0.f;
#if MK_DBG_WHAT == 0
        v = bflo(rwc[m * 2048 + 2 * c]) + bflo(rwc[m * 2048 + 2 * c + 1]);
#elif MK_DBG_WHAT == 1
        v = bflo(c2[m * 2304 + 2 * c]) + bflo(c2[m * 2304 + 2 * c + 1]) + (c < 256 ? bflo(c2[m * 2304 + 2048 + c]) : 0.f);
#elif MK_DBG_WHAT == 2
        v = (c < 512 ? bflo(yf[m * 512 + c]) : bflo(yb[m * 512 + c - 512]));
#elif MK_DBG_WHAT == 3
        v = (c < 256 ? bflo(sg[m * 256 + c]) : (c < 272 ? sb[((c - 256) >> 3) * (size_t)T * 8 + m * 8 + (c & 7)] : bflo(hb[m * 1024 + c])));
#elif MK_DBG_WHAT == 6
        v = bflo(((const bf16_t*)(ws + WS_WIN))[(size_t)(4352 + (m % 3072)) * 1024 + c]) + bflo(hb[m * 1024 + c]);
#elif MK_DBG_WHAT == 5
        v = bflo(((const bf16_t*)(ws + WS_GT))[m * 1024 + c]);
#elif MK_DBG_WHAT == 4
        v = bflo(rwc[(size_t)T * 1024 + m * 1024 + c]);
#endif
        p.out[i] = v;
    }
}
#else
#define DBG_STOP(k) do { } while (0)
#endif

#define L1_REFRESH() do { asm volatile("s_waitcnt vmcnt(0)" ::: "memory"); __builtin_amdgcn_fence(__ATOMIC_ACQUIRE, "agent"); asm volatile("s_waitcnt vmcnt(0)" ::: "memory"); } while (0)
#define PHASE_IDS() int tid = threadIdx.x; asm volatile("" : "+v"(tid)); const int lane = tid & 63, wave = __builtin_amdgcn_readfirstlane(tid >> 6); const int gw = vcu * 8 + wave, gtid = bx * 512 + tid; (void)lane; (void)gw; (void)gtid
#define Win_t ((bf16_t*)(ws + WS_WIN))
#define Wbr_t ((bf16_t*)(ws + WS_WBR))
#define Wout_t ((bf16_t*)(ws + WS_WOUT))
#define W1_t ((bf16_t*)(ws + WS_W1))
#define W2_t ((bf16_t*)(ws + WS_W2))
#define w2t ((bf16_t*)(ws + WS_W2T))
#define a2t ((bf16_t*)(ws + WS_A2T))
#define g2t ((bf16_t*)(ws + WS_G2T))
#define Hb ((bf16_t*)(ws + WS_H))
#define RWC ((bf16_t*)(ws + WS_RWC))
#define C2 ((bf16_t*)(ws + WS_C2))
#define YF ((bf16_t*)(ws + WS_YF))
#define YB ((bf16_t*)(ws + WS_YB))
#define SG ((bf16_t*)(ws + WS_SG))
#define VT ((bf16_t*)(ws + WS_VT))
#define SB ((float*)(ws + WS_SB))
#define Gt ((bf16_t*)(ws + WS_GT))
#define Mg ((bf16_t*)(ws + WS_MRG))
#define Ub ((bf16_t*)(ws + WS_U))
__global__ void __launch_bounds__(512, 2) fwd_megakernel(Params p) {
    extern __shared__ __attribute__((aligned(16))) unsigned char lds_raw[];
    LAS unsigned char* lds = (LAS unsigned char*)lds_raw;
    cg::grid_group grid = cg::this_grid();
    volatile LAS unsigned* misc = (volatile LAS unsigned*)(lds + 139264);
    if (threadIdx.x < 16) misc[threadIdx.x] = 0u;
    __syncthreads();
    XcdBarrier xbar = xcd_barrier_post((unsigned*)(p.ws + 65536), misc);
    grid.sync();
    const int G = gridDim.x, bx = blockIdx.x;
    const int vcu = (G % 8 == 0) ? (bx % 8) * (G / 8) + bx / 8 : bx;
    const int NGW = G * 8, NGT = G * 512;
    float* X = p.out;

    for (int l = 0; l < DEPTH; ++l) {
        const float* xin = (l == 0) ? p.in[0] : X;
        unsigned char* ws0 = p.ws; asm volatile("" : "+s"(ws0));
        GAS unsigned char* ws = (GAS unsigned char*)ws0;
        if (PHMASK & (1u << 0)) {
            PHASE_IDS();
            LAS float* scr = (LAS float*)(lds + wave * 8448);
            const float* w_in = p.in[2] + (size_t)l * D_MODEL * IN_COLS;
            const float* w_br = p.in[19] + (size_t)l * 3 * 512 * D_MODEL;
            const float* w_out = p.in[20] + (size_t)l * D_MODEL * D_MODEL;
            const float* w_m1 = p.in[22] + (size_t)l * D_MODEL * D_FF;
            const float* w_m2 = p.in[23] + (size_t)l * D_FF * D_MODEL;
            const float* rw_w2 = p.in[6] + (size_t)l * 2 * 64 * 512;
            const float* rw_a2 = p.in[8] + (size_t)l * 2 * 64 * 512;
            const float* rw_g2 = p.in[9] + (size_t)l * 128 * 512;
            constexpr int I_IN = 232 * 16, I_BR = 3 * 8 * 32, I_OUT = 16 * 32, I_M1 = 16 * 128, I_M2 = 64 * 32, I_L = 32, I_G = 32;
            constexpr int NITEMS = I_IN + I_BR + I_OUT + I_M1 + I_M2 + 2 * I_L + I_G;
            for (int it = gw; it < NITEMS; it += NGW) {
                int r = it;
                if (r < I_IN) { const int db = r % 232, kb = r / 232; int src;
                    if (db < 60) src = 32 * db;
                    else if (db < 64) {
                        const int c = lane & 7;
#pragma unroll
                        for (int j = 0; j < 4; ++j) { const int n = (lane >> 3) + 8 * j; *(u32x4*)(Win_t + (size_t)(32 * db + n) * D_MODEL + 64 * kb + 8 * c) = (u32x4){0u, 0u, 0u, 0u}; }
                        continue; }
                    else if (db < 112) src = 1920 + 32 * (db - 64);
                    else if (db < 136) { const int pp = 32 * (db - 112), tile = pp >> 8, c = pp & 255, bj = c >> 7, wc = (c & 127) >> 5; src = 3456 + tile * 256 + 64 * wc + 32 * bj; }
                    else src = 4224 + 32 * (db - 136);
                    transpose_item(w_in, IN_COLS, 64 * kb, src, Win_t, D_MODEL, 32 * db, scr, lane); continue; }
                r -= I_IN;
                if (r < I_BR) { const int bb = r / 256, q = r % 256, kb = q / 32, nb = q % 32;
                    transpose_item(w_br + (size_t)bb * 512 * D_MODEL, D_MODEL, 64 * kb, 32 * nb, Wbr_t + (size_t)bb * D_MODEL * 512, 512, 32 * nb, scr, lane); continue; }
                r -= I_BR;
                if (r < I_OUT) { transpose_item(w_out, D_MODEL, 64 * (r / 32), 32 * (r % 32), Wout_t, D_MODEL, 32 * (r % 32), scr, lane); continue; }
                r -= I_OUT;
                if (r < I_M1) { transpose_item(w_m1, D_FF, 64 * (r / 128), 32 * (r % 128), W1_t, D_MODEL, 32 * (r % 128), scr, lane); continue; }
                r -= I_M1;
                if (r < I_M2) { transpose_item(w_m2, D_MODEL, 64 * (r / 32), 32 * (r % 32), W2_t, D_FF, 32 * (r % 32), scr, lane); continue; }
                r -= I_M2;
                if (r < I_L) { const int dd = r / 16, nb = r % 16; transpose_item(rw_w2 + (size_t)dd * 64 * 512, 512, 0, 32 * nb, w2t + (size_t)dd * 512 * 64, 64, 32 * nb, scr, lane); continue; }
                r -= I_L;
                if (r < I_L) { const int dd = r / 16, nb = r % 16; transpose_item(rw_a2 + (size_t)dd * 64 * 512, 512, 0, 32 * nb, a2t + (size_t)dd * 512 * 64, 64, 32 * nb, scr, lane); continue; }
                r -= I_L;
                { const int kb = r / 16, nb = r % 16; transpose_item(rw_g2, 512, 64 * kb, 32 * nb, g2t, 256, 32 * nb, scr, lane); }
            }
            for (int i = gtid; i < 512 * 16; i += NGT) *(u32x4*)(g2t + (size_t)(i >> 4) * 256 + 128 + 8 * (i & 15)) = (u32x4){0u, 0u, 0u, 0u};
            if (l == 0) for (int i = gtid; i < T * 16; i += NGT) *(u32x4*)(SG + (size_t)(i >> 4) * 256 + 128 + 8 * (i & 15)) = (u32x4){0u, 0u, 0u, 0u};
            const float* g1 = p.in[1] + (size_t)l * D_MODEL;
            if (T % (2 * NGW) == 0) { for (int m = gw; m < T; m += 2 * NGW) rms_row2(xin + (size_t)m * D_MODEL, xin + (size_t)(m + NGW) * D_MODEL, g1, Hb + (size_t)m * D_MODEL, Hb + (size_t)(m + NGW) * D_MODEL, lane); }
            else { for (int m = gw; m < T; m += NGW) rms_row(xin + (size_t)m * D_MODEL, g1, Hb + (size_t)m * D_MODEL, lane); }
        }
        xcd_barrier(xbar);
        DBG_STOP(1);
        if (PHMASK & (1u << 1)) {
            pg8::StaticOrder S;
#ifndef SKIP_P2A
            { pg8::Gemm g{Hb, Win_t, T, 3584, D_MODEL, D_MODEL}; S.init(T, 3584, G, bx);
              pg8::EpiStore<0> E{RWC, LD_RWC, C2, LD_C2, 8}; pg8::gemm_phase(lds, g, S, E); }
#endif
#ifndef SKIP_P2B
            { pg8::Gemm g{Hb, Win_t + (size_t)3584 * D_MODEL, T, 768, D_MODEL, D_MODEL}; S.init(T, 768, G, bx);
              pg8::EpiAttn E{C2, VT, p.in[17] + l * 64, p.in[18] + l * 64}; pg8::gemm_phase(lds, g, S, E); }
#endif
        }
        xcd_barrier(xbar);
        DBG_STOP(2);
        if (PHMASK & (1u << 2)) {
            PHASE_IDS();
            const float* cvw = p.in[15] + (size_t)l * 3 * 512; const float* cvb = p.in[16] + (size_t)l * 512;
            ScanW sw{p.in[3] + (size_t)l * RW_COLS, p.in[4] + (size_t)l * RW_COLS, p.in[5] + (size_t)l * 1024, p.in[7] + (size_t)l * 1024,
                     p.in[10] + (size_t)l * 512, p.in[11] + (size_t)l * 512, p.in[12] + (size_t)l * 512, w2t, a2t};
#ifndef SKIP_SCAN
#ifdef MK_DUP_SCAN
            for (int u = vcu; u < 256; u += G) { scan_unit(lds, RWC, YF, YB, SG, SB, sw, u >> 4, (u >> 1) & 7, u & 1, C2, cvw, cvb, u); __syncthreads(); }
#endif
            for (int u = vcu; u < 256; u += G) { scan_unit(lds, RWC, YF, YB, SG, SB, sw, u >> 4, (u >> 1) & 7, u & 1, C2, cvw, cvb, u); __syncthreads(); }
#endif
#ifndef SKIP_ATTN
#ifdef MK_DUP_ATTN
            for (int u = vcu; u < 1024; u += G) { attn_unit(lds, C2, (bf16_t*)(ws + 892 * MiB), u >> 6, (u >> 5) & 1, u & 31); }
#endif
            for (int u = vcu; u < 1024; u += G) { attn_unit(lds, C2, nullptr, u >> 6, (u >> 5) & 1, u & 31); }
#endif
        }
        xcd_barrier(xbar);
        DBG_STOP(3);
        if (PHMASK & (1u << 3)) {
            PHASE_IDS();
            const float* mup = p.in[3] + (size_t)l * RW_COLS + 1024; const float* mun = p.in[4] + (size_t)l * RW_COLS + 1024;
            const float* lng = p.in[13] + (size_t)l * 512; const float* lnb = p.in[14] + (size_t)l * 512;
            for (int m = gw; m < T; m += NGW) {
                const int t = m & 4095, c0 = 8 * lane, hh = lane >> 3;
                float yf[8], yb[8], vc[8], vpv[8], vn[8], y[8];
                unpack8(*(const u32x4*)(YF + (size_t)m * 512 + c0), yf); unpack8(*(const u32x4*)(YB + (size_t)m * 512 + c0), yb);
                const bf16_t* rp = RWC + (size_t)m * LD_RWC + 1024 + c0;
                unpack8(*(const u32x4*)rp, vc);
                if (t > 0) unpack8(*(const u32x4*)(rp - LD_RWC), vpv); else {
#pragma unroll
                    for (int j = 0; j < 8; ++j) vpv[j] = 0.f; }
                if (t < SEQ - 1) unpack8(*(const u32x4*)(rp + LD_RWC), vn); else {
#pragma unroll
                    for (int j = 0; j < 8; ++j) vn[j] = 0.f; }
                float s = 0.f;
#pragma unroll
                for (int j = 0; j < 8; ++j) { y[j] = yf[j] + yb[j]; s += y[j]; }
                const float mean = red8(s) * (1.f / 64.f);
                float q = 0.f;
#pragma unroll
                for (int j = 0; j < 8; ++j) { y[j] -= mean; q += y[j] * y[j]; }
                const float rstd = __builtin_amdgcn_rsqf(red8(q) * (1.f / 64.f) + 64e-5f);
                const float bs = 0.5f * (SB[(size_t)m * 8 + hh] + SB[((size_t)T + m) * 8 + hh]);
                float o[8];
#pragma unroll
                for (int j = 0; j < 8; ++j) { const float zv = vc[j] + mup[c0 + j] * (vpv[j] - vc[j]) + mun[c0 + j] * (vn[j] - vc[j]);
                    o[j] = y[j] * rstd * lng[c0 + j] + lnb[c0 + j] + bs * zv; }
                *(u32x4*)(YF + (size_t)m * 512 + c0) = pack8(o);
            }
        }
        xcd_barrier(xbar);
        DBG_STOP(4);
        if (PHMASK & (1u << 4)) {
            pg8::StaticOrder S; pg8::Gemm g{SG, g2t, T, 512, 256, 256}; S.init(T, 512, G, bx);
            pg8::EpiMulInPlace E{YF, 512}; pg8::gemm_phase(lds, g, S, E);
        }
        xcd_barrier(xbar);
        DBG_STOP(5);
        if (PHMASK & (1u << 5)) {
            pg8::StaticOrder S; S.init(T, 1024, G, bx);
            const bf16_t* Wg = Win_t + (size_t)4352 * D_MODEL;
            if (P4_CALLS >= 1)
            { pg8::Gemm g{Hb, Wg, T, 1024, D_MODEL, D_MODEL}; pg8::EpiStore<MK_GATE_ACT> E{Gt, D_MODEL, Gt, D_MODEL, 1 << 20}; pg8::gemm_phase(lds, g, S, E); }
            L1_REFRESH();
            if (P4_CALLS >= 2)
            { pg8::Gemm g{YF, Wbr_t, T, 1024, 512, 512}; pg8::EpiBranch<true> E{Gt, Mg}; pg8::gemm_phase(lds, g, S, E); }
            if (P4_CALLS >= 3)
            { pg8::Gemm g{Hb, Wg + (size_t)1024 * D_MODEL, T, 1024, D_MODEL, D_MODEL}; pg8::EpiStore<1> E{Gt, D_MODEL, Gt, D_MODEL, 1 << 20}; pg8::gemm_phase(lds, g, S, E); }
            L1_REFRESH();
            if (P4_CALLS >= 4)
            { pg8::Gemm g{C2, Wbr_t + (size_t)1024 * 512, T, 1024, 512, LD_C2}; pg8::EpiBranch<false> E{Gt, Mg}; pg8::gemm_phase(lds, g, S, E); }
            if (P4_CALLS >= 5)
            { pg8::Gemm g{Hb, Wg + (size_t)2048 * D_MODEL, T, 1024, D_MODEL, D_MODEL}; pg8::EpiStore<1> E{Gt, D_MODEL, Gt, D_MODEL, 1 << 20}; pg8::gemm_phase(lds, g, S, E); }
            L1_REFRESH();
            if (P4_CALLS >= 6)
            { pg8::Gemm g{C2 + 1536, Wbr_t + (size_t)2048 * 512, T, 1024, 512, LD_C2}; pg8::EpiBranch<false> E{Gt, Mg}; pg8::gemm_phase(lds, g, S, E); }
        }
        xcd_barrier(xbar);
        DBG_STOP(6);
        if (PHMASK & (1u << 6)) {
            pg8::StaticOrder S; S.init(T, 1024, G, bx);
            pg8::Gemm g{Mg, Wout_t, T, 1024, D_MODEL, D_MODEL}; pg8::EpiResidual E{xin, X}; pg8::gemm_phase(lds, g, S, E);
        }
        xcd_barrier(xbar);
        DBG_STOP(7);
        if (PHMASK & (1u << 7)) {
            PHASE_IDS();
            const float* g2 = p.in[21] + (size_t)l * D_MODEL;
            if (T % (2 * NGW) == 0) { for (int m = gw; m < T; m += 2 * NGW) rms_row2(X + (size_t)m * D_MODEL, X + (size_t)(m + NGW) * D_MODEL, g2, Hb + (size_t)m * D_MODEL, Hb + (size_t)(m + NGW) * D_MODEL, lane); }
            else { for (int m = gw; m < T; m += NGW) rms_row(X + (size_t)m * D_MODEL, g2, Hb + (size_t)m * D_MODEL, lane); }
        }
        xcd_barrier(xbar);
        DBG_STOP(8);
        if (PHMASK & (1u << 8)) {
            pg8::StaticOrder S; S.init(T, D_FF, G, bx);
            pg8::Gemm g{Hb, W1_t, T, D_FF, D_MODEL, D_MODEL}; pg8::EpiStore<2> E{Ub, D_FF, Ub, D_FF, 1 << 20}; pg8::gemm_phase(lds, g, S, E);
#ifdef MK_DUP_P7
            pg8::gemm_phase(lds, g, S, E);
#endif
        }
        xcd_barrier(xbar);
        DBG_STOP(9);
        if (PHMASK & (1u << 9)) {
            pg8::StaticOrder S; S.init(T, 1024, G, bx);
            pg8::Gemm g{Ub, W2_t, T, 1024, D_FF, D_FF}; pg8::EpiResidual E{X, X}; pg8::gemm_phase(lds, g, S, E);
        }
        xcd_barrier(xbar);
        DBG_STOP(10);
    }
}

extern "C" void kernel_launch(void* const* d_in, const int* in_sizes, int n_in, void* d_out, int out_size, void* d_ws, size_t ws_size, hipStream_t stream) {
    static int grid = 0;
    if (grid == 0) {
        if (n_in != 24 || out_size != T * D_MODEL || ws_size < WS_END) { fprintf(stderr, "kernel_launch: unexpected shapes (n_in %d out %d ws %zu)\n", n_in, out_size, ws_size); grid = -1; return; }
        int dev = 0, cus = 0, per_cu = 0;
        hipGetDevice(&dev);
        hipDeviceGetAttribute(&cus, hipDeviceAttributeMultiprocessorCount, dev);
        hipFuncSetAttribute((const void*)fwd_megakernel, hipFuncAttributeMaxDynamicSharedMemorySize, LDS_BYTES);
        hipOccupancyMaxActiveBlocksPerMultiprocessor(&per_cu, (const void*)fwd_megakernel, 512, LDS_BYTES);
        if (per_cu < 1) { fprintf(stderr, "kernel_launch: occupancy query says %d blocks per CU\n", per_cu); per_cu = 1; }
        (void)hipGetLastError();
        grid = cus;
    }
    if (grid < 0) return;
    if (hipMemsetAsync(d_ws, 0, 1u << 20, stream) != hipSuccess) { fprintf(stderr, "kernel_launch: memset failed\n"); return; }
    Params p{};
    for (int i = 0; i < 24; ++i) p.in[i] = (const float*)d_in[i];
    p.out = (float*)d_out; p.ws = (unsigned char*)d_ws;
    void* args[] = {&p};
    hipError_t e = hipLaunchCooperativeKernel((const void*)fwd_megakernel, dim3(grid), dim3(512), args, LDS_BYTES, stream);
    if (e != hipSuccess) fprintf(stderr, "cooperative launch failed: %s (grid %d)\n", hipGetErrorString(e), grid);
}
```
